# Optimizing an MI355X kernel written in HIP

```python
import jax, jax.numpy as jnp
from jax import lax
import numpy as np

D_MODEL = 2048
BATCH = 16
SEQ = 2048
DEPTH = 4
DEC_BATCH = 4
DEC_SEQ = 4096
PAST_LEN = 128

N_META = 16
GRID_W = 64
NORM_EPS = 1e-6
N_MIXERS = 3
N_RG = (DEPTH + 2) // 3
N_NA = (DEPTH + 1) // 3
N_GDN = DEPTH // 3
CONV4_PAD_LEFT = 1

RG_WIDTH = D_MODEL
RG_BLOCK = 256
RG_BLOCKS = RG_WIDTH // RG_BLOCK
RG_CONV = 4
RG_C = 8.0

NA_HEAD_DIM = 128
NA_HEADS = D_MODEL // NA_HEAD_DIM
NA_WIN_R = 8
NA_WIN_C = 16
NA_QCB = 16
NA_KCB = NA_QCB + NA_WIN_C
NA_NCB = GRID_W // NA_QCB
NEG_INF = -1e30

GDN_DK = 128
GDN_DV = 128
GDN_QK_HEADS = D_MODEL // GDN_DK
GDN_V_HEADS = 2 * GDN_QK_HEADS
GDN_KEY_DIM = GDN_QK_HEADS * GDN_DK
GDN_VAL_DIM = GDN_V_HEADS * GDN_DV
GDN_CONV_DIM = 2 * GDN_KEY_DIM + GDN_VAL_DIM
GDN_PROJ = GDN_CONV_DIM + GDN_VAL_DIM + 4 * GDN_V_HEADS
GDN_CONV = 4
GDN_CHUNK = 64

D_FF = ((8 * D_MODEL // 3 + 255) // 256) * 256
FFN_CONV = 3

kernel_name = 'hybrid_bidir_encoder_rglru_natten_gdn'


def _rmsnorm(x, w):
    xf = x.astype(jnp.float32)
    y = xf * lax.rsqrt(jnp.mean(xf * xf, axis=-1, keepdims=True) + NORM_EPS)
    return (y * w.astype(jnp.float32)).astype(x.dtype)


def _dwconv(x, w, pad_left):
    K, T = w.shape[0], x.shape[1]
    xp = jnp.pad(x, ((0, 0), (pad_left, K - 1 - pad_left), (0, 0)))
    y = xp[:, 0:T] * w[0]
    for j in range(1, K):
        y = y + xp[:, j:j + T] * w[j]
    return y


def _linear_combine(left, right):
    a1, b1 = left
    a2, b2 = right
    return a1 * a2, a2 * b1 + b2


def _rglru_scan(xc, w_a, b_a, w_i, b_i, lam, reverse):
    B, T, W = xc.shape
    xb = xc.reshape(B, T, RG_BLOCKS, RG_BLOCK)
    r = jax.nn.sigmoid(jnp.einsum('btnc,ncd->btnd', xb, w_a.astype(jnp.float32)).reshape(B, T, W) + b_a.astype(jnp.float32))
    i = jax.nn.sigmoid(jnp.einsum('btnc,ncd->btnd', xb, w_i.astype(jnp.float32)).reshape(B, T, W) + b_i.astype(jnp.float32))
    log_a = -RG_C * r * jax.nn.softplus(-lam.astype(jnp.float32))
    a = jnp.exp(log_a)
    u = jnp.sqrt(-jnp.expm1(2.0 * log_a)) * (i * xc)
    _, hs = lax.associative_scan(_linear_combine, (a, u), axis=1, reverse=reverse)
    return hs


def _rglru_mixer(h, w_in, conv_w, conv_b, w_a, b_a, w_i, b_i, lam, w_out):
    y = h @ w_in
    gate = jax.nn.gelu(y[..., :RG_WIDTH], approximate=True)
    xc = (_dwconv(y[..., RG_WIDTH:], conv_w, CONV4_PAD_LEFT) + conv_b).astype(jnp.float32)
    hs = (_rglru_scan(xc, w_a[0], b_a[0], w_i[0], b_i[0], lam[0], False)
          + _rglru_scan(xc, w_a[1], b_a[1], w_i[1], b_i[1], lam[1], True))
    return (gate * hs.astype(h.dtype)) @ w_out


def _na_mixer(h, w_qkv, rpb, meta_bias, w_o):
    B, T, _ = h.shape
    L = T - N_META
    rows = L // GRID_W
    kh = min(NA_WIN_R, rows)
    qkv = (h @ w_qkv).reshape(B, T, 3, NA_HEADS, NA_HEAD_DIM)
    q = qkv[:, :, 0] * (NA_HEAD_DIM ** -0.5)
    k = qkv[:, :, 1]
    v = qkv[:, :, 2]
    qm, km, vm = q[:, :N_META], k[:, :N_META], v[:, :N_META]
    kg = k[:, N_META:].reshape(B, rows, GRID_W, NA_HEADS, NA_HEAD_DIM)
    vg = v[:, N_META:].reshape(B, rows, GRID_W, NA_HEADS, NA_HEAD_DIM)
    qg = q[:, N_META:].reshape(B, rows, GRID_W, NA_HEADS, NA_HEAD_DIM).transpose(1, 0, 2, 3, 4)
    mb = meta_bias.astype(jnp.float32)
    rpb_f = rpb.astype(jnp.float32)

    s_m = jnp.einsum('bqhd,bkhd->bhqk', qm, km).astype(jnp.float32) + mb[:, None, :]
    out_meta = jnp.einsum('bhqk,bkhd->bqhd', jax.nn.softmax(s_m, axis=-1).astype(v.dtype), vm)

    r_idx = np.arange(rows)
    row_start = np.clip(r_idx - NA_WIN_R // 2, 0, rows - kh)
    row_off = row_start[:, None] + np.arange(kh)[None, :] - r_idx[:, None] + NA_WIN_R - 1
    cols = np.arange(GRID_W)
    col_start = np.clip(cols - NA_WIN_C // 2, 0, GRID_W - NA_WIN_C).reshape(NA_NCB, NA_QCB)
    kblk_start = [int(np.clip(b * NA_QCB - NA_WIN_C // 2, 0, GRID_W - NA_KCB)) for b in range(NA_NCB)]
    key_col = np.array(kblk_start)[:, None] + np.arange(NA_KCB)[None, :]
    q_col = cols.reshape(NA_NCB, NA_QCB)
    col_valid = jnp.asarray((key_col[:, None, :] >= col_start[..., None]) & (key_col[:, None, :] < col_start[..., None] + NA_WIN_C))
    col_off = jnp.asarray(np.clip(key_col[:, None, :] - q_col[..., None], -(NA_WIN_C - 1), NA_WIN_C - 1) + NA_WIN_C - 1, jnp.int32)

    def row_attend(args):
        q_r, rs_r, roff_r = args
        k_r = lax.dynamic_slice_in_dim(kg, rs_r, kh, axis=1)
        v_r = lax.dynamic_slice_in_dim(vg, rs_r, kh, axis=1)
        k_b = jnp.stack([k_r[:, :, s:s + NA_KCB] for s in kblk_start], axis=1)
        v_b = jnp.stack([v_r[:, :, s:s + NA_KCB] for s in kblk_start], axis=1)
        q_b = q_r.reshape(B, NA_NCB, NA_QCB, NA_HEADS, NA_HEAD_DIM)
        s_loc = jnp.einsum('bnqhd,bnrkhd->bhnqrk', q_b, k_b).astype(jnp.float32)
        bias = rpb_f[:, roff_r[None, None, :, None], col_off[:, :, None, :]]
        s_loc = jnp.where(col_valid[:, :, None, :], s_loc + bias, NEG_INF)
        s_met = jnp.einsum('bnqhd,bmhd->bhnqm', q_b, km).astype(jnp.float32) + mb[:, None, None, :]
        s_all = jnp.concatenate([s_loc.reshape(B, NA_HEADS, NA_NCB, NA_QCB, kh * NA_KCB), s_met], axis=-1)
        p = jax.nn.softmax(s_all, axis=-1).astype(v.dtype)
        p_loc = p[..., :kh * NA_KCB].reshape(B, NA_HEADS, NA_NCB, NA_QCB, kh, NA_KCB)
        p_met = p[..., kh * NA_KCB:]
        o = jnp.einsum('bhnqrk,bnrkhd->bnqhd', p_loc, v_b) + jnp.einsum('bhnqm,bmhd->bnqhd', p_met, vm)
        return o.reshape(B, GRID_W, NA_HEADS, NA_HEAD_DIM)

    out_grid = lax.map(row_attend, (qg, jnp.asarray(row_start, jnp.int32), jnp.asarray(row_off, jnp.int32)))
    out_grid = out_grid.transpose(1, 0, 2, 3, 4).reshape(B, L, NA_HEADS, NA_HEAD_DIM)
    o = jnp.concatenate([out_meta, out_grid], axis=1).reshape(B, T, NA_HEADS * NA_HEAD_DIM)
    return o @ w_o


def _l2norm(x):
    return x * lax.rsqrt(jnp.sum(x * x, axis=-1, keepdims=True) + 1e-6)


def _chunk_gated_delta(q, k, v, beta, g):
    B, T, H, DK = q.shape
    DV = v.shape[-1]
    C = GDN_CHUNK
    N = T // C

    def to_chunks(t):
        return jnp.moveaxis(t.reshape((B, N, C) + t.shape[2:]), 3, 1)

    q = to_chunks(q) * (DK ** -0.5)
    k = to_chunks(k)
    v = to_chunks(v)
    beta = to_chunks(beta)
    g = jnp.cumsum(to_chunks(g), axis=-1)
    incl = jnp.tril(jnp.ones((C, C), dtype=bool))
    strict = jnp.tril(jnp.ones((C, C), dtype=bool), -1)
    decay = jnp.where(incl, jnp.exp(jnp.where(incl, g[..., :, None] - g[..., None, :], 0.0)), 0.0)
    kk = jnp.einsum('bhncd,bhnsd->bhncs', k, k)
    a_mat = jnp.where(strict, kk * decay, 0.0) * beta[..., :, None] + jnp.eye(C, dtype=q.dtype)
    rhs = jnp.concatenate([v * beta[..., None], k * (beta * jnp.exp(g))[..., None]], axis=-1)
    sol = lax.linalg.triangular_solve(a_mat, rhs, left_side=True, lower=True, unit_diagonal=True)
    u, w = sol[..., :DV], sol[..., DV:]
    qk = jnp.where(incl, jnp.einsum('bhncd,bhnsd->bhncs', q, k) * decay, 0.0)
    g_last = g[..., -1]
    k_st = k * jnp.exp(g_last[..., None] - g)[..., None]
    q_st = q * jnp.exp(g)[..., None]
    xs = tuple(jnp.moveaxis(t, 2, 0) for t in (q_st, k_st, u, w, qk, g_last))

    def step(S, inp):
        q_i, k_i, u_i, w_i, qk_i, gl_i = inp
        v_new = u_i - jnp.einsum('bhcd,bhde->bhce', w_i, S)
        o_i = jnp.einsum('bhcd,bhde->bhce', q_i, S) + jnp.einsum('bhcs,bhse->bhce', qk_i, v_new)
        S = S * jnp.exp(gl_i)[..., None, None] + jnp.einsum('bhcd,bhce->bhde', k_i, v_new)
        return S, o_i

    S0 = jnp.zeros((B, H, DK, DV), jnp.float32)
    _, o = lax.scan(step, S0, xs)
    return o.transpose(1, 0, 3, 2, 4).reshape(B, T, H, DV)


def _gdn_mixer(h, w_in, conv_w, a_log, dt_bias, norm_w, w_out):
    B, T, _ = h.shape
    proj = h @ w_in
    qkv = jax.nn.silu(_dwconv(proj[..., :GDN_CONV_DIM], conv_w, CONV4_PAD_LEFT)).astype(jnp.float32)
    z = proj[..., GDN_CONV_DIM:GDN_CONV_DIM + GDN_VAL_DIM].astype(jnp.float32).reshape(B, T, GDN_V_HEADS, GDN_DV)
    ba = proj[..., GDN_CONV_DIM + GDN_VAL_DIM:].astype(jnp.float32).reshape(B, T, 2, 2, GDN_V_HEADS)
    beta = jax.nn.sigmoid(ba[:, :, 0])
    g = -jnp.exp(a_log.astype(jnp.float32)) * jax.nn.softplus(ba[:, :, 1] + dt_bias.astype(jnp.float32))
    q = _l2norm(qkv[..., :GDN_KEY_DIM].reshape(B, T, GDN_QK_HEADS, GDN_DK))
    k = _l2norm(qkv[..., GDN_KEY_DIM:2 * GDN_KEY_DIM].reshape(B, T, GDN_QK_HEADS, GDN_DK))
    v = qkv[..., 2 * GDN_KEY_DIM:].reshape(B, T, GDN_V_HEADS, GDN_DV)
    rep = GDN_V_HEADS // GDN_QK_HEADS
    q = jnp.repeat(q, rep, axis=2)
    k = jnp.repeat(k, rep, axis=2)
    pad = (-T) % GDN_CHUNK

    def pad_t(t):
        return jnp.pad(t, [(0, 0), (pad, 0)] + [(0, 0)] * (t.ndim - 2))

    def flip(t):
        return jnp.flip(t, axis=1)

    q, k, v, beta, g = pad_t(q), pad_t(k), pad_t(v), pad_t(beta), pad_t(g)
    o_f = _chunk_gated_delta(q, k, v, beta[:, :, 0], g[:, :, 0])
    o_b = flip(_chunk_gated_delta(flip(q), flip(k), flip(v), flip(beta[:, :, 1]), flip(g[:, :, 1])))
    o = (o_f + o_b)[:, pad:]
    o = o * lax.rsqrt(jnp.mean(o * o, axis=-1, keepdims=True) + NORM_EPS) * norm_w.astype(jnp.float32) * jax.nn.silu(z)
    return o.reshape(B, T, GDN_VAL_DIM).astype(h.dtype) @ w_out


def _conv_ffn(h, w_gate, w_up, conv_w, conv_b, w_down):
    a = _dwconv(h @ w_gate, conv_w, FFN_CONV // 2) + conv_b
    return (jax.nn.silu(a) * (h @ w_up)) @ w_down


def _trunk(x, meta_tokens, mix_norm, ffn_norm, final_norm,
           rg_w_in, rg_conv_w, rg_conv_b, rg_w_a, rg_b_a, rg_w_i, rg_b_i, rg_lam, rg_w_out,
           na_w_qkv, na_rpb, na_meta_bias, na_w_o,
           gdn_w_in, gdn_conv_w, gdn_a_log, gdn_dt_bias, gdn_norm_w, gdn_w_out,
           ffn_w_gate, ffn_w_up, ffn_conv_w, ffn_conv_b, ffn_w_down):
    B = x.shape[0]
    meta = jnp.broadcast_to(meta_tokens.astype(x.dtype)[None], (B, N_META, D_MODEL))
    h = jnp.concatenate([meta, x], axis=1)
    for i in range(DEPTH):
        kind, j = i % N_MIXERS, i // N_MIXERS
        hn = _rmsnorm(h, mix_norm[i])
        if kind == 0:
            mix = _rglru_mixer(hn, rg_w_in[j], rg_conv_w[j], rg_conv_b[j], rg_w_a[j], rg_b_a[j],
                               rg_w_i[j], rg_b_i[j], rg_lam[j], rg_w_out[j])
        elif kind == 1:
            mix = _na_mixer(hn, na_w_qkv[j], na_rpb[j], na_meta_bias[j], na_w_o[j])
        else:
            mix = _gdn_mixer(hn, gdn_w_in[j], gdn_conv_w[j], gdn_a_log[j], gdn_dt_bias[j],
                             gdn_norm_w[j], gdn_w_out[j])
        h = h + mix
        h = h + _conv_ffn(_rmsnorm(h, ffn_norm[i]), ffn_w_gate[i], ffn_w_up[i], ffn_conv_w[i],
                          ffn_conv_b[i], ffn_w_down[i])
    return _rmsnorm(h, final_norm)[:, N_META:]


def setup_inputs(seed: int = 0) -> dict:
    key = jax.random.key(seed)
    ks = iter(jax.random.split(key, 40))

    def nrm(shape, scale):
        return jax.random.normal(next(ks), shape, jnp.float32) * scale

    def gain(shape):
        return 1.0 + nrm(shape, 0.02)

    u_lru = jax.random.uniform(next(ks), (N_RG, 2, RG_WIDTH), jnp.float32, 0.9, 0.999)
    a_lru = u_lru ** (1.0 / RG_C)
    rg_lam = jnp.log(a_lru) - jnp.log1p(-a_lru)
    gdn_a_log = jnp.log(jax.random.uniform(next(ks), (N_GDN, 2, GDN_V_HEADS), jnp.float32, 1.0, 16.0))
    return {
        'x_prompt': nrm((BATCH, SEQ, D_MODEL), 1.0),
        'x_sample': nrm((DEC_BATCH, DEC_SEQ, D_MODEL), 1.0),
        'meta_tokens': nrm((N_META, D_MODEL), 1.0),
        'mix_norm': gain((DEPTH, D_MODEL)),
        'ffn_norm': gain((DEPTH, D_MODEL)),
        'final_norm': gain((D_MODEL,)),
        'rg_w_in': nrm((N_RG, D_MODEL, 2 * RG_WIDTH), D_MODEL ** -0.5),
        'rg_conv_w': nrm((N_RG, RG_CONV, RG_WIDTH), RG_CONV ** -0.5),
        'rg_conv_b': nrm((N_RG, RG_WIDTH), 0.02),
        'rg_w_a': nrm((N_RG, 2, RG_BLOCKS, RG_BLOCK, RG_BLOCK), RG_BLOCK ** -0.5),
        'rg_b_a': nrm((N_RG, 2, RG_WIDTH), 0.02),
        'rg_w_i': nrm((N_RG, 2, RG_BLOCKS, RG_BLOCK, RG_BLOCK), RG_BLOCK ** -0.5),
        'rg_b_i': nrm((N_RG, 2, RG_WIDTH), 0.02),
        'rg_lam': rg_lam,
        'rg_w_out': nrm((N_RG, RG_WIDTH, D_MODEL), RG_WIDTH ** -0.5),
        'na_w_qkv': nrm((N_NA, D_MODEL, 3 * NA_HEADS * NA_HEAD_DIM), D_MODEL ** -0.5),
        'na_rpb': nrm((N_NA, NA_HEADS, 2 * NA_WIN_R - 1, 2 * NA_WIN_C - 1), 0.1),
        'na_meta_bias': nrm((N_NA, NA_HEADS, N_META), 0.1),
        'na_w_o': nrm((N_NA, NA_HEADS * NA_HEAD_DIM, D_MODEL), (NA_HEADS * NA_HEAD_DIM) ** -0.5),
        'gdn_w_in': nrm((N_GDN, D_MODEL, GDN_PROJ), D_MODEL ** -0.5),
        'gdn_conv_w': nrm((N_GDN, GDN_CONV, GDN_CONV_DIM), GDN_CONV ** -0.5),
        'gdn_a_log': gdn_a_log,
        'gdn_dt_bias': 1.0 + nrm((N_GDN, 2, GDN_V_HEADS), 0.1),
        'gdn_norm_w': gain((N_GDN, GDN_DV)),
        'gdn_w_out': nrm((N_GDN, GDN_VAL_DIM, D_MODEL), GDN_VAL_DIM ** -0.5),
        'ffn_w_gate': nrm((DEPTH, D_MODEL, D_FF), D_MODEL ** -0.5),
        'ffn_w_up': nrm((DEPTH, D_MODEL, D_FF), D_MODEL ** -0.5),
        'ffn_conv_w': nrm((DEPTH, FFN_CONV, D_FF), FFN_CONV ** -0.5),
        'ffn_conv_b': nrm((DEPTH, D_FF), 0.02),
        'ffn_w_down': nrm((DEPTH, D_FF, D_MODEL), D_FF ** -0.5),
    }


def reference(x_prompt, x_sample, meta_tokens, mix_norm, ffn_norm, final_norm,
              rg_w_in, rg_conv_w, rg_conv_b, rg_w_a, rg_b_a, rg_w_i, rg_b_i, rg_lam, rg_w_out,
              na_w_qkv, na_rpb, na_meta_bias, na_w_o,
              gdn_w_in, gdn_conv_w, gdn_a_log, gdn_dt_bias, gdn_norm_w, gdn_w_out,
              ffn_w_gate, ffn_w_up, ffn_conv_w, ffn_conv_b, ffn_w_down):
    weights = (meta_tokens, mix_norm, ffn_norm, final_norm,
               rg_w_in, rg_conv_w, rg_conv_b, rg_w_a, rg_b_a, rg_w_i, rg_b_i, rg_lam, rg_w_out,
               na_w_qkv, na_rpb, na_meta_bias, na_w_o,
               gdn_w_in, gdn_conv_w, gdn_a_log, gdn_dt_bias, gdn_norm_w, gdn_w_out,
               ffn_w_gate, ffn_w_up, ffn_conv_w, ffn_conv_b, ffn_w_down)
    y_prompt = _trunk(x_prompt, *weights)
    y_sample = _trunk(x_sample, *weights)
    return (y_prompt, y_sample)
```

```cpp
#include <hip/hip_runtime.h>
#include <cstdio>
#include <cstdint>

#define LAS __attribute__((address_space(3)))
#define GAS __attribute__((address_space(1)))
typedef unsigned short bf16_t;
typedef short bf16x8 __attribute__((ext_vector_type(8)));
typedef short s16x4 __attribute__((ext_vector_type(4)));
typedef float f32x4 __attribute__((ext_vector_type(4)));
typedef float f32x2 __attribute__((ext_vector_type(2)));
typedef unsigned u32x4 __attribute__((ext_vector_type(4)));
typedef unsigned u32x2 __attribute__((ext_vector_type(2)));
#define DI __device__ __forceinline__

constexpr int D = 2048, NSEQ = 20, NPROMPT = 16, TP = 2064, TS = 4112, LP = 2048, LS = 4096, NMETA = 16;
constexpr int MPROMPT = NPROMPT * TP;
constexpr int MTOK = MPROMPT + 4 * TS;
constexpr int MP = 49664;
constexpr int DFF = 5632;
constexpr float NORM_EPS = 1e-6f;
DI int seq_off(int b) { return b < NPROMPT ? b * TP : MPROMPT + (b - NPROMPT) * TS; }
DI int seq_len(int b) { return b < NPROMPT ? TP : TS; }
DI void row_bt(int R, int& b, int& t) { if (R < MPROMPT) { b = R / TP; t = R - b * TP; } else { const int q = (R - MPROMPT) / TS; b = NPROMPT + q; t = R - MPROMPT - q * TS; } }

typedef __bf16 bf16v2_ __attribute__((ext_vector_type(2)));
DI unsigned cvt_pk_bf16(float lo, float hi) { const bf16v2_ r = __builtin_convertvector((f32x2){lo, hi}, bf16v2_); return __builtin_bit_cast(unsigned, r); }
DI float bf_lo(unsigned w) { return __uint_as_float(w << 16); }
DI float bf_hi(unsigned w) { return __uint_as_float(w & 0xffff0000u); }
DI float bf2f(bf16_t h) { return __uint_as_float(((unsigned)h) << 16); }
DI bf16_t f2bf(float f) { return (bf16_t)(cvt_pk_bf16(f, 0.f) & 0xffffu); }
DI float fast_rcp(float x) { return __builtin_amdgcn_rcpf(x); }
DI float sigmoidf_(float x) { return fast_rcp(1.f + __expf(-x)); }
DI float siluf_(float x) { return x * sigmoidf_(x); }
DI float softplusf_(float x) { return x > 20.f ? x : log1pf(__expf(x)); }
DI float softplus_lite(float x) { const float e = __expf(x), u = 1.f + e, d = u - 1.f; return x > 20.f ? x : (d == 0.f ? e : __logf(u) * e * fast_rcp(d)); }
DI float gelu_tanh_(float x) { const float u = 1.5957691216057308f * (x + 0.044715f * x * x * x); return x * sigmoidf_(u); }
DI int lane_id() { int r; asm volatile("v_mbcnt_lo_u32_b32 %0, -1, 0\n\tv_mbcnt_hi_u32_b32 %0, -1, %0" : "=&v"(r)); return r; }
DI float wave_sum(float v) {
#pragma unroll
    for (int o = 1; o < 64; o <<= 1) v += __shfl_xor(v, o);
    return v;
}

#define XB_TMO      128
#define XB_XCNT(j)  (256  + 64 * (j))
#define XB_XSUB(j)  (1280 + 64 * (j))
#define XB_XGEN(j)  (2304 + 64 * (j))
#define XB_TOP      3328
#define XB_TOPGEN   3392
#define XCD_BAR_WORDS 3456
#define XB_SPIN_CAP (1u << 22)
DI unsigned xb_ld(unsigned* p)              { return __hip_atomic_load(p, __ATOMIC_RELAXED, __HIP_MEMORY_SCOPE_AGENT); }
DI unsigned xb_add(unsigned* p, unsigned v) { return __hip_atomic_fetch_add(p, v, __ATOMIC_RELAXED, __HIP_MEMORY_SCOPE_AGENT); }
DI unsigned xb_xcc_id() { return (unsigned)__builtin_amdgcn_s_getreg((3 << 11) | 20) & 0xFu; }
#define XB_SPIN(cond, bar) do { unsigned _sp = 0; while (cond) { __builtin_amdgcn_s_sleep(1); \
    if ((++_sp & 255u) == 0u) { if (xb_ld(&(bar)[XB_TMO])) break; if (_sp > XB_SPIN_CAP) { atomicAdd(&(bar)[XB_TMO], 1u); break; } } } } while (0)
struct XcdBarrier { unsigned* bar; unsigned x; volatile LAS unsigned* st; };
DI XcdBarrier xcd_barrier_post(unsigned* bar, volatile LAS unsigned* st, bool leader) {
    XcdBarrier b; b.bar = bar; b.x = xb_xcc_id(); b.st = st;
    if (leader) (void)xb_add(&bar[XB_XCNT(b.x)], 1u);
    return b;
}
DI void xcd_barrier_complete(unsigned* bar, unsigned x, unsigned& nloc, unsigned& nx) {
    const unsigned G = gridDim.x * gridDim.y * gridDim.z;
    unsigned sum, cnt, mine, sp = 0u;
    for (;;) {
        sum = 0u; cnt = 0u; mine = 0u;
#pragma unroll
        for (unsigned j = 0; j < 16; ++j) { const unsigned c = xb_ld(&bar[XB_XCNT(j)]); sum += c; cnt += (c > 0u) ? 1u : 0u; mine = (j == x) ? c : mine; }
        if (sum == G) break;
        __builtin_amdgcn_s_sleep(1);
        if ((++sp & 255u) == 0u) { if (xb_ld(&bar[XB_TMO])) break; if (sp > XB_SPIN_CAP) { atomicAdd(&bar[XB_TMO], 1u); break; } }
    }
    nloc = mine > 0u ? mine : 1u; nx = cnt > 0u ? cnt : 1u;
}
DI void xcd_barrier(const XcdBarrier& b, bool leader) {
    asm volatile("s_waitcnt vmcnt(0)" ::: "memory");
    __syncthreads();
    if (leader) {
        unsigned* bar = b.bar;
        __builtin_amdgcn_s_waitcnt(0);
        unsigned nloc = b.st[0], nx = b.st[1];
        if (nloc == 0u) { xcd_barrier_complete(bar, b.x, nloc, nx); b.st[0] = nloc; b.st[1] = nx; }
        const unsigned old = xb_add(&bar[XB_XSUB(b.x)], 1u);
        const unsigned gen = old / nloc;
        if (old + 1u == (gen + 1u) * nloc) {
            __builtin_amdgcn_fence(__ATOMIC_RELEASE, "agent");
            asm volatile("s_waitcnt vmcnt(0)" ::: "memory");
            const unsigned og = xb_add(&bar[XB_TOP], 1u);
            const unsigned tg = og / nx;
            if (og + 1u == (tg + 1u) * nx) xb_add(&bar[XB_TOPGEN], 1u);
            else XB_SPIN(xb_ld(&bar[XB_TOPGEN]) == tg, bar);
            __builtin_amdgcn_fence(__ATOMIC_ACQUIRE, "agent");
            xb_add(&bar[XB_XGEN(b.x)], 1u);
            asm volatile("s_waitcnt vmcnt(0)" ::: "memory");
        } else {
            XB_SPIN(xb_ld(&bar[XB_XGEN(b.x)]) == gen, bar);
            __builtin_amdgcn_fence(__ATOMIC_ACQUIRE, "agent");
            asm volatile("s_waitcnt vmcnt(0)" ::: "memory");
        }
    }
    __syncthreads();
}

namespace pg8 {
constexpr int BM = 256, BK = 64, HALF = 128, HTB = HALF * BK * 2, STAGE_BYTES = 8 * HTB, NXCD = 8;
__host__ __device__ __forceinline__ int lds_byte(int r, int c) { const int st = (r >> 4) * 2 + (c >> 5), rr = r & 15, cc = c & 31, ob = rr * 64 + cc * 2; return st * 1024 + (ob ^ (((ob >> 9) & 1) << 5)); }
__host__ __device__ __forceinline__ void stage_rc(int b, int& R, int& C) { const int st = b / 1024, sb = b % 1024, swz = sb ^ (((sb >> 9) & 1) << 5); R = (st >> 1) * 16 + swz / 64; C = (st & 1) * 32 + (swz % 64) / 2; }
__host__ __device__ __forceinline__ int perm32(int rho) { const int n = rho >> 4, i = rho & 15; return 8 * (i >> 2) + 4 * n + (i & 3); }

struct Unit { int pm, pn; long aoff, boff; int nt, sub; };
struct Gemm { const char* A; const char* B; unsigned lda, ldb; long hstepA, hstepB; int nt; };
struct TileOrder {
    int nM, nN, nwg, G, c, WGM;
    DI void init(int nM_, int nN_, int G_, int c_, int wgm_ = 4) { nM = nM_; nN = nN_; nwg = nM * nN; G = G_; c = c_; WGM = wgm_; }
    DI bool tile(int i, int& pm, int& pn) const {
        const long L = (long)i * G + c; if (L >= nwg) return false;
        int wgid = (int)L; { const int q = nwg / NXCD, r = nwg % NXCD, xcd = wgid % NXCD, off = wgid / NXCD; wgid = (xcd < r ? xcd * (q + 1) : r * (q + 1) + (xcd - r) * q) + off; }
        const int nig = WGM * nN, gid = wgid / nig, fm = gid * WGM, gsz = (nM - fm) < WGM ? (nM - fm) : WGM;
        pm = fm + ((wgid % nig) % gsz); pn = (wgid % nig) / gsz; return true;
    }
};

template <class Epi, class Sched, bool ALIGN_EPI>
DI void gemm_phase(LAS unsigned char* lds, const Gemm g, const Sched& S, const Epi& E, int wave_id) {
    int tid_ = wave_id * 64 + lane_id(); asm volatile("" : "+v"(tid_));
    const int tid = tid_, wid = __builtin_amdgcn_readfirstlane(tid >> 6), lane = tid & 63, wr = wid >> 2, wc = wid & 3, fr = lane & 15, fq = lane >> 4;
    unsigned voffA[2], voffB[2];
#pragma unroll
    for (int i = 0; i < 2; ++i) { int R, C; stage_rc(tid * 16 + i * 8192, R, C); const int Rb = Epi::PERM ? ((R & ~31) + perm32(R & 31)) : R;
        voffA[i] = (unsigned)R * g.lda + (unsigned)C * 2u; voffB[i] = (unsigned)Rb * g.ldb + (unsigned)C * 2u; }
    const long kstep = (long)(BK * 2);
    const long hA = g.hstepA, hB = g.hstepB;
    const unsigned ldsw = (unsigned)wid * 1024u;
    const int aoff = lds_byte(wr * 64 + fr, fq * 8), boff = lds_byte(wc * 32 + fr, fq * 8);
#define PG8_SA(b, h) (((b) * 2 + (h)) * HTB)
#define PG8_SB(b, h) ((4 + (b) * 2 + (h)) * HTB)
#define PG8_STAGE(bufoff, gbase, voff) do { _Pragma("unroll") for (int _i = 0; _i < 2; ++_i) \
        __builtin_amdgcn_global_load_lds((const unsigned*)((const char*)(gbase) + (voff)[_i]), (LAS unsigned*)(lds + (bufoff) + ldsw + _i * 8192), 16, 0, 0); } while (0)
#define PG8_LDA(dst, b, h) do { _Pragma("unroll") for (int m = 0; m < 4; ++m) _Pragma("unroll") for (int k = 0; k < 2; ++k) dst[m][k] = *(const LAS bf16x8*)(lds + PG8_SA(b, h) + aoff + m * 2048 + k * 1024); } while (0)
#define PG8_LDB(dst, b, h) do { _Pragma("unroll") for (int n = 0; n < 2; ++n) _Pragma("unroll") for (int k = 0; k < 2; ++k) dst[n][k] = *(const LAS bf16x8*)(lds + PG8_SB(b, h) + boff + n * 2048 + k * 1024); } while (0)
#define PG8_MMA(ai, bj, At, Bt) do { __builtin_amdgcn_s_setprio(1); _Pragma("unroll") for (int m = 0; m < 4; ++m) _Pragma("unroll") for (int n = 0; n < 2; ++n) _Pragma("unroll") for (int k = 0; k < 2; ++k) \
        acc[ai][bj][m][n] = __builtin_amdgcn_mfma_f32_16x16x32_bf16(Bt[n][k], At[m][k], acc[ai][bj][m][n], 0, 0, 0); __builtin_amdgcn_s_setprio(0); } while (0)
#define PG8_WAIT_V(n) asm volatile("s_waitcnt vmcnt(" #n ")" ::: "memory")
#define PG8_WAIT_L(n) asm volatile("s_waitcnt lgkmcnt(" #n ")" ::: "memory")
#define PG8_BAR __builtin_amdgcn_s_barrier()
#define PG8_SCHED __builtin_amdgcn_sched_barrier(0)
    Unit cur, nxt; int ui = 0;
    if (!S.next(0, cur)) return;
    f32x4 acc[2][2][4][2];
#pragma unroll
    for (int a = 0; a < 2; ++a)
#pragma unroll
        for (int b = 0; b < 2; ++b)
#pragma unroll
            for (int m = 0; m < 4; ++m)
#pragma unroll
                for (int n = 0; n < 2; ++n) acc[a][b][m][n] = (f32x4){0.f, 0.f, 0.f, 0.f};
    bf16x8 At[4][2], B0[2][2], B1[2][2];
    const char* cA = g.A + cur.aoff; const char* cB = g.B + cur.boff;
    PG8_STAGE(PG8_SB(0, 0), cB, voffB); PG8_STAGE(PG8_SB(0, 1), cB + hB, voffB); PG8_STAGE(PG8_SA(0, 0), cA, voffA); PG8_STAGE(PG8_SA(0, 1), cA + hA, voffA);
    if (wr == 1) PG8_BAR;
    PG8_WAIT_V(2); PG8_BAR;
    PG8_STAGE(PG8_SB(1, 0), cB + kstep, voffB); PG8_STAGE(PG8_SA(1, 0), cA + kstep, voffA); PG8_STAGE(PG8_SB(1, 1), cB + hB + kstep, voffB);
    PG8_WAIT_V(6); PG8_BAR;
    for (;;) {
        const bool has_next = S.next(ui + 1, nxt);
        const char* nA = has_next ? g.A + nxt.aoff : cA; const char* nB = has_next ? g.B + nxt.boff : cB;
        const int nt = cur.nt;
        for (int t = 0; t < nt; t += 2) {
            const bool last = (t == nt - 2);
            const char* a1 = cA + (long)(t + 1) * kstep;
            const char* a2 = last ? nA : cA + (long)(t + 2) * kstep; const char* b2 = last ? nB : cB + (long)(t + 2) * kstep;
            const char* a3 = a2 + kstep; const char* b3 = b2 + kstep;
            PG8_LDB(B0, 0, 0); PG8_LDB(B1, 0, 1); PG8_SCHED; PG8_LDA(At, 0, 0); PG8_STAGE(PG8_SA(1, 1), a1 + hA, voffA);
            PG8_WAIT_V(8); PG8_WAIT_L(0); PG8_BAR; PG8_MMA(0, 0, At, B0); PG8_MMA(0, 1, At, B1); PG8_BAR; PG8_SCHED;
            PG8_LDA(At, 0, 1); PG8_STAGE(PG8_SB(0, 0), b2, voffB); PG8_STAGE(PG8_SB(0, 1), b2 + hB, voffB); PG8_STAGE(PG8_SA(0, 0), a2, voffA);
            PG8_WAIT_V(8); PG8_WAIT_L(0); PG8_BAR; PG8_MMA(1, 0, At, B0); PG8_MMA(1, 1, At, B1); PG8_BAR; PG8_SCHED;
            PG8_LDB(B0, 1, 0); PG8_LDB(B1, 1, 1); PG8_SCHED; PG8_LDA(At, 1, 0); PG8_STAGE(PG8_SA(0, 1), a2 + hA, voffA);
            PG8_WAIT_V(8); PG8_WAIT_L(0); PG8_BAR; PG8_MMA(0, 0, At, B0); PG8_MMA(0, 1, At, B1); PG8_BAR; PG8_SCHED;
            PG8_LDA(At, 1, 1); PG8_STAGE(PG8_SB(1, 0), b3, voffB); PG8_STAGE(PG8_SB(1, 1), b3 + hB, voffB); PG8_STAGE(PG8_SA(1, 0), a3, voffA);
            PG8_WAIT_V(8); PG8_WAIT_L(0); PG8_BAR; PG8_MMA(1, 0, At, B0); PG8_MMA(1, 1, At, B1); PG8_BAR; PG8_SCHED;
        }
        if constexpr (ALIGN_EPI) { if (wr == 0) PG8_BAR; }
        E(acc, cur, ui, wr, wc, fr, fq);
        if (!has_next) break;
#pragma unroll
        for (int a = 0; a < 2; ++a)
#pragma unroll
            for (int b = 0; b < 2; ++b)
#pragma unroll
                for (int m = 0; m < 4; ++m)
#pragma unroll
                    for (int n = 0; n < 2; ++n) acc[a][b][m][n] = (f32x4){0.f, 0.f, 0.f, 0.f};
        cur = nxt; cA = nA; cB = nB; ++ui;
        if constexpr (ALIGN_EPI) { if (wr == 1) PG8_BAR; }
    }
    PG8_WAIT_V(0);
    if constexpr (!ALIGN_EPI) { if (wr == 0) PG8_BAR; }
    PG8_BAR;
#undef PG8_SA
#undef PG8_SB
#undef PG8_STAGE
#undef PG8_LDA
#undef PG8_LDB
#undef PG8_MMA
#undef PG8_WAIT_V
#undef PG8_WAIT_L
#undef PG8_BAR
#undef PG8_SCHED
}
}
constexpr size_t MiB = (size_t)1 << 20;
constexpr size_t WS_CTL = 0, CTL_ZERO_BYTES = 64 * 1024;
constexpr size_t WS_WMIX = 1 * MiB, WS_WFFN = 67 * MiB, WS_XN = 133 * MiB, WS_H = 328 * MiB, WS_SCR = 716 * MiB, WS_END = 1524 * MiB;
constexpr size_t B194 = (size_t)MP * D * 2;
static_assert(B194 == 194 * MiB, "buffer size");
static_assert(WS_XN + 4096 + B194 <= WS_H && WS_H + 2 * B194 <= WS_SCR && WS_SCR + 4 * B194 <= WS_END, "ws map");
static_assert((size_t)MP * DFF * 2 <= WS_END - WS_SCR && (size_t)MP * 6144 * 2 <= WS_END - WS_SCR && WS_SCR + 4 * B194 + (size_t)MP * 128 <= WS_END, "scratch");
constexpr int CW_BAR = 1024;
constexpr int MISC_OFF = 163840 - 256, RING_BYTES = 131072, EDGE_OFF = 131072, EDGE_BYTES = 8192, LDS_BYTES = 163840;

struct Args { const float* in[30]; float* out; unsigned char* ws; int ph_lo, ph_hi; };

struct Frame {
    LAS unsigned char* lds;
    int wave, G, bid;
    DI int lane() const { return lane_id(); }
    DI int tid() const { return wave * 64 + lane_id(); }
    const float* const* in;
    float* out; unsigned char* ws;
    DI const float* I(int i) const { return in[i]; }
    DI bf16_t* XN() const { return (bf16_t*)(ws + WS_XN + 4096); }
    DI bf16_t* XC() const { return (bf16_t*)(ws + WS_H); }
    DI unsigned char* SCR() const { return ws + WS_SCR; }
    DI unsigned char* WMIX() const { return ws + WS_WMIX; }
    DI unsigned char* WFFN() const { return ws + WS_WFFN; }
};

struct SchedLin {
    pg8::TileOrder o; long a_base, a_tile, b_base, b_tile; int nt;
    DI bool next(int i, pg8::Unit& u) const { if (!o.tile(i, u.pm, u.pn)) return false; u.aoff = a_base + (long)u.pm * a_tile; u.boff = b_base + (long)u.pn * b_tile; u.nt = nt; u.sub = -1; return true; }
};
struct SchedGates {
    pg8::TileOrder o;
    DI bool next(int i, pg8::Unit& u) const { if (!o.tile(i, u.pm, u.pn)) return false; const int dir = u.pn >> 4, blk = (u.pn >> 1) & 7, hh = u.pn & 1;
        u.aoff = (long)u.pm * 256 * (D * 2) + blk * 512; u.boff = (long)((dir * 2) * 8 + blk) * 131072 + hh * 65536; u.nt = 4; u.sub = -1; return true; }
};

constexpr int RES_MAIN_PM = 192, RES_ROW0 = RES_MAIN_PM * 256, RES_NSPLIT = 4;
struct SchedRes {
    pg8::TileOrder o; long a_tile, b_base, b_tile; int nt; int G, c;
    DI void init(int G_, int c_, long a_tile_, long b_base_, long b_tile_, int nt_, int wgm_ = 4) { o.init(RES_MAIN_PM, 8, G_, c_, wgm_); G = G_; c = c_; a_tile = a_tile_; b_base = b_base_; b_tile = b_tile_; nt = nt_; }
    DI bool next(int i, pg8::Unit& u) const {
        const long L = (long)i * G + c;
        if (L < RES_MAIN_PM * 8) { o.tile(i, u.pm, u.pn); u.aoff = (long)u.pm * a_tile; u.boff = b_base + (long)u.pn * b_tile; u.nt = nt; u.sub = -1; return true; }
        const int r = (int)(L - RES_MAIN_PM * 8); if (r >= 16 * RES_NSPLIT) return false;
        const int s = r % RES_NSPLIT, t = r / RES_NSPLIT, nts = nt / RES_NSPLIT;
        u.pm = RES_MAIN_PM + (t >> 3); u.pn = t & 7; u.aoff = (long)u.pm * a_tile + (long)s * nts * 128; u.boff = b_base + (long)u.pn * b_tile + (long)s * nts * 128; u.nt = nts; u.sub = s; return true; }
};

DI float row_rs(const float* rsv, int row, int) { return rsv[row]; }
#ifndef NT_STORES
#define NT_STORES 0
#endif
template <class T> DI void st_stream(T* p, const T v) { if (NT_STORES) __builtin_nontemporal_store(v, p); else *p = v; }
DI u32x4 pack8(const f32x4 v0, const f32x4 v1) { u32x4 w; w.x = cvt_pk_bf16(v0[0], v0[1]); w.y = cvt_pk_bf16(v0[2], v0[3]); w.z = cvt_pk_bf16(v1[0], v1[1]); w.w = cvt_pk_bf16(v1[2], v1[3]); return w; }

struct EpiRgIn {
    static constexpr bool PERM = true;
    bf16_t* ygate; bf16_t* yrec; const float* ss;
    DI void operator()(const f32x4 (&acc)[2][2][4][2], const pg8::Unit& u, int, int wr, int wc, int fr, int fq) const {
        const bool isg = u.pn < 8; bf16_t* base = isg ? ygate : yrec; const int colt = (isg ? u.pn : u.pn - 8) * 256;
        const int row0 = u.pm * 256 + wr * 64 + fr, col0 = colt + wc * 32 + 8 * fq;
        float rs8[2][4];
#pragma unroll
        for (int ai = 0; ai < 2; ++ai)
#pragma unroll
            for (int m = 0; m < 4; ++m) rs8[ai][m] = row_rs(ss, row0 + ai * 128 + m * 16, fq);
#pragma unroll
        for (int ai = 0; ai < 2; ++ai)
#pragma unroll
            for (int m = 0; m < 4; ++m) { bf16_t* rowp = base + (size_t)(row0 + ai * 128 + m * 16) * D + col0; const float rs = rs8[ai][m];
#pragma unroll
                for (int bj = 0; bj < 2; ++bj) { f32x4 v0 = acc[ai][bj][m][0] * rs, v1 = acc[ai][bj][m][1] * rs;
                    if (isg) {
#pragma unroll
                        for (int j = 0; j < 4; ++j) { v0[j] = gelu_tanh_(v0[j]); v1[j] = gelu_tanh_(v1[j]); } }
                    st_stream((u32x4*)(rowp + bj * 128), pack8(v0, v1)); } }
    }
};
struct EpiPlainBf16 {
    static constexpr bool PERM = true;
    bf16_t* O; int ldc; const float* ss;
    DI void operator()(const f32x4 (&acc)[2][2][4][2], const pg8::Unit& u, int, int wr, int wc, int fr, int fq) const {
        const int row0 = u.pm * 256 + wr * 64 + fr, col0 = u.pn * 256 + wc * 32 + 8 * fq;
        float rs8[2][4];
#pragma unroll
        for (int ai = 0; ai < 2; ++ai)
#pragma unroll
            for (int m = 0; m < 4; ++m) rs8[ai][m] = row_rs(ss, row0 + ai * 128 + m * 16, fq);
#pragma unroll
        for (int ai = 0; ai < 2; ++ai)
#pragma unroll
            for (int m = 0; m < 4; ++m) { bf16_t* rowp = O + (size_t)(row0 + ai * 128 + m * 16) * ldc + col0; const float rs = rs8[ai][m];
#pragma unroll
                for (int bj = 0; bj < 2; ++bj) st_stream((u32x4*)(rowp + bj * 128), pack8(acc[ai][bj][m][0] * rs, acc[ai][bj][m][1] * rs)); }
    }
};
struct EpiGdnProj {
    static constexpr bool PERM = true;
    bf16_t* qkv; bf16_t* z; float* bg; const float* a_log; const float* dt_bias; bf16_t* halo; const float* ss;
    DI void operator()(const f32x4 (&acc)[2][2][4][2], const pg8::Unit& u, int, int wr, int wc, int fr, int fq) const {
        const int row0 = u.pm * 256 + wr * 64 + fr;
        float rs8[2][4];
#pragma unroll
        for (int ai = 0; ai < 2; ++ai)
#pragma unroll
            for (int m = 0; m < 4; ++m) rs8[ai][m] = row_rs(ss, row0 + ai * 128 + m * 16, fq);
        if (u.pn < 24) {
            bf16_t* base; int ldc, colt; if (u.pn < 16) { base = qkv; ldc = 4096; colt = u.pn * 256; } else { base = z; ldc = 2048; colt = (u.pn - 16) * 256; }
            const int col0 = colt + wc * 32 + 8 * fq;
#pragma unroll
            for (int ai = 0; ai < 2; ++ai)
#pragma unroll
                for (int m = 0; m < 4; ++m) { const int row = row0 + ai * 128 + m * 16; bf16_t* rowp = base + (size_t)row * ldc + col0;
                    const int r64 = row & 63, rb = row >> 6;
                    bf16_t* hp = nullptr;
                    if (u.pn < 16) { if (r64 == 63) hp = halo + ((size_t)(rb + 1) * 3 + 0) * 4096 + col0; else if (r64 == 0 && rb > 0) hp = halo + ((size_t)(rb - 1) * 3 + 1) * 4096 + col0; else if (r64 == 1 && rb > 0) hp = halo + ((size_t)(rb - 1) * 3 + 2) * 4096 + col0; }
                    const float rs = rs8[ai][m];
#pragma unroll
                    for (int bj = 0; bj < 2; ++bj) { const u32x4 w = pack8(acc[ai][bj][m][0] * rs, acc[ai][bj][m][1] * rs); st_stream((u32x4*)(rowp + bj * 128), w); if (hp) *(u32x4*)(hp + bj * 128) = w; } }
        } else {
            const int c0 = wc * 32 + 8 * fq;
            float al[8], db[8];
#pragma unroll
            for (int j = 0; j < 8; ++j) { const int c = c0 + j; al[j] = c >= 64 ? __expf(a_log[c - 64]) : 0.f; db[j] = c >= 64 ? dt_bias[c - 64] : 0.f; }
#pragma unroll
            for (int ai = 0; ai < 2; ++ai)
#pragma unroll
                for (int m = 0; m < 4; ++m) { float* rowp = bg + (size_t)(row0 + ai * 128 + m * 16) * 128 + c0; const float rs = rs8[ai][m];
                    f32x4 o[2];
#pragma unroll
                    for (int n = 0; n < 2; ++n)
#pragma unroll
                        for (int j = 0; j < 4; ++j) { const float x = acc[ai][0][m][n][j] * rs; const int jj = n * 4 + j;
                            o[n][j] = (c0 >= 64) ? -al[jj] * softplusf_(x + db[jj]) : sigmoidf_(x); }
                    *(f32x4*)(rowp) = o[0]; *(f32x4*)(rowp + 4) = o[1]; }
        }
    }
};
struct EpiResAdd {
    static constexpr bool PERM = true;
    const bf16_t* xin; bf16_t* xn; float* ss; float* slab;
    DI void operator()(const f32x4 (&acc)[2][2][4][2], const pg8::Unit& u, int, int wr, int wc, int fr, int fq) const {
        const int row0 = u.pm * 256 + wr * 64 + fr, col0 = u.pn * 256 + wc * 32 + 8 * fq;
        if (u.sub >= 0) {
#pragma unroll
            for (int ai = 0; ai < 2; ++ai)
#pragma unroll
                for (int m = 0; m < 4; ++m) { float* sp = slab + ((size_t)u.sub * 512 + (row0 + ai * 128 + m * 16 - RES_ROW0)) * D + col0;
#pragma unroll
                    for (int bj = 0; bj < 2; ++bj) { *(f32x4*)(sp + bj * 128) = acc[ai][bj][m][0]; *(f32x4*)(sp + bj * 128 + 4) = acc[ai][bj][m][1]; } }
            return; }
        const int l_ = lane_id(); const unsigned voff = (unsigned)((l_ & 15) * D + 8 * (l_ >> 4)) * 2u;
        const char* xi_u = (const char*)xin + ((size_t)(u.pm * 256 + wr * 64) * D + u.pn * 256 + wc * 32) * 2;
        char* xn_u = (char*)xn + ((size_t)(u.pm * 256 + wr * 64) * D + u.pn * 256 + wc * 32) * 2;
        u32x4 v[2][4][2];
#pragma unroll
        for (int ai = 0; ai < 2; ++ai)
#pragma unroll
            for (int m = 0; m < 4; ++m)
#pragma unroll
                for (int bj = 0; bj < 2; ++bj) v[ai][m][bj] = *(const u32x4*)(xi_u + (size_t)(ai * 128 + m * 16) * (D * 2) + bj * 256 + voff);
#pragma unroll
        for (int ai = 0; ai < 2; ++ai) {
#pragma unroll
            for (int m = 0; m < 4; ++m) { const int row = row0 + ai * 128 + m * 16; char* rowp = xn_u + (size_t)(ai * 128 + m * 16) * (D * 2);
                float sq = 0.f;
#pragma unroll
                for (int bj = 0; bj < 2; ++bj) { const u32x4 vv = v[ai][m][bj];
                    const f32x4 h0 = (f32x4){bf_lo(vv.x), bf_hi(vv.x), bf_lo(vv.y), bf_hi(vv.y)} + acc[ai][bj][m][0], h1 = (f32x4){bf_lo(vv.z), bf_hi(vv.z), bf_lo(vv.w), bf_hi(vv.w)} + acc[ai][bj][m][1];
                    const u32x4 w = pack8(h0, h1); *(u32x4*)(rowp + bj * 256 + voff) = w;
                    if (ss) { const float r0 = bf_lo(w.x), r1 = bf_hi(w.x), r2 = bf_lo(w.y), r3 = bf_hi(w.y), r4 = bf_lo(w.z), r5 = bf_hi(w.z), r6 = bf_lo(w.w), r7 = bf_hi(w.w);
                        sq += ((r0 * r0 + r1 * r1) + (r2 * r2 + r3 * r3)) + ((r4 * r4 + r5 * r5) + (r6 * r6 + r7 * r7)); } }
                if (ss) { sq += __shfl_xor(sq, 16); sq += __shfl_xor(sq, 32); if (fq == 0) ss[((size_t)u.pm * 32 + u.pn * 4 + wc) * 256 + (row & 255)] = sq; } }
        }
    }
};
#ifndef GATES_TOP
#define GATES_TOP 4
#endif
struct EpiGates {
    static constexpr bool PERM = true;
    const bf16_t* xc; bf16_t* la; bf16_t* uu;
    size_t dstride; const float* b_a; const float* b_i; const float* lam;
    LAS float* cl;
    DI void operator()(const f32x4 (&acc)[2][2][4][2], const pg8::Unit& u, int, int wr, int wc, int fr, int fq) const {
        const int dir = u.pn >> 4, blk = (u.pn >> 1) & 7, hh = u.pn & 1;
        const int row0 = u.pm * 256 + wr * 64 + fr, c0 = blk * 256 + hh * 128 + wc * 32 + 8 * fq;
        LAS float* cw_ = cl + (wr * 4 + wc) * 96;
        { const int lane = lane_id(); if (lane < 32) { const int c = dir * D + blk * 256 + hh * 128 + wc * 32 + lane;
            cw_[lane] = b_a[c]; cw_[32 + lane] = b_i[c]; cw_[64 + lane] = -8.0f * softplus_lite(-lam[c]); } }
        const int l_ = lane_id(); const unsigned voff = (unsigned)((l_ & 15) * D + 8 * (l_ >> 4)) * 2u;
        const size_t uoff = ((size_t)(u.pm * 256 + wr * 64) * D + blk * 256 + hh * 128 + wc * 32) * 2;
        const char* xc_u = (const char*)xc + uoff; char* la_u = (char*)(la + dir * dstride) + uoff; char* uu_u = (char*)(uu + dir * dstride) + uoff;
        u32x4 xw4[2][4];
#pragma unroll
        for (int g = 0; g < GATES_TOP; ++g) xw4[g >> 2][g & 3] = *(const u32x4*)(xc_u + (size_t)((g >> 2) * 128 + (g & 3) * 16) * (D * 2) + voff);
#pragma unroll
        for (int ai = 0; ai < 2; ++ai) {
#pragma unroll
            for (int m = 0; m < 4; ++m) { const size_t off = (size_t)(ai * 128 + m * 16) * (D * 2);
                const u32x4 xw = xw4[ai][m];
                float xv[8]; xv[0] = bf_lo(xw.x); xv[1] = bf_hi(xw.x); xv[2] = bf_lo(xw.y); xv[3] = bf_hi(xw.y); xv[4] = bf_lo(xw.z); xv[5] = bf_hi(xw.z); xv[6] = bf_lo(xw.w); xv[7] = bf_hi(xw.w);
                f32x4 lo[2], uo[2];
#pragma unroll
                for (int n = 0; n < 2; ++n) { LAS float* cp = cw_ + 8 * fq; asm volatile("" : "+v"(cp));
                    const f32x4 ba = *(const LAS f32x4*)(cp + 4 * n), bi = *(const LAS f32x4*)(cp + 32 + 4 * n), sp = *(const LAS f32x4*)(cp + 64 + 4 * n);
#pragma unroll
                    for (int j = 0; j < 4; ++j) { const int jj = n * 4 + j;
                        const float r = sigmoidf_(acc[ai][0][m][n][j] + ba[j]), ig = sigmoidf_(acc[ai][1][m][n][j] + bi[j]);
                        const float l = sp[j] * r;
                        lo[n][j] = l; const float x2 = 2.0f * l;
                        const float om_e = 1.0f - __expf(x2), om_s = -x2 * (1.0f + 0.5f * x2);
                        const float om = x2 > -0.0009765625f ? om_s : om_e;
                        uo[n][j] = __builtin_amdgcn_sqrtf(fmaxf(om, 0.f)) * (ig * xv[jj]); }
                    __builtin_amdgcn_sched_barrier(0); }
                *(u32x4*)(la_u + off + voff) = pack8(lo[0], lo[1]);
                *(u32x4*)(uu_u + off + voff) = pack8(uo[0], uo[1]);
                __builtin_amdgcn_sched_barrier(0);
                if (ai == 0 && m == 0) {
#pragma unroll
                    for (int g = GATES_TOP; g < 8; ++g) xw4[g >> 2][g & 3] = *(const u32x4*)(xc_u + (size_t)((g >> 2) * 128 + (g & 3) * 16) * (D * 2) + voff);
                    __builtin_amdgcn_sched_barrier(0); } }
        }
    }
};
struct EpiFfnUp {
    static constexpr bool PERM = true;
    bf16_t* act; const float* cw; const float* cb; LAS float* edge; const float* ss; const unsigned char* rflag;
    DI void operator()(f32x4 (&acc)[2][2][4][2], const pg8::Unit& u, int ui, int wr, int wc, int fr, int fq) const {
        const int lane = fq * 16 + fr;
        LAS float* ef = edge + (ui & 1) * 1024, * el = ef + 512;
        LAS float* tapl = edge + 2048 + (wr * 4 + wc) * 128;
        const int cg0 = wc * 32 + 8 * fq;
        float rs8[2][4]; unsigned flp[2] = {0u, 0u};
#pragma unroll
        for (int ai = 0; ai < 2; ++ai)
#pragma unroll
            for (int m = 0; m < 4; ++m) { const int r = 128 * ai + 64 * wr + 16 * m + fr; const int R = 254 * u.pm - 1 + r; const int Rc = R < 0 ? 0 : R;
                rs8[ai][m] = row_rs(ss, Rc, fq); flp[ai] |= ((__float_as_uint(rs8[ai][m]) & 3u) | ((r >= 1 && r <= 254 && R < MTOK) ? 4u : 0u)) << (8 * m); }
        if (lane < 32) { const int a = lane >> 3, c = lane & 7; const float* src = (a < 3 ? cw + (size_t)a * DFF : cb) + u.pn * 128 + wc * 32 + 4 * c;
            *(LAS f32x4*)(tapl + a * 32 + 4 * c) = *(const f32x4*)src; }
#pragma unroll
        for (int ai = 0; ai < 2; ++ai)
#pragma unroll
            for (int m = 0; m < 4; ++m)
#pragma unroll
                for (int bj = 0; bj < 2; ++bj)
#pragma unroll
                    for (int n = 0; n < 2; ++n) acc[ai][bj][m][n] = acc[ai][bj][m][n] * rs8[ai][m];
        __builtin_amdgcn_sched_barrier(0);
#pragma unroll
        for (int ai = 0; ai < 2; ++ai) { const int sg = 2 * ai + wr;
            if (fr == 0) { *(LAS f32x4*)(ef + sg * 128 + cg0) = acc[ai][0][0][0]; *(LAS f32x4*)(ef + sg * 128 + cg0 + 4) = acc[ai][0][0][1]; }
            if (fr == 15) { *(LAS f32x4*)(el + sg * 128 + cg0) = acc[ai][0][3][0]; *(LAS f32x4*)(el + sg * 128 + cg0 + 4) = acc[ai][0][3][1]; } }
        asm volatile("s_waitcnt lgkmcnt(0)" ::: "memory"); __builtin_amdgcn_s_barrier(); asm volatile("" ::: "memory");
        const int cf0 = u.pn * 128 + cg0;
#ifdef FFU_EPI_REP
        int reps_ = FFU_EPI_REP; asm volatile("" : "+s"(reps_));
        for (int rep_ = 0; rep_ < reps_; ++rep_)
#endif
#pragma unroll
        for (int ai = 0; ai < 2; ++ai) { const int sg = 2 * ai + wr;
#pragma unroll
            for (int n = 0; n < 2; ++n) {
                const f32x4 w0 = *(const LAS f32x4*)(tapl + 8 * fq + 4 * n), w1 = *(const LAS f32x4*)(tapl + 32 + 8 * fq + 4 * n), w2 = *(const LAS f32x4*)(tapl + 64 + 8 * fq + 4 * n), bb = *(const LAS f32x4*)(tapl + 96 + 8 * fq + 4 * n);
                const f32x4 htop = sg > 0 ? *(LAS f32x4*)(el + (sg - 1) * 128 + cg0 + 4 * n) : (f32x4){0.f, 0.f, 0.f, 0.f};
                const f32x4 hbot = sg < 3 ? *(LAS f32x4*)(ef + (sg + 1) * 128 + cg0 + 4 * n) : (f32x4){0.f, 0.f, 0.f, 0.f};
                unsigned pk[4][2];
#pragma unroll
                for (int jp = 0; jp < 2; ++jp) {
                    float rr[2][4];
#pragma unroll
                    for (int j2 = 0; j2 < 2; ++j2) { const int j = 2 * jp + j2;
                        float v[4], upv[4], dnv[4];
#pragma unroll
                        for (int m = 0; m < 4; ++m) { v[m] = acc[ai][0][m][n][j];
                            upv[m] = __int_as_float(__builtin_amdgcn_update_dpp(0, __float_as_int(v[m]), 0x121, 0xf, 0xf, false));
                            dnv[m] = __int_as_float(__builtin_amdgcn_update_dpp(0, __float_as_int(v[m]), 0x12F, 0xf, 0xf, false)); }
#pragma unroll
                        for (int m = 0; m < 4; ++m) {
                            float pv = fr > 0 ? upv[m] : (m > 0 ? upv[m > 0 ? m - 1 : 0] : htop[j]);
                            float nv = fr < 15 ? dnv[m] : (m < 3 ? dnv[m < 3 ? m + 1 : 3] : hbot[j]);
                            pv = (flp[ai] & (1u << (8 * m))) ? 0.f : pv; nv = (flp[ai] & (2u << (8 * m))) ? 0.f : nv;
                            const float a = w0[j] * pv + w1[j] * v[m] + w2[j] * nv + bb[j];
                            rr[j2][m] = siluf_(a) * acc[ai][1][m][n][j]; } }
#pragma unroll
                    for (int m = 0; m < 4; ++m) pk[m][jp] = cvt_pk_bf16(rr[0][m], rr[1][m]);
                    __builtin_amdgcn_sched_barrier(0);
                }
#pragma unroll
                for (int m = 0; m < 4; ++m) if (flp[ai] & (4u << (8 * m))) { u32x2 w; w.x = pk[m][0]; w.y = pk[m][1];
                    st_stream((u32x2*)(act + (size_t)(254 * u.pm - 1 + 128 * ai + 64 * wr + 16 * m + fr) * DFF + cf0 + 4 * n), w); }
                __builtin_amdgcn_sched_barrier(0);
            }
        }
    }
};
#define LDS_WAIT() asm volatile("s_waitcnt lgkmcnt(0)" ::: "memory")
DI void cvt_item(const float* W, int ldw, int col0, bf16_t* WT, int ldt, int k0, int n0, LAS float* scr, int lane, const float* gain = nullptr) {
    { float w[32]; const float* wp = W + (size_t)(k0 + (lane >> 5)) * ldw + col0 + n0 + (lane & 31);
#pragma unroll
        for (int i = 0; i < 32; ++i) w[i] = wp[(size_t)(2 * i) * ldw];
        if (gain) {
#pragma unroll
            for (int i = 0; i < 32; ++i) w[i] *= gain[k0 + 2 * i + (lane >> 5)]; }
#pragma unroll
        for (int i = 0; i < 32; ++i) scr[(2 * i + (lane >> 5)) * 33 + (lane & 31)] = w[i]; }
    LDS_WAIT(); asm volatile("" ::: "memory");
    const int c = lane & 7;
#pragma unroll
    for (int j = 0; j < 4; ++j) { const int n = (lane >> 3) + 8 * j; const LAS float* s = scr + (8 * c) * 33 + n;
        u32x4 o; o.x = cvt_pk_bf16(s[0 * 33], s[1 * 33]); o.y = cvt_pk_bf16(s[2 * 33], s[3 * 33]); o.z = cvt_pk_bf16(s[4 * 33], s[5 * 33]); o.w = cvt_pk_bf16(s[6 * 33], s[7 * 33]);
        *(u32x4*)(WT + (size_t)(n0 + n) * ldt + k0 + 8 * c) = o; }
    LDS_WAIT(); asm volatile("" ::: "memory");
}
struct CvtCursor { int cur, base, step; };
DI void cvt_job(CvtCursor& cc, const float* W, int ldw, int col0, int ncols, int K, bf16_t* WT, int ldt, LAS float* scr, int lane, const float* gain = nullptr) {
    const int nb = ncols / 32, n = (K / 64) * nb;
    while (cc.cur < cc.base + n) { const int it = cc.cur - cc.base; cvt_item(W, ldw, col0, WT, ldt, 64 * (it / nb), 32 * (it % nb), scr, lane, gain); cc.cur += cc.step; }
    cc.base += n;
}
DI void cvt_ffn(Frame& F, CvtCursor& cc, int li, LAS float* scr) {
    bf16_t* wg = (bf16_t*)F.WFFN(); bf16_t* wu = wg + (size_t)DFF * D; bf16_t* wd = wu + (size_t)DFF * D;
    cvt_job(cc, F.I(25) + (size_t)li * D * DFF, DFF, 0, DFF, D, wg, D, scr, F.lane(), F.I(4) + (size_t)li * D);
    cvt_job(cc, F.I(26) + (size_t)li * D * DFF, DFF, 0, DFF, D, wu, D, scr, F.lane(), F.I(4) + (size_t)li * D);
    cvt_job(cc, F.I(29) + (size_t)li * DFF * D, D, 0, D, DFF, wd, DFF, scr, F.lane());
}
DI void cvt_rg(Frame& F, CvtCursor& cc, int j, int li, LAS float* scr) {
    bf16_t* win = (bf16_t*)F.WMIX(); bf16_t* gates = win + (size_t)4096 * D; bf16_t* wout = gates + (size_t)32 * 65536;
    cvt_job(cc, F.I(6) + (size_t)j * D * 4096, 4096, 0, 4096, D, win, D, scr, F.lane(), F.I(3) + (size_t)li * D);
    {
        const int n = 32 * 32;
        while (cc.cur < cc.base + n) { const int it = cc.cur - cc.base; const int bid = it >> 5, sub = it & 31; const int gate = bid >> 4, dir = (bid >> 3) & 1, blk = bid & 7;
            const float* src = F.I(gate ? 11 : 9) + (size_t)((j * 2 + dir) * 8 + blk) * 65536;
            cvt_item(src, 256, 0, gates + (size_t)((dir * 2 + gate) * 8 + blk) * 65536, 256, 64 * (sub >> 3), 32 * (sub & 7), scr, F.lane()); cc.cur += cc.step; }
        cc.base += n; }
    cvt_job(cc, F.I(14) + (size_t)j * D * D, D, 0, D, D, wout, D, scr, F.lane());
}
DI void cvt_na(Frame& F, CvtCursor& cc, LAS float* scr) {
    bf16_t* wqkv = (bf16_t*)F.WMIX(); bf16_t* wo = wqkv + (size_t)6144 * D;
    cvt_job(cc, F.I(15), 6144, 0, 6144, D, wqkv, D, scr, F.lane(), F.I(3) + (size_t)1 * D);
    cvt_job(cc, F.I(18), D, 0, D, D, wo, D, scr, F.lane());
}
DI void cvt_gdn(Frame& F, CvtCursor& cc, LAS float* scr) {
    bf16_t* w0 = (bf16_t*)F.WMIX(); bf16_t* w1 = w0 + (size_t)6400 * D; bf16_t* wout = w1 + (size_t)6144 * D;
    const float* W = F.I(19);
    for (int g = 0; g < 2; ++g) { bf16_t* w = g ? w1 : w0;
        cvt_job(cc, W, 12416, g * 1024, 1024, D, w, D, scr, F.lane(), F.I(3) + (size_t)2 * D);
        cvt_job(cc, W, 12416, 2048 + g * 1024, 1024, D, w + (size_t)1024 * D, D, scr, F.lane(), F.I(3) + (size_t)2 * D);
        cvt_job(cc, W, 12416, 4096 + g * 2048, 2048, D, w + (size_t)2048 * D, D, scr, F.lane(), F.I(3) + (size_t)2 * D);
        cvt_job(cc, W, 12416, 8192 + g * 2048, 2048, D, w + (size_t)4096 * D, D, scr, F.lane(), F.I(3) + (size_t)2 * D); }
    cvt_job(cc, W, 12416, 12288, 128, D, w0 + (size_t)6144 * D, D, scr, F.lane(), F.I(3) + (size_t)2 * D);
    cvt_job(cc, F.I(24), D, 0, D, 4096, wout, 4096, scr, F.lane());
}

DI float rs_tag(int R, float rs) { int b, t; row_bt(R, b, t); const unsigned f = (t == 0 ? 1u : 0u) | ((b < NSEQ && t == seq_len(b) - 1) ? 2u : 0u); return __uint_as_float((__float_as_uint(rs) & ~3u) | f); }
template <int MODE> DI void norm_phase(Frame& F, bf16_t* X, const float* gain, float* rsv, const bf16_t* xin2 = nullptr, const float* slab = nullptr) {
    const int gw = F.bid * 8 + F.wave, NGW = F.G * 8, lane = F.lane();
    if (MODE == 1) {
        for (int i = F.bid * 512 + F.tid(); i < (MP - MTOK + 1) * (D / 8); i += F.G * 512) { const int r = i / (D / 8), c = i % (D / 8); const int R = r == 0 ? -1 : MTOK + r - 1;
            *(u32x4*)(X + (long)R * D + c * 8) = (u32x4){0u, 0u, 0u, 0u}; }
        for (int i = F.bid * 512 + F.tid(); i < MP - MTOK; i += F.G * 512) rsv[MTOK + i] = 0.f;
    }
    for (int R = gw; R < MTOK; R += NGW) {
        int b, t; row_bt(R, b, t);
        bf16_t* xr = X + (size_t)R * D;
        if (MODE == 2 && t < NMETA) continue;
        f32x4 v[8]; float s = 0.f;
        if (MODE == 1) {
            const float* src; if (t < NMETA) src = F.I(2) + (size_t)t * D; else if (b < NPROMPT) src = F.I(0) + ((size_t)b * LP + (t - NMETA)) * D; else src = F.I(1) + ((size_t)(b - NPROMPT) * LS + (t - NMETA)) * D;
#pragma unroll
            for (int j = 0; j < 8; ++j) { const f32x4 x = *(const f32x4*)(src + 4 * (lane + 64 * j)); u32x2 w; w.x = cvt_pk_bf16(x[0], x[1]); w.y = cvt_pk_bf16(x[2], x[3]); *(u32x2*)(xr + 4 * (lane + 64 * j)) = w;
                v[j] = (f32x4){bf_lo(w.x), bf_hi(w.x), bf_lo(w.y), bf_hi(w.y)}; }
        } else {
#pragma unroll
            for (int j = 0; j < 8; ++j) { const u32x2 w = *(const u32x2*)((R >= RES_ROW0 && xin2 ? xin2 + (size_t)R * D : xr) + 4 * (lane + 64 * j)); v[j] = (f32x4){bf_lo(w.x), bf_hi(w.x), bf_lo(w.y), bf_hi(w.y)}; }
            if (R >= RES_ROW0 && slab) {
#pragma unroll
                for (int s = 0; s < RES_NSPLIT; ++s)
#pragma unroll
                    for (int j = 0; j < 8; ++j) v[j] += *(const f32x4*)(slab + ((size_t)s * 512 + (R - RES_ROW0)) * D + 4 * (lane + 64 * j));
#pragma unroll
                for (int j = 0; j < 8; ++j) { const unsigned w0 = cvt_pk_bf16(v[j][0], v[j][1]), w1 = cvt_pk_bf16(v[j][2], v[j][3]); v[j] = (f32x4){bf_lo(w0), bf_hi(w0), bf_lo(w1), bf_hi(w1)}; } }
        }
#pragma unroll
        for (int j = 0; j < 8; ++j) s += (v[j][0] * v[j][0] + v[j][1] * v[j][1]) + (v[j][2] * v[j][2] + v[j][3] * v[j][3]);
        const float rs = 1.0f / sqrtf(wave_sum(s) * (1.0f / D) + NORM_EPS);
        if (MODE == 1) { if (lane == 0) rsv[R] = rs_tag(R, rs); }
        else {
            float* orow = F.out + (b < NPROMPT ? ((size_t)b * LP + (t - NMETA)) : ((size_t)NPROMPT * LP + (size_t)(b - NPROMPT) * LS + (t - NMETA))) * D;
#pragma unroll
            for (int j = 0; j < 8; ++j) { const f32x4 gv = *(const f32x4*)(gain + 4 * (lane + 64 * j)); *(f32x4*)(orow + 4 * (lane + 64 * j)) = v[j] * rs * gv; }
        }
    }
}
DI void ss_final_phase(Frame& F, const float* ssp, float* rsv, const bf16_t* xin, bf16_t* xout, const float* slab0, const float* slab1) {
    for (int R = F.bid * 512 + F.tid(); R < RES_ROW0; R += F.G * 512) { const float* p = ssp + (size_t)(R >> 8) * 32 * 256 + (R & 255); float s = 0.f;
#pragma unroll
        for (int i = 0; i < 8; ++i) s += (p[(4 * i) * 256] + p[(4 * i + 1) * 256]) + (p[(4 * i + 2) * 256] + p[(4 * i + 3) * 256]);
        rsv[R] = rs_tag(R, 1.0f / sqrtf(s * (1.0f / D) + NORM_EPS)); }
    const int lane = F.lane();
    for (int R = RES_ROW0 + F.bid * 8 + F.wave; R < MP; R += F.G * 8) {
        float v[32];
#pragma unroll
        for (int i = 0; i < 4; ++i) { const u32x4 x = *(const u32x4*)(xin + (size_t)R * D + lane * 32 + 8 * i); const unsigned w[4] = {x.x, x.y, x.z, x.w};
#pragma unroll
            for (int k = 0; k < 4; ++k) { v[8 * i + 2 * k] = bf_lo(w[k]); v[8 * i + 2 * k + 1] = bf_hi(w[k]); } }
#pragma unroll
        for (int set = 0; set < 2; ++set) { const float* sl = set ? slab1 : slab0; if (!sl) continue;
#pragma unroll
            for (int s = 0; s < RES_NSPLIT; ++s) { const float* p = sl + ((size_t)s * 512 + (R - RES_ROW0)) * D + lane * 32;
#pragma unroll
                for (int i = 0; i < 8; ++i) { const f32x4 a = *(const f32x4*)(p + 4 * i); v[4 * i] += a[0]; v[4 * i + 1] += a[1]; v[4 * i + 2] += a[2]; v[4 * i + 3] += a[3]; } } }
        float sq = 0.f;
#pragma unroll
        for (int i = 0; i < 4; ++i) { u32x4 w; unsigned ww[4];
#pragma unroll
            for (int k = 0; k < 4; ++k) { ww[k] = cvt_pk_bf16(v[8 * i + 2 * k], v[8 * i + 2 * k + 1]); const float a = bf_lo(ww[k]), b = bf_hi(ww[k]); sq += a * a + b * b; }
            w.x = ww[0]; w.y = ww[1]; w.z = ww[2]; w.w = ww[3]; *(u32x4*)(xout + (size_t)R * D + lane * 32 + 8 * i) = w; }
        const float tot = wave_sum(sq);
        if (lane == 0) rsv[R] = rs_tag(R, 1.0f / sqrtf(tot * (1.0f / D) + NORM_EPS));
    }
}
DI void fill_rflag(Frame& F, unsigned char* rf) { for (int R = F.bid * 512 + F.tid(); R < MP; R += F.G * 512) { int b, t; row_bt(R, b, t); rf[R] = (unsigned char)((t == 0 ? 1 : 0) | ((b < NSEQ && t == seq_len(b) - 1) ? 2 : 0)); } }

DI void rg_conv_phase(Frame& F, const bf16_t* yrec, bf16_t* xc, const float* cw, const float* cb) {
    const int tid = F.tid(), cg = tid & 255, c0 = cg * 8;
    float w[4][8], bb[8];
#pragma unroll
    for (int j = 0; j < 4; ++j)
#pragma unroll
        for (int e = 0; e < 8; ++e) w[j][e] = cw[j * D + c0 + e];
#pragma unroll
    for (int e = 0; e < 8; ++e) bb[e] = cb[c0 + e];
    for (int s = F.bid * 2 + (tid >> 8); s < MTOK / 16; s += F.G * 2) {
        const int R0 = 16 * s; int b, t0; row_bt(R0, b, t0); const int T = seq_len(b);
        const bf16_t* yp = yrec + (size_t)R0 * D + c0;
        u32x4 x0 = (u32x4){0u, 0u, 0u, 0u}, x1, x2, x3;
        if (t0 > 0) x0 = *(const u32x4*)(yp - D);
        x1 = *(const u32x4*)(yp); x2 = *(const u32x4*)(yp + D); x3 = *(const u32x4*)(yp + 2 * D);
#pragma unroll
        for (int i = 0; i < 16; ++i) {
            u32x4 xn = (u32x4){0u, 0u, 0u, 0u};
            if (i < 15 && t0 + i + 3 < T) xn = *(const u32x4*)(yp + (size_t)(i + 3) * D);
            float a[8];
#pragma unroll
            for (int e = 0; e < 8; ++e) a[e] = bb[e];
            const u32x4 xs[4] = {x0, x1, x2, x3};
#pragma unroll
            for (int j = 0; j < 4; ++j) { const u32x4 x = xs[j];
                a[0] += w[j][0] * bf_lo(x.x); a[1] += w[j][1] * bf_hi(x.x); a[2] += w[j][2] * bf_lo(x.y); a[3] += w[j][3] * bf_hi(x.y);
                a[4] += w[j][4] * bf_lo(x.z); a[5] += w[j][5] * bf_hi(x.z); a[6] += w[j][6] * bf_lo(x.w); a[7] += w[j][7] * bf_hi(x.w); }
            u32x4 o; o.x = cvt_pk_bf16(a[0], a[1]); o.y = cvt_pk_bf16(a[2], a[3]); o.z = cvt_pk_bf16(a[4], a[5]); o.w = cvt_pk_bf16(a[6], a[7]);
            *(u32x4*)(xc + (size_t)(R0 + i) * D + c0) = o;
            x0 = x1; x1 = x2; x2 = x3; x3 = xn;
        }
    }
}

template <int N, bool REV> DI void rg_ld(const bf16_t* p, size_t base, int t0, unsigned (&w)[8]) {
#pragma unroll
    for (int i = 0; i < 8; ++i) if (i < N) w[i] = *(const unsigned*)(p + base + (size_t)(REV ? t0 - i : t0 + i) * D);
}
DI void rg_scan_phase(Frame& F, const bf16_t* laf, const bf16_t* uf, const bf16_t* lab, bf16_t* ub, const bf16_t* ygate) {
    int tid_ = F.wave * 64 + lane_id(); asm volatile("" : "+v"(tid_));
    const int tid = tid_, lane = tid & 63, wave = __builtin_amdgcn_readfirstlane(tid >> 6), seg = 2 * wave + (lane >> 5), l32 = lane & 31;
    LAS float* AGG = (LAS float*)F.lds;
    LAS float* CB = AGG + 2 * 16 * 256;
    int items[3]; int ni = 0;
    if (F.G == 256) { if (F.bid < 128) { items[0] = F.bid; items[1] = 128 + F.bid; items[2] = 0; ni = 2; } else { const int b0 = 256 + 3 * (F.bid - 128); items[0] = b0; items[1] = b0 + 1; items[2] = b0 + 2; ni = 3; } }
    for (int ii = 0; ; ++ii) {
        int id;
        if (F.G == 256) { if (ii >= ni) break; id = ii == 0 ? items[0] : (ii == 1 ? items[1] : items[2]); } else { id = F.bid + ii * F.G; if (id >= 640) break; }
        const int b = id < 128 ? NPROMPT + (id >> 5) : ((id - 128) >> 5), cg = id & 31;
        const int T = seq_len(b), SL = T >> 4, NC = T >> 7, nb = NC >> 4;
        const size_t base = (size_t)seq_off(b) * D + cg * 64 + l32 * 2;
        {
            const int s1 = seg * SL + SL - 1;
            float slb0 = 0.f, slb1 = 0.f, hb0 = 0.f, hb1 = 0.f, r1s0 = 0.f, r1s1 = 0.f, r1h0 = 0.f, r1h1 = 0.f, r2s0 = 0.f, r2s1 = 0.f, r2h0 = 0.f, r2h1 = 0.f;
            const int w1 = seg, w2 = 128 + seg;
            unsigned lb[8], ub_[8], lr[8], ur[8];
            rg_ld<1, true>(lab, base, s1 - (SL - 1), lr); rg_ld<1, true>(ub, base, s1 - (SL - 1), ur);
            rg_ld<8, true>(lab, base, s1, lb); rg_ld<8, true>(ub, base, s1, ub_);
            for (int i0 = 0; i0 + 8 <= SL; i0 += 8) {
                unsigned lbn[8], ubn[8];
#pragma unroll
                for (int i = 0; i < 8; ++i) { lbn[i] = 0u; ubn[i] = 0u; }
                if (i0 + 16 <= SL) { rg_ld<8, true>(lab, base, s1 - i0 - 8, lbn); rg_ld<8, true>(ub, base, s1 - i0 - 8, ubn); }
#pragma unroll
                for (int i = 0; i < 8; ++i) { const float c0 = bf_lo(lb[i]), c1 = bf_hi(lb[i]); slb0 += c0; slb1 += c1; hb0 = __expf(c0) * hb0 + bf_lo(ub_[i]); hb1 = __expf(c1) * hb1 + bf_hi(ub_[i]);
                    const bool q1 = (i0 + i == w1), q2 = (i0 + i == w2);
                    r1s0 = q1 ? slb0 : r1s0; r1s1 = q1 ? slb1 : r1s1; r1h0 = q1 ? hb0 : r1h0; r1h1 = q1 ? hb1 : r1h1;
                    r2s0 = q2 ? slb0 : r2s0; r2s1 = q2 ? slb1 : r2s1; r2h0 = q2 ? hb0 : r2h0; r2h1 = q2 ? hb1 : r2h1; }
#pragma unroll
                for (int i = 0; i < 8; ++i) { lb[i] = lbn[i]; ub_[i] = ubn[i]; }
            }
            { const float c0 = bf_lo(lr[0]), c1 = bf_hi(lr[0]); slb0 += c0; slb1 += c1; hb0 = __expf(c0) * hb0 + bf_lo(ur[0]); hb1 = __expf(c1) * hb1 + bf_hi(ur[0]);
                const bool q1 = (SL - 1 == w1), q2 = (SL - 1 == w2);
                r1s0 = q1 ? slb0 : r1s0; r1s1 = q1 ? slb1 : r1s1; r1h0 = q1 ? hb0 : r1h0; r1h1 = q1 ? hb1 : r1h1;
                r2s0 = q2 ? slb0 : r2s0; r2s1 = q2 ? slb1 : r2s1; r2h0 = q2 ? hb0 : r2h0; r2h1 = q2 ? hb1 : r2h1; }
            __syncthreads();
            { LAS float* a = AGG + seg * 256 + 2 * l32; *(LAS f32x2*)(a) = (f32x2){slb0, slb1}; *(LAS f32x2*)(a + 64) = (f32x2){hb0, hb1}; }
            __syncthreads();
            float cb0 = 0.f, cb1 = 0.f;
            for (int v = 15; v > seg; --v) { const LAS float* a = AGG + v * 256 + 2 * l32; const f32x2 sl = *(const LAS f32x2*)(a), hh = *(const LAS f32x2*)(a + 64); cb0 = hh[0] + __expf(sl[0]) * cb0; cb1 = hh[1] + __expf(sl[1]) * cb1; }
            *(LAS f32x2*)(CB + (nb * seg + nb) * 64 + 2 * l32) = (f32x2){r1h0 + __expf(r1s0) * cb0, r1h1 + __expf(r1s1) * cb1};
            if (nb == 2) *(LAS f32x2*)(CB + (nb * seg + nb - 1) * 64 + 2 * l32) = (f32x2){r2h0 + __expf(r2s0) * cb0, r2h1 + __expf(r2s1) * cb1};
            __syncthreads();
        }
        float CF0 = 0.f, CF1 = 0.f;
        unsigned A_lf[8], A_uf[8], A_lb[8], A_ub[8], A_g[8];
        { const int t0 = 8 * seg; rg_ld<8, false>(laf, base, t0, A_lf); rg_ld<8, false>(uf, base, t0, A_uf); rg_ld<8, false>(lab, base, t0, A_lb); rg_ld<8, false>(ub, base, t0, A_ub); rg_ld<8, false>(ygate, base, t0, A_g); }
        for (int c = 0; c <= NC; ++c) {
            const bool tail = (c == NC);
            const int tb = 128 * c + (tail ? seg : 8 * seg);
            unsigned B_lf[8], B_uf[8], B_lb[8], B_ub[8], B_g[8];
#pragma unroll
            for (int i = 0; i < 8; ++i) { B_lf[i] = 0u; B_uf[i] = 0u; B_lb[i] = 0u; B_ub[i] = 0u; B_g[i] = 0u; }
            if (c + 1 < NC) { const int t0 = 128 * (c + 1) + 8 * seg; rg_ld<8, false>(laf, base, t0, B_lf); rg_ld<8, false>(uf, base, t0, B_uf); rg_ld<8, false>(lab, base, t0, B_lb); rg_ld<8, false>(ub, base, t0, B_ub); rg_ld<8, false>(ygate, base, t0, B_g); }
            else if (c + 1 == NC) { const int t0 = 128 * NC + seg; rg_ld<1, false>(laf, base, t0, B_lf); rg_ld<1, false>(uf, base, t0, B_uf); rg_ld<1, false>(lab, base, t0, B_lb); rg_ld<1, false>(ub, base, t0, B_ub); rg_ld<1, false>(ygate, base, t0, B_g); }
            float af0[8], af1[8], ab0[8], ab1[8];
            float slf0 = 0.f, slf1 = 0.f, hf0 = 0.f, hf1 = 0.f, slb0 = 0.f, slb1 = 0.f, hb0 = 0.f, hb1 = 0.f;
#pragma unroll
            for (int i = 0; i < 8; ++i) { const float a0 = bf_lo(A_lf[i]), a1 = bf_hi(A_lf[i]); slf0 += a0; slf1 += a1; af0[i] = __expf(a0); af1[i] = __expf(a1); hf0 = af0[i] * hf0 + bf_lo(A_uf[i]); hf1 = af1[i] * hf1 + bf_hi(A_uf[i]); }
#pragma unroll
            for (int i = 7; i >= 0; --i) { const float c0 = bf_lo(A_lb[i]), c1 = bf_hi(A_lb[i]); slb0 += c0; slb1 += c1; ab0[i] = __expf(c0); ab1[i] = __expf(c1); hb0 = ab0[i] * hb0 + bf_lo(A_ub[i]); hb1 = ab1[i] * hb1 + bf_hi(A_ub[i]); }
            LAS float* ag = AGG + (c & 1) * 4096;
            { LAS float* a = ag + seg * 256 + 2 * l32; *(LAS f32x2*)(a) = (f32x2){slf0, slf1}; *(LAS f32x2*)(a + 64) = (f32x2){hf0, hf1}; *(LAS f32x2*)(a + 128) = (f32x2){slb0, slb1}; *(LAS f32x2*)(a + 192) = (f32x2){hb0, hb1}; }
            __syncthreads();
            float cf0 = CF0, cf1 = CF1;
            for (int v = 0; v < seg; ++v) { const LAS float* a = ag + v * 256 + 2 * l32; const f32x2 sl = *(const LAS f32x2*)(a), hh = *(const LAS f32x2*)(a + 64); cf0 = hh[0] + __expf(sl[0]) * cf0; cf1 = hh[1] + __expf(sl[1]) * cf1; }
            { float e0 = cf0, e1 = cf1;
                for (int v = seg; v < 16; ++v) { const LAS float* a = ag + v * 256 + 2 * l32; const f32x2 sl = *(const LAS f32x2*)(a), hh = *(const LAS f32x2*)(a + 64); e0 = hh[0] + __expf(sl[0]) * e0; e1 = hh[1] + __expf(sl[1]) * e1; }
                CF0 = e0; CF1 = e1; }
            float cb0 = 0.f, cb1 = 0.f;
            if (!tail) { const f32x2 r = *(const LAS f32x2*)(CB + (c + 1) * 64 + 2 * l32); cb0 = r[0]; cb1 = r[1]; }
            for (int v = 15; v > seg; --v) { const LAS float* a = ag + v * 256 + 2 * l32; const f32x2 sl = *(const LAS f32x2*)(a + 128), hh = *(const LAS f32x2*)(a + 192); cb0 = hh[0] + __expf(sl[0]) * cb0; cb1 = hh[1] + __expf(sl[1]) * cb1; }
            float f0[8], f1[8];
#pragma unroll
            for (int i = 0; i < 8; ++i) { cf0 = af0[i] * cf0 + bf_lo(A_uf[i]); cf1 = af1[i] * cf1 + bf_hi(A_uf[i]); f0[i] = cf0; f1[i] = cf1; }
#pragma unroll
            for (int i = 7; i >= 0; --i) { cb0 = ab0[i] * cb0 + bf_lo(A_ub[i]); cb1 = ab1[i] * cb1 + bf_hi(A_ub[i]);
                f0[i] = bf_lo(A_g[i]) * (f0[i] + cb0); f1[i] = bf_hi(A_g[i]) * (f1[i] + cb1); }
            if (!tail) {
#pragma unroll
                for (int i = 0; i < 8; ++i) *(unsigned*)(ub + base + (size_t)(tb + i) * D) = cvt_pk_bf16(f0[i], f1[i]);
            } else *(unsigned*)(ub + base + (size_t)tb * D) = cvt_pk_bf16(f0[0], f1[0]);
#pragma unroll
            for (int i = 0; i < 8; ++i) { A_lf[i] = B_lf[i]; A_uf[i] = B_uf[i]; A_lb[i] = B_lb[i]; A_ub[i] = B_ub[i]; A_g[i] = B_g[i]; }
        }
    }
}
constexpr int NA_VPITCH = 136;
constexpr int NA_WAVE_LDS = 32 * NA_VPITCH * 2 + 2048;
DI void na_attn_phase(Frame& F, const bf16_t* qkv, bf16_t* O, const float* rpb, const float* mbias) {
    int tid_ = F.wave * 64 + lane_id(); asm volatile("" : "+v"(tid_));
    const int lane = tid_ & 63, l15 = lane & 15, quad = lane >> 4;
    LAS unsigned char* wl = F.lds + F.wave * NA_WAVE_LDS;
    LAS bf16_t* vt = (LAS bf16_t*)wl;
    LAS float* rp = (LAS float*)(wl + 32 * NA_VPITCH * 2);
    int cached_h = -1;
    const float scale = 0.08838834764831845f;
    const int NITEMS = MTOK;
    for (int id = F.bid * 8 + F.wave; id < NITEMS; id += F.G * 8) {
        int b, h, it, rows;
        if (id < MPROMPT) { const int bh = id / 129; it = id - bh * 129; b = bh >> 4; h = bh & 15; rows = 32; }
        else { const int i2 = id - MPROMPT; const int bh = i2 / 257; it = i2 - bh * 257; b = NPROMPT + (bh >> 4); h = bh & 15; rows = 64; }
        const bool is_meta = (it == rows * 4);
        const int r = it >> 2, n = it & 3;
        const int so = seq_off(b);
        if (h != cached_h) {
            __builtin_amdgcn_wave_barrier();
            for (int i = lane; i < 465; i += 64) rp[i] = rpb[h * 465 + i];
            if (lane < 16) rp[480 + lane] = mbias[h * 16 + lane];
            cached_h = h; LDS_WAIT(); __builtin_amdgcn_wave_barrier(); asm volatile("" ::: "memory");
        }
        int rs = r - 4; rs = rs < 0 ? 0 : (rs > rows - 8 ? rows - 8 : rs);
        int ks = 16 * n - 8; ks = ks < 0 ? 0 : (ks > 32 ? 32 : ks);
        const int qrow = is_meta ? so + l15 : so + NMETA + 64 * r + 16 * n + l15;
        const int qcol = 16 * n + l15; int cs = qcol - 8; cs = cs < 0 ? 0 : (cs > 48 ? 48 : cs);
        bf16x8 qf[4];
#pragma unroll
        for (int s = 0; s < 4; ++s) qf[s] = *(const bf16x8*)(qkv + (size_t)qrow * 6144 + h * 128 + 32 * s + 8 * quad);
        f32x4 sv[17];
#pragma unroll
        for (int kb = 0; kb < 17; ++kb) sv[kb] = (f32x4){-1e30f, -1e30f, -1e30f, -1e30f};
        if (!is_meta) {
#pragma unroll
            for (int kb0 = 0; kb0 < 16; kb0 += 8) {
                bf16x8 kf[8][4];
#pragma unroll
                for (int i = 0; i < 8; ++i) { const int kb = kb0 + i, kr = kb >> 1; const int krow = so + NMETA + 64 * (rs + kr) + ks + 16 * (kb & 1) + l15;
#pragma unroll
                    for (int s = 0; s < 4; ++s) kf[i][s] = *(const bf16x8*)(qkv + (size_t)krow * 6144 + 2048 + h * 128 + 32 * s + 8 * quad); }
#pragma unroll
                for (int i = 0; i < 8; ++i) { const int kb = kb0 + i, kr = kb >> 1;
                    f32x4 st = (f32x4){0.f, 0.f, 0.f, 0.f};
#pragma unroll
                    for (int s = 0; s < 4; ++s) st = __builtin_amdgcn_mfma_f32_16x16x32_bf16(kf[i][s], qf[s], st, 0, 0, 0);
                    const int roff = (rs + kr) - r + 7;
#pragma unroll
                    for (int g = 0; g < 4; ++g) { const int keycol = ks + 16 * (kb & 1) + 4 * quad + g; const bool valid = (keycol >= cs) && (keycol < cs + 16);
                        int coff = keycol - qcol; coff = coff < -15 ? -15 : (coff > 15 ? 15 : coff);
                        sv[kb][g] = valid ? st[g] * scale + rp[roff * 31 + coff + 15] : -1e30f; }
                }
            }
        }
        {
            const int krow = so + l15;
            f32x4 st = (f32x4){0.f, 0.f, 0.f, 0.f};
#pragma unroll
            for (int s = 0; s < 4; ++s) { const bf16x8 kf = *(const bf16x8*)(qkv + (size_t)krow * 6144 + 2048 + h * 128 + 32 * s + 8 * quad);
                st = __builtin_amdgcn_mfma_f32_16x16x32_bf16(kf, qf[s], st, 0, 0, 0); }
#pragma unroll
            for (int g = 0; g < 4; ++g) sv[16][g] = st[g] * scale + rp[480 + 4 * quad + g];
        }
        float mx = -1e30f;
#pragma unroll
        for (int kb = 0; kb < 17; ++kb)
#pragma unroll
            for (int g = 0; g < 4; ++g) mx = fmaxf(mx, sv[kb][g]);
        mx = fmaxf(mx, __shfl_xor(mx, 16)); mx = fmaxf(mx, __shfl_xor(mx, 32));
        float sum = 0.f;
#pragma unroll
        for (int kb = 0; kb < 17; ++kb)
#pragma unroll
            for (int g = 0; g < 4; ++g) { const float p = __expf(sv[kb][g] - mx); sv[kb][g] = p; sum += p; }
        sum += __shfl_xor(sum, 16); sum += __shfl_xor(sum, 32);
        const float inv = 1.0f / sum;
        f32x4 ot[8];
#pragma unroll
        for (int d = 0; d < 8; ++d) ot[d] = (f32x4){0.f, 0.f, 0.f, 0.f};
        u32x4 vcur[8];
        {   const int kr0 = is_meta ? 8 : 0;
#pragma unroll
            for (int i = 0; i < 8; ++i) { const int cid = i * 64 + lane, vr = cid >> 4, c16 = cid & 15; vcur[i] = (u32x4){0u, 0u, 0u, 0u};
                if (kr0 < 8) vcur[i] = *(const u32x4*)(qkv + (size_t)(so + NMETA + 64 * rs + ks + vr) * 6144 + 4096 + h * 128 + 8 * c16);
                else if (vr < 16) vcur[i] = *(const u32x4*)(qkv + (size_t)(so + vr) * 6144 + 4096 + h * 128 + 8 * c16); } }
#pragma unroll
        for (int kr = 0; kr < 9; ++kr) {
            if (!(is_meta && kr < 8)) {
            __builtin_amdgcn_wave_barrier(); asm volatile("" ::: "memory");
#pragma unroll
            for (int i = 0; i < 8; ++i) { const int cid = i * 64 + lane, vr = cid >> 4, c16 = cid & 15; *(LAS u32x4*)(vt + vr * NA_VPITCH + 8 * c16) = vcur[i]; }
            LDS_WAIT(); __builtin_amdgcn_wave_barrier(); asm volatile("" ::: "memory");
            u32x4 vnext[8];
#pragma unroll
            for (int i = 0; i < 8; ++i) { const int cid = i * 64 + lane, vr = cid >> 4, c16 = cid & 15; vnext[i] = (u32x4){0u, 0u, 0u, 0u};
                if (kr + 1 < 8) vnext[i] = *(const u32x4*)(qkv + (size_t)(so + NMETA + 64 * (rs + kr + 1) + ks + vr) * 6144 + 4096 + h * 128 + 8 * c16);
                else if (kr + 1 == 8 && vr < 16) vnext[i] = *(const u32x4*)(qkv + (size_t)(so + vr) * 6144 + 4096 + h * 128 + 8 * c16); }
            f32x4 p0, p1;
            if (kr < 8) { p0 = sv[2 * kr]; p1 = sv[2 * kr + 1]; } else { p0 = sv[16]; p1 = (f32x4){0.f, 0.f, 0.f, 0.f}; }
            u32x4 pw; pw.x = cvt_pk_bf16(p0[0] * inv, p0[1] * inv); pw.y = cvt_pk_bf16(p0[2] * inv, p0[3] * inv); pw.z = cvt_pk_bf16(p1[0] * inv, p1[1] * inv); pw.w = cvt_pk_bf16(p1[2] * inv, p1[3] * inv);
            const bf16x8 pf = __builtin_bit_cast(bf16x8, pw);
#pragma unroll
            for (int d = 0; d < 8; ++d) {
                bf16x8 vf;
#pragma unroll
                for (int j = 0; j < 8; ++j) vf[j] = (short)vt[(16 * (j >> 2) + 4 * quad + (j & 3)) * NA_VPITCH + 16 * d + l15];
                ot[d] = __builtin_amdgcn_mfma_f32_16x16x32_bf16(vf, pf, ot[d], 0, 0, 0);
            }
#pragma unroll
            for (int i = 0; i < 8; ++i) vcur[i] = vnext[i];
            }
        }
#pragma unroll
        for (int d = 0; d < 8; ++d) { u32x2 w; w.x = cvt_pk_bf16(ot[d][0], ot[d][1]); w.y = cvt_pk_bf16(ot[d][2], ot[d][3]);
            *(u32x2*)(O + (size_t)qrow * D + h * 128 + 16 * d + 4 * quad) = w; }
    }
}
constexpr int GD_QS = 0, GD_KS = 17408, GD_VS = 34816, GD_ABF = 52224, GD_ADG = 61440, GD_TIB = 66560, GD_KST = 68608, GD_QKM = 87040, GD_WB = 96256, GD_VEC = 113664, GD_CW = 114944, GD_END = 121088;
constexpr int GD_O = 114944;
constexpr int P_QS = 136, P_KST = 72, P_ADG = 20, P_O = 132;
typedef short bf16x4 __attribute__((ext_vector_type(4)));

DI void gdn_conv_phase(Frame& F, int half, bf16_t* qkvp, const bf16_t* halo, const float* conv_w) {
    int tid_ = F.wave * 64 + lane_id(); asm volatile("" : "+v"(tid_));
    const int tid = tid_, piece = tid & 63, tg = tid >> 6;
    constexpr int NIT = (MTOK / 64) * 8;
    for (int item = F.bid; item < NIT; item += F.G) {
        const bool ivld = true;
        const int rb = item >> 3, cs = item & 7, col = cs * 512 + piece * 8;
        const int X = col < 1024 ? 0 : (col < 2048 ? 1 : 2);
        const int wcol = X == 0 ? half * 1024 + col : (X == 1 ? 2048 + half * 1024 + (col - 1024) : 4096 + half * 2048 + (col - 2048));
        const int r0 = 64 * rb + 8 * tg; int b, t0; row_bt(r0, b, t0); const int T = seq_len(b);
        u32x4 xr[11];
#pragma unroll
        for (int r = 0; r < 11; ++r) { const int tt = t0 - 1 + r, w = r0 - 1 + r; xr[r] = (u32x4){0u, 0u, 0u, 0u};
            if (ivld && tt >= 0 && tt < T) { const bf16_t* p;
                if (w < 64 * rb) p = halo + ((size_t)rb * 3 + 0) * 4096 + col; else if (w >= 64 * rb + 64) p = halo + ((size_t)rb * 3 + 1 + (w - 64 * rb - 64)) * 4096 + col; else p = qkvp + (size_t)w * 4096 + col;
                xr[r] = *(const u32x4*)p; } }
        f32x4 wlo[4], whi[4];
#pragma unroll
        for (int j = 0; j < 4; ++j) { wlo[j] = *(const f32x4*)(conv_w + j * 8192 + wcol); whi[j] = *(const f32x4*)(conv_w + j * 8192 + wcol + 4); }
        u32x4 res[8];
#pragma unroll
        for (int ro = 0; ro < 8; ++ro) {
            float a[8];
#pragma unroll
            for (int e = 0; e < 8; ++e) a[e] = 0.f;
#pragma unroll
            for (int j = 0; j < 4; ++j) { const u32x4 x = xr[ro + j];
                a[0] += wlo[j][0] * bf_lo(x.x); a[1] += wlo[j][1] * bf_hi(x.x); a[2] += wlo[j][2] * bf_lo(x.y); a[3] += wlo[j][3] * bf_hi(x.y);
                a[4] += whi[j][0] * bf_lo(x.z); a[5] += whi[j][1] * bf_hi(x.z); a[6] += whi[j][2] * bf_lo(x.w); a[7] += whi[j][3] * bf_hi(x.w); }
            float ss = 0.f;
#pragma unroll
            for (int e = 0; e < 8; ++e) { a[e] = siluf_(a[e]); ss += a[e] * a[e]; }
            ss += __shfl_xor(ss, 1); ss += __shfl_xor(ss, 2); ss += __shfl_xor(ss, 4); ss += __shfl_xor(ss, 8);
            const float sc = X == 2 ? 1.0f : (1.0f / sqrtf(ss + 1e-6f)) * (X == 0 ? 0.08838834764831845f : 1.0f);
            res[ro] = (u32x4){cvt_pk_bf16(a[0] * sc, a[1] * sc), cvt_pk_bf16(a[2] * sc, a[3] * sc), cvt_pk_bf16(a[4] * sc, a[5] * sc), cvt_pk_bf16(a[6] * sc, a[7] * sc)};
        }
        __syncthreads();
        if (ivld) {
#pragma unroll
            for (int ro = 0; ro < 8; ++ro) *(u32x4*)(qkvp + (size_t)(r0 + ro) * 4096 + col) = res[ro]; }
    }
}
DI bf16x8 frag_perm(const LAS bf16_t* rowp, int kbase, int quad) {
    const s16x4 a = *(const LAS s16x4*)(rowp + kbase + 4 * quad), b = *(const LAS s16x4*)(rowp + kbase + 16 + 4 * quad);
    bf16x8 r; r[0] = a[0]; r[1] = a[1]; r[2] = a[2]; r[3] = a[3]; r[4] = b[0]; r[5] = b[1]; r[6] = b[2]; r[7] = b[3]; return r;
}
DI bf16x8 pack_acc(const f32x4 a, const f32x4 b) { const u32x4 w = pack8(a, b); return __builtin_bit_cast(bf16x8, w); }
DI bf16x4 pack4(const f32x4 a) { u32x2 w; w.x = cvt_pk_bf16(a[0], a[1]); w.y = cvt_pk_bf16(a[2], a[3]); return __builtin_bit_cast(bf16x4, w); }
#define MFMA16(a, b, c) __builtin_amdgcn_mfma_f32_16x16x16bf16_1k((a), (b), (c), 0, 0, 0)


DI void gd_tok_ab(int n, int dir, int& A, int& sg) { sg = dir ? -1 : 1; A = n == 0 ? (dir ? 15 : -48) : NMETA + 64 * (n - 1) + (dir ? 63 : 0); }
DI int gd_tok(int n, int dir, int slot) { int A, sg; gd_tok_ab(n, dir, A, sg); return A + sg * slot; }
DI void gd_fetch(const bf16_t* qkvp, const float* bg, int so, int hl, int ql, int hv, int n, int dir, int tid, int wave, u32x4 (&pf)[6], float& gv, float& bv) {
    int A, sg; gd_tok_ab(n, dir, A, sg);
    const int pc = tid & 15, cq = ql * 128 + 8 * pc, ck = 1024 + cq, cv = 2048 + hl * 128 + 8 * pc;
#pragma unroll
    for (int h2 = 0; h2 < 2; ++h2) { const int t = A + sg * ((tid >> 4) + 32 * h2);
        pf[h2] = pf[2 + h2] = pf[4 + h2] = (u32x4){0u, 0u, 0u, 0u};
        if (t >= 0) { const bf16_t* rp = qkvp + (size_t)(so + t) * 4096; pf[h2] = *(const u32x4*)(rp + cq); pf[2 + h2] = *(const u32x4*)(rp + ck); pf[4 + h2] = *(const u32x4*)(rp + cv); } }
    gv = 0.f; bv = 0.f;
    if (wave == 0) { const int t1 = A + sg * (tid & 63); if (t1 >= 0) { const float* p = bg + (size_t)(so + t1) * 128 + dir * 32 + hv; bv = p[0]; gv = p[64]; } }
}
#define GD_BAR() asm volatile("s_waitcnt lgkmcnt(0)\n\ts_barrier" ::: "memory")
#define GD_IDS() int tq_ = tid0; asm volatile("" : "+v"(tq_)); const int tid = tq_, lane = tid & 63, l15 = lane & 15, quad = lane >> 4, tau = tid >> 3, sub = tid & 7; (void)l15; (void)quad; (void)tau; (void)sub; (void)lane;
constexpr int GD_OB_SPLIT = 48640;
DI bf16_t* gd_ob_row(bf16_t* obA, bf16_t* obB, int R) { return R < GD_OB_SPLIT ? obA + (size_t)R * D : obB + (size_t)(R - GD_OB_SPLIT) * D; }
DI void gdn_core_phase(Frame& F, int half, const bf16_t* qkvp, const float* bg, bf16_t* og, bf16_t* obA, bf16_t* obB) {
    int tid_ = F.wave * 64 + lane_id(); asm volatile("" : "+v"(tid_));
    const int tid0 = tid_, wave = __builtin_amdgcn_readfirstlane(tid0 >> 6);
    LAS unsigned char* L = F.lds;
    LAS bf16_t* QS = (LAS bf16_t*)(L + GD_QS); LAS bf16_t* KS = (LAS bf16_t*)(L + GD_KS); LAS bf16_t* VS = (LAS bf16_t*)(L + GD_VS);
    LAS bf16_t* ABF = (LAS bf16_t*)(L + GD_ABF); LAS float* ADG = (LAS float*)(L + GD_ADG); LAS bf16_t* TIB = (LAS bf16_t*)(L + GD_TIB);
    LAS bf16_t* KST = (LAS bf16_t*)(L + GD_KST); LAS bf16_t* QKM = (LAS bf16_t*)(L + GD_QKM);
    LAS bf16_t* WB = (LAS bf16_t*)(L + GD_WB); LAS float* OL = (LAS float*)(L + GD_O);
    LAS float* GC = (LAS float*)(L + GD_VEC); LAS float* BETA = GC + 64; LAS float* EG = GC + 128; LAS float* EKL = GC + 192; LAS float* GL = GC + 256;
    for (int ii = 0; ; ++ii) {
        int id;
        if (F.G == 256) { if (F.bid < 128) { if (ii >= 2) break; id = ii == 0 ? F.bid : 128 + F.bid; } else { if (ii >= 3) break; id = 256 + 3 * (F.bid - 128) + ii; } }
        else { id = F.bid + ii * F.G; if (id >= NSEQ * 32) break; }
        const int s_ = id < 128 ? id : id - 128;
        const int b = id < 128 ? NPROMPT + (s_ >> 5) : (s_ >> 5), hl = (s_ >> 1) & 15, dir = s_ & 1, hv = half * 16 + hl, ql = hl >> 1;
        const int so = seq_off(b), T = seq_len(b), NC = 1 + (T - NMETA) / 64;
        __syncthreads();
        {
            f32x4 Sacc[8];
#pragma unroll
            for (int i = 0; i < 8; ++i) Sacc[i] = (f32x4){0.f, 0.f, 0.f, 0.f};
            u32x4 pf[6]; float pgv, pbv;
            gd_fetch(qkvp, bg, so, hl, ql, hv, dir ? NC - 1 : 0, dir, tid0, wave, pf, pgv, pbv);
#define GD_S5() do { if (tprev >= 0) { GD_IDS(); f32x4 o[4]; _Pragma("unroll") for (int i = 0; i < 4; ++i) o[i] = *(const LAS f32x4*)(OL + tau * P_O + 16 * sub + 4 * i); \
                *(u32x4*)(gpprev) = pack8(o[0], o[1]); *(u32x4*)(gpprev + 8) = pack8(o[2], o[3]); } } while (0)
            int tprev = -1; bf16_t* gpprev = og;
            for (int step = 0; step < NC; ++step) {
                const int n = dir ? NC - 1 - step : step;
                int t, R; float gv = 0.f, bv = 0.f; bf16_t* gp;
                GD_S5();
                { GD_IDS();
                t = gd_tok(n, dir, tau);
                R = so + (t < 0 ? 0 : t);
#pragma unroll
                for (int i = 0; i < 6; ++i) { const int X = i >> 1, slot = (tid >> 4) + 32 * (i & 1), pc = tid & 15;
                    LAS bf16_t* dst = (X == 0 ? QS : (X == 1 ? KS : VS)) + slot * P_QS + 8 * pc;
                    *(LAS u32x4*)(dst) = pf[i];
                    if (X == 1) { const unsigned w4[4] = {pf[i].x, pf[i].y, pf[i].z, pf[i].w};
#pragma unroll
                        for (int e = 0; e < 8; ++e) KST[(8 * pc + e) * P_KST + slot] = (bf16_t)((e & 1) ? (w4[e >> 1] >> 16) : (w4[e >> 1] & 0xffffu)); } }
                gv = pgv; bv = pbv;
                if (step + 1 < NC) gd_fetch(qkvp, bg, so, hl, ql, hv, dir ? NC - 2 - step : step + 1, dir, tid, wave, pf, pgv, pbv);
                gp = (dir ? gd_ob_row(obA, obB, R) : og + (size_t)R * D) + hl * 128 + 16 * sub;
                }
                if (wave == 0) { GD_IDS();
                    float c = gv;
#pragma unroll
                    for (int o = 1; o < 64; o <<= 1) { const float y = __shfl_up(c, o); if (lane >= o) c += y; }
                    const float gl = __shfl(c, 63);
                    GC[lane] = c; BETA[lane] = bv; EG[lane] = __expf(c); EKL[lane] = __expf(gl - c); if (lane == 0) GL[0] = __expf(gl);
                }
                GD_BAR();
                { GD_IDS();
                    const int cb = wave >> 1;
                    bf16x8 ka[4], qa[4];
#pragma unroll
                    for (int ks = 0; ks < 4; ++ks) { ka[ks] = *(const LAS bf16x8*)(KS + (16 * cb + l15) * P_QS + 32 * ks + 8 * quad); qa[ks] = *(const LAS bf16x8*)(QS + (16 * cb + l15) * P_QS + 32 * ks + 8 * quad); }
                    const f32x4 gcc = *(const LAS f32x4*)(GC + 16 * cb + 4 * quad), btc = *(const LAS f32x4*)(BETA + 16 * cb + 4 * quad);
#pragma unroll
                    for (int s2 = 0; s2 < 2; ++s2) { const int sb = 2 * (wave & 1) + s2;
                        f32x4 kk = (f32x4){0.f, 0.f, 0.f, 0.f}, qk = kk;
#pragma unroll
                        for (int ks = 0; ks < 4; ++ks) { const bf16x8 kb = *(const LAS bf16x8*)(KS + (16 * sb + l15) * P_QS + 32 * ks + 8 * quad);
                            kk = __builtin_amdgcn_mfma_f32_16x16x32_bf16(ka[ks], kb, kk, 0, 0, 0); qk = __builtin_amdgcn_mfma_f32_16x16x32_bf16(qa[ks], kb, qk, 0, 0, 0); }
                        const int s = 16 * sb + l15; const float gcs = GC[s];
#pragma unroll
                        for (int g = 0; g < 4; ++g) { const int c = 16 * cb + 4 * quad + g;
                            const float dec = (s <= c) ? __expf(fminf(gcc[g] - gcs, 0.f)) : 0.f;
                            const float av = (s < c) ? btc[g] * kk[g] * dec : 0.f;
                            QKM[c * P_KST + s] = f2bf(qk[g] * dec);
                            ABF[c * P_KST + s] = f2bf(av);
                            if (sb == cb) ADG[(cb * 16 + 4 * quad + g) * P_ADG + l15] = av; }
                    }
                }
                GD_BAR();
                if (wave == 0) { GD_IDS();
                    float tcol[16];
#pragma unroll
                    for (int r = 0; r < 16; ++r) { float acc = (r == l15) ? 1.f : 0.f;
                        const LAS float* lr = ADG + (quad * 16 + r) * P_ADG;
#pragma unroll
                        for (int s4 = 0; s4 < (r + 3) / 4; ++s4) { const f32x4 lv = *(const LAS f32x4*)(lr + 4 * s4);
#pragma unroll
                            for (int e = 0; e < 4; ++e) if (4 * s4 + e < r) acc -= lv[e] * tcol[4 * s4 + e]; }
                        tcol[r] = acc; TIB[(quad * 16 + r) * 16 + l15] = f2bf(acc); }
                }
                f32x4 ru[4], rw[4];
                { GD_IDS();
#pragma unroll
                for (int k = 0; k < 4; ++k) { const f32x4 bt = *(const LAS f32x4*)(BETA + 16 * k + 4 * quad), eg = *(const LAS f32x4*)(EG + 16 * k + 4 * quad);
#pragma unroll
                    for (int g = 0; g < 4; ++g) { const int c = 16 * k + 4 * quad + g;
                        ru[k][g] = bf2f(VS[c * P_QS + 16 * wave + l15]) * bt[g]; rw[k][g] = bf2f(KS[c * P_QS + 16 * wave + l15]) * (bt[g] * eg[g]); } } }
                GD_BAR();
                f32x4 uu[4];
                { GD_IDS();
                    bf16x4 xu[4], xw[4];
#pragma unroll
                    for (int k = 0; k < 4; ++k) {
                        f32x4 su = (f32x4){0.f, 0.f, 0.f, 0.f}, sw = su;
#pragma unroll
                        for (int j = 0; j < 4; ++j) if (j < k) { const bf16x4 af = *(const LAS bf16x4*)(ABF + (16 * k + l15) * P_KST + 16 * j + 4 * quad);
                            su = MFMA16(af, xu[j], su); sw = MFMA16(af, xw[j], sw); }
                        const bf16x4 tf = *(const LAS bf16x4*)(TIB + (k * 16 + l15) * 16 + 4 * quad);
                        const f32x4 z4 = (f32x4){0.f, 0.f, 0.f, 0.f};
                        const f32x4 xuk = MFMA16(tf, pack4(ru[k] - su), z4), xwk = MFMA16(tf, pack4(rw[k] - sw), z4);
                        uu[k] = xuk; xu[k] = pack4(xuk); xw[k] = pack4(xwk);
#pragma unroll
                        for (int g = 0; g < 4; ++g) WB[(16 * k + 4 * quad + g) * P_QS + 16 * wave + l15] = f2bf(xwk[g]);
                    }
                }
                GD_BAR();
                { GD_IDS();
                    bf16x8 Sb[4];
#pragma unroll
                    for (int ks = 0; ks < 4; ++ks) Sb[ks] = pack_acc(Sacc[2 * ks], Sacc[2 * ks + 1]);
                    f32x4 vn[4], oo[4];
#pragma unroll
                    for (int cb = 0; cb < 4; ++cb) {
                        f32x4 ws = (f32x4){0.f, 0.f, 0.f, 0.f}, qs = ws;
#pragma unroll
                        for (int ks = 0; ks < 4; ++ks) { ws = __builtin_amdgcn_mfma_f32_16x16x32_bf16(frag_perm(WB + (16 * cb + l15) * P_QS, 32 * ks, quad), Sb[ks], ws, 0, 0, 0);
                            qs = __builtin_amdgcn_mfma_f32_16x16x32_bf16(frag_perm(QS + (16 * cb + l15) * P_QS, 32 * ks, quad), Sb[ks], qs, 0, 0, 0); }
                        const f32x4 egc = *(const LAS f32x4*)(EG + 16 * cb + 4 * quad);
                        vn[cb] = uu[cb] - ws; oo[cb] = egc * qs;
                    }
                    bf16x8 vb[2];
#pragma unroll
                    for (int kc = 0; kc < 2; ++kc) vb[kc] = pack_acc(vn[2 * kc], vn[2 * kc + 1]);
#pragma unroll
                    for (int cb = 0; cb < 4; ++cb) {
#pragma unroll
                        for (int kc = 0; kc < 2; ++kc) oo[cb] = __builtin_amdgcn_mfma_f32_16x16x32_bf16(frag_perm(QKM + (16 * cb + l15) * P_KST, 32 * kc, quad), vb[kc], oo[cb], 0, 0, 0);
#pragma unroll
                        for (int g = 0; g < 4; ++g) OL[(16 * cb + 4 * quad + g) * P_O + 16 * wave + l15] = oo[cb][g];
                        const f32x4 ek = *(const LAS f32x4*)(EKL + 16 * cb + 4 * quad);
                        vn[cb] = vn[cb] * ek;
                    }
#pragma unroll
                    for (int kc = 0; kc < 2; ++kc) vb[kc] = pack_acc(vn[2 * kc], vn[2 * kc + 1]);
                    const float egl = GL[0];
#pragma unroll
                    for (int db = 0; db < 8; ++db) { f32x4 s = Sacc[db] * egl;
#pragma unroll
                        for (int kc = 0; kc < 2; ++kc) s = __builtin_amdgcn_mfma_f32_16x16x32_bf16(frag_perm(KST + (16 * db + l15) * P_KST, 32 * kc, quad), vb[kc], s, 0, 0, 0);
                        Sacc[db] = s; }
                }
                GD_BAR();
                tprev = t; gpprev = gp;
            }
            GD_S5();
        }
    }
}

DI void gdn_combine_phase(Frame& F, bf16_t* og, bf16_t* obA, bf16_t* obB, const bf16_t* zb, const float* norm_w) {
    const int lane = F.lane(), e0 = (lane & 15) * 8;
    f32x4 nw0 = *(const f32x4*)(norm_w + e0), nw1 = *(const f32x4*)(norm_w + e0 + 4);
    for (int R = F.bid * 8 + F.wave; R < MTOK; R += F.G * 8) {
        bf16_t* op = og + (size_t)R * D + lane * 8; const bf16_t* bp = gd_ob_row(obA, obB, R) + lane * 8; const bf16_t* zp = zb + (size_t)R * D + lane * 8;
        u32x4 f[4], g[4], z[4];
#pragma unroll
        for (int q = 0; q < 4; ++q) { f[q] = *(const u32x4*)(op + 512 * q); g[q] = *(const u32x4*)(bp + 512 * q); z[q] = *(const u32x4*)(zp + 512 * q); }
#pragma unroll
        for (int q = 0; q < 4; ++q) {
            const unsigned fw[4] = {f[q].x, f[q].y, f[q].z, f[q].w}, gw[4] = {g[q].x, g[q].y, g[q].z, g[q].w}, zw[4] = {z[q].x, z[q].y, z[q].z, z[q].w};
            float o[8], zz[8]; float ss = 0.f;
#pragma unroll
            for (int k = 0; k < 4; ++k) { o[2 * k] = bf_lo(fw[k]) + bf_lo(gw[k]); o[2 * k + 1] = bf_hi(fw[k]) + bf_hi(gw[k]); zz[2 * k] = bf_lo(zw[k]); zz[2 * k + 1] = bf_hi(zw[k]); }
#pragma unroll
            for (int e = 0; e < 8; ++e) ss += o[e] * o[e];
            ss += __shfl_xor(ss, 1); ss += __shfl_xor(ss, 2); ss += __shfl_xor(ss, 4); ss += __shfl_xor(ss, 8);
            const float rn = 1.0f / sqrtf(ss * (1.0f / 128.0f) + NORM_EPS);
            f32x4 a, b2;
#pragma unroll
            for (int k = 0; k < 4; ++k) { a[k] = o[k] * rn * nw0[k] * siluf_(zz[k]); b2[k] = o[4 + k] * rn * nw1[k] * siluf_(zz[4 + k]); }
            *(u32x4*)(op + 512 * q) = pack8(a, b2);
        }
    }
}
constexpr int N_PHASES = 38;
#ifndef ALIGN_RES
#define ALIGN_RES true
#endif
#ifndef ALIGN_CONS
#define ALIGN_CONS true
#endif
#ifndef WGM_DEF
#define WGM_DEF 4
#endif
#ifndef WGM_RES
#define WGM_RES 4
#endif
#ifndef WGM_FFU
#define WGM_FFU 4
#endif
#ifndef WGM_GATES
#define WGM_GATES 4
#endif
DI pg8::Gemm mk_gemm(const void* A, unsigned lda, const void* B, unsigned ldb, long hB, int nt) { pg8::Gemm g; g.A = (const char*)A; g.B = (const char*)B; g.lda = lda; g.ldb = ldb; g.hstepA = 128L * lda; g.hstepB = hB; g.nt = nt; return g; }
DI SchedLin mk_lin(Frame& F, int nM, int nN, long a_base, long a_tile, long b_base, long b_tile, int nt = 32, int wgm = WGM_DEF) { SchedLin s; s.o.init(nM, nN, F.G, F.bid, wgm); s.a_base = a_base; s.a_tile = a_tile; s.b_base = b_base; s.b_tile = b_tile; s.nt = nt; return s; }
DI SchedRes mk_res(Frame& F, long a_tile, long b_base, long b_tile, int nt, int wgm = WGM_RES) { SchedRes s; s.init(F.G, F.bid, a_tile, b_base, b_tile, nt, wgm); return s; }

__global__ void __launch_bounds__(512, 2) trunk_fwd(Args args) {
    extern __shared__ __attribute__((aligned(16))) unsigned char lds_raw[];
    Frame F;
    F.lds = (LAS unsigned char*)lds_raw;
    F.wave = __builtin_amdgcn_readfirstlane(threadIdx.x >> 6); F.G = gridDim.x; F.bid = blockIdx.x;
    F.in = args.in; F.out = args.out; F.ws = args.ws;
    volatile LAS unsigned* MISC = (volatile LAS unsigned*)(F.lds + MISC_OFF);
    if (F.tid() < 16) MISC[F.tid()] = 0u;
    __syncthreads();
    const int lo = args.ph_lo, hi = args.ph_hi;
    unsigned* ctl = (unsigned*)(F.ws + WS_CTL);
    XcdBarrier bar; bar.bar = ctl + CW_BAR; bar.x = 0; bar.st = nullptr;
    if (hi - lo > 1) bar = xcd_barrier_post(ctl + CW_BAR, MISC + 8, F.wave == 0 && lane_id() == 0);
#define IN(k) (lo <= (k) && (k) < hi)
#define SEAM(k) do { if (IN(k) && IN((k) + 1)) xcd_barrier(bar, F.wave == 0 && lane_id() == 0); } while (0)
#ifndef REP_MASK
#define REP_MASK 0ull
#endif
#define PHASE(k, ...) if (IN(k)) { if constexpr (((REP_MASK) >> (k)) & 1ull) { __VA_ARGS__; xcd_barrier(bar, F.wave == 0 && lane_id() == 0); } __VA_ARGS__; } SEAM(k);
    LAS float* cscr = (LAS float*)(F.lds + F.wave * 16384);
    bf16_t* const XNp = F.XN(); bf16_t* const XCp = F.XC(); unsigned char* const SCR = F.SCR();
    bf16_t* const OUTB = (bf16_t*)F.out;
    constexpr unsigned LD2K = 4096;


#define CVT_BEGIN() CvtCursor cc{F.bid * 8 + F.wave, 0, F.G * 8}
#define CVT_BEGIN_LIN(REM_) CvtCursor cc{(F.bid >= (REM_)) ? (F.bid - (REM_)) * 8 + F.wave : 0x3fffffff, 0, (F.G - (REM_)) * 8}
#define CVT_BEGIN_RES() CvtCursor cc{(F.G == 256) ? (F.bid >= 64 ? (F.bid - 64) * 8 + F.wave : 0x3fffffff) : F.bid * 8 + F.wave, 0, (F.G == 256) ? 192 * 8 : F.G * 8}
#define PH_FIN(XI_, XO_, S1_, ...) { CVT_BEGIN(); __VA_ARGS__; ss_final_phase(F, ssp, rsv, XI_, XO_, SLAB0, S1_); }
#define PH_FFN_UP(LI_, X_) { bf16_t* wg = (bf16_t*)F.WFFN(); \
        pg8::Gemm g = mk_gemm(X_, LD2K, wg, LD2K, (long)DFF * LD2K, 32); SchedLin S = mk_lin(F, 195, 44, -(long)LD2K, 254L * LD2K, 0, 128L * LD2K, 32, WGM_FFU); \
        EpiFfnUp E{(bf16_t*)SCR, F.I(27) + (size_t)(LI_) * 3 * DFF, F.I(28) + (size_t)(LI_) * DFF, (LAS float*)(F.lds + EDGE_OFF), rsv, (const unsigned char*)(F.ws + WS_CTL + 768 * 1024)}; \
        pg8::gemm_phase<EpiFfnUp, SchedLin, true>(F.lds, g, S, E, F.wave); }
#define PH_FFN_DOWN(XI_, XO_, SS_, ...) { bf16_t* wd = (bf16_t*)F.WFFN() + (size_t)2 * DFF * D; \
        pg8::Gemm g = mk_gemm(SCR, DFF * 2, wd, DFF * 2, 128L * DFF * 2, 88); SchedRes S = mk_res(F, 256L * DFF * 2, 0, 256L * DFF * 2, 88); \
        EpiResAdd E{XI_, XO_, SS_, SLAB0}; pg8::gemm_phase<EpiResAdd, SchedRes, ALIGN_RES>(F.lds, g, S, E, F.wave); { CVT_BEGIN_RES(); __VA_ARGS__; } }
#define PH_RG_IN(X_, ...) { bf16_t* win = (bf16_t*)F.WMIX(); \
        pg8::Gemm g = mk_gemm(X_, LD2K, win, LD2K, 128L * LD2K, 32); SchedLin S = mk_lin(F, 194, 16, 0, 256L * LD2K, 0, 256L * LD2K); \
        EpiRgIn E{OUTB, (bf16_t*)SCR, rsv}; pg8::gemm_phase<EpiRgIn, SchedLin, ALIGN_CONS>(F.lds, g, S, E, F.wave); { CVT_BEGIN_LIN((194 * 16) % F.G); __VA_ARGS__; } }
#define PH_RG_CONV(J_) { rg_conv_phase(F, (const bf16_t*)SCR, XCp, F.I(7) + (size_t)(J_) * 4 * D, F.I(8) + (size_t)(J_) * D); }
#define PH_RG_GATES(J_) { bf16_t* gates = (bf16_t*)F.WMIX() + (size_t)4096 * D; \
        pg8::Gemm g = mk_gemm(XCp, LD2K, gates, 512, 8L * 131072, 4); SchedGates S; S.o.init(194, 32, F.G, F.bid, WGM_GATES); \
        EpiGates E{XCp, (bf16_t*)SCR, (bf16_t*)(SCR + B194), B194, F.I(10) + (size_t)(J_) * 2 * D, F.I(12) + (size_t)(J_) * 2 * D, F.I(13) + (size_t)(J_) * 2 * D, (LAS float*)(F.lds + EDGE_OFF)}; \
        pg8::gemm_phase<EpiGates, SchedGates, true>(F.lds, g, S, E, F.wave); }
#define PH_RG_SCAN() { rg_scan_phase(F, (const bf16_t*)SCR, (bf16_t*)(SCR + B194), (const bf16_t*)(SCR + 2 * B194), (bf16_t*)(SCR + 3 * B194), OUTB); }
#define PH_RG_OUT(XI_, XO_, ...) { bf16_t* wout = (bf16_t*)F.WMIX() + (size_t)4096 * D + (size_t)32 * 65536; \
        pg8::Gemm g = mk_gemm(SCR + 3 * B194, LD2K, wout, LD2K, 128L * LD2K, 32); SchedRes S = mk_res(F, 256L * LD2K, 0, 256L * LD2K, 32); \
        EpiResAdd E{XI_, XO_, ssp, SLAB0}; pg8::gemm_phase<EpiResAdd, SchedRes, ALIGN_RES>(F.lds, g, S, E, F.wave); { CVT_BEGIN_RES(); __VA_ARGS__; } }
#define PH_GDN_PROJ(HALF_, X_, ...) { bf16_t* w = (bf16_t*)F.WMIX() + ((HALF_) ? (size_t)6400 * D : 0); \
        pg8::Gemm g = mk_gemm(X_, LD2K, w, LD2K, 128L * LD2K, 32); SchedLin S = mk_lin(F, 194, (HALF_) ? 24 : 25, 0, 256L * LD2K, 0, 256L * LD2K); \
        EpiGdnProj E{(bf16_t*)SCR, (HALF_) ? (bf16_t*)(SCR + 2 * B194) : XB, (float*)(SCR + 3 * B194), F.I(21), F.I(22), (bf16_t*)(SCR + 3 * B194 + 26 * MiB), rsv}; pg8::gemm_phase<EpiGdnProj, SchedLin, ALIGN_CONS>(F.lds, g, S, E, F.wave); { CVT_BEGIN_LIN((194 * ((HALF_) ? 24 : 25)) % F.G); __VA_ARGS__; } }
#define PH_GDN_CONV(HALF_) { gdn_conv_phase(F, HALF_, (bf16_t*)SCR, (const bf16_t*)(SCR + 3 * B194 + 26 * MiB), F.I(20)); }
#define GD_OBA (OUTB + (size_t)MP * D)
#define GD_OBB ((bf16_t*)(SCR + 3 * B194 + 48 * MiB))
#define PH_GDN_CORE(HALF_) { gdn_core_phase(F, HALF_, (const bf16_t*)SCR, (const float*)(SCR + 3 * B194), (HALF_) ? XCp : OUTB, GD_OBA, GD_OBB); }
#define PH_GDN_COMB(HALF_) { gdn_combine_phase(F, (HALF_) ? XCp : OUTB, GD_OBA, GD_OBB, (HALF_) ? (const bf16_t*)(SCR + 2 * B194) : (const bf16_t*)XB, F.I(23)); }
#define PH_GDN_OUT(HALF_, XI_, XO_, SS_, ...) { bf16_t* wout = (bf16_t*)F.WMIX() + (size_t)(6400 + 6144) * D; \
        pg8::Gemm g = mk_gemm((HALF_) ? XCp : OUTB, LD2K, wout, 8192, 128L * 8192, 32); SchedRes S = mk_res(F, 256L * LD2K, (long)(HALF_) * 4096, 256L * 8192, 32); \
        EpiResAdd E{XI_, XO_, SS_, (HALF_) ? SLAB1 : SLAB0}; pg8::gemm_phase<EpiResAdd, SchedRes, ALIGN_RES>(F.lds, g, S, E, F.wave); { CVT_BEGIN_RES(); __VA_ARGS__; } }
    float* const SLAB0 = (float*)(SCR + 784 * MiB); float* const SLAB1 = (float*)(SCR + 640 * MiB); float* const NOSLAB = nullptr;
    float* const ssp = (float*)(SCR + 4 * B194);
    float* const rsv = (float*)(F.ws + WS_CTL + 256 * 1024);
    bf16_t* const NOXN = nullptr; float* const NOSS = nullptr; (void)NOXN;

    bf16_t* const XA = XNp; bf16_t* const XB = (bf16_t*)(F.ws + WS_H + B194);
    PHASE(0, { CVT_BEGIN(); cvt_rg(F, cc, 0, 0, cscr); norm_phase<1>(F, XA, F.I(3), rsv); })
    PHASE(1, PH_RG_IN(XA, cvt_ffn(F, cc, 0, cscr))) PHASE(2, PH_RG_CONV(0)) PHASE(3, PH_RG_GATES(0)) PHASE(4, PH_RG_SCAN()) PHASE(5, PH_RG_OUT(XA, XB, (void)cc))
    PHASE(6, PH_FIN(XA, XB, NOSLAB, (void)cc))
    PHASE(7, PH_FFN_UP(0, XB)) PHASE(8, PH_FFN_DOWN(XB, XA, ssp, cvt_na(F, cc, cscr))) PHASE(9, PH_FIN(XB, XA, NOSLAB, (void)cc))
    PHASE(10, { pg8::Gemm g = mk_gemm(XA, LD2K, F.WMIX(), LD2K, 128L * LD2K, 32); SchedLin S = mk_lin(F, 194, 24, 0, 256L * LD2K, 0, 256L * LD2K);
        EpiPlainBf16 E{(bf16_t*)SCR, 6144, rsv}; pg8::gemm_phase<EpiPlainBf16, SchedLin, ALIGN_CONS>(F.lds, g, S, E, F.wave); { CVT_BEGIN_LIN((194 * 24) % F.G); cvt_ffn(F, cc, 1, cscr); } })
    PHASE(11, { na_attn_phase(F, (const bf16_t*)SCR, OUTB, F.I(16), F.I(17)); })
    PHASE(12, { bf16_t* wo = (bf16_t*)F.WMIX() + (size_t)6144 * D;
        pg8::Gemm g = mk_gemm(OUTB, LD2K, wo, LD2K, 128L * LD2K, 32); SchedRes S = mk_res(F, 256L * LD2K, 0, 256L * LD2K, 32);
        EpiResAdd E{XA, XB, ssp, SLAB0}; pg8::gemm_phase<EpiResAdd, SchedRes, ALIGN_RES>(F.lds, g, S, E, F.wave); })
    PHASE(13, PH_FIN(XA, XB, NOSLAB, (void)cc))
    PHASE(14, PH_FFN_UP(1, XB)) PHASE(15, PH_FFN_DOWN(XB, XA, ssp, cvt_gdn(F, cc, cscr))) PHASE(16, PH_FIN(XB, XA, NOSLAB, (void)cc))
    PHASE(17, PH_GDN_PROJ(0, XA, (void)cc)) PHASE(18, PH_GDN_CONV(0)) PHASE(19, PH_GDN_CORE(0))
    PHASE(20, { PH_GDN_COMB(0) PH_GDN_PROJ(1, XA, cvt_ffn(F, cc, 2, cscr)) }) PHASE(21, PH_GDN_CONV(1)) PHASE(22, PH_GDN_CORE(1))
    PHASE(23, { PH_GDN_COMB(1) PH_GDN_OUT(0, XA, XB, NOSS, (void)cc) })
    PHASE(24, PH_GDN_OUT(1, XB, XA, ssp, (void)cc))
    PHASE(25, PH_FIN(XA, XA, SLAB1, (void)cc))
    PHASE(26, PH_FFN_UP(2, XA)) PHASE(27, PH_FFN_DOWN(XA, XB, ssp, cvt_rg(F, cc, 1, 3, cscr))) PHASE(28, PH_FIN(XA, XB, NOSLAB, (void)cc))
    PHASE(29, PH_RG_IN(XB, cvt_ffn(F, cc, 3, cscr))) PHASE(30, PH_RG_CONV(1)) PHASE(31, PH_RG_GATES(1)) PHASE(32, PH_RG_SCAN()) PHASE(33, PH_RG_OUT(XB, XA, (void)cc))
    PHASE(34, PH_FIN(XB, XA, NOSLAB, (void)cc))
    PHASE(35, PH_FFN_UP(3, XA)) PHASE(36, PH_FFN_DOWN(XA, XB, NOSS, (void)cc))
    PHASE(37, { norm_phase<2>(F, XB, F.I(5), nullptr, XA, SLAB0); })
#undef IN
#undef SEAM
}

__global__ void fill_k(float* o, size_t n, float v) { for (size_t i = (size_t)blockIdx.x * blockDim.x + threadIdx.x; i < n; i += (size_t)gridDim.x * blockDim.x) o[i] = v; }
#ifndef MK_ONE_LAUNCH
#define MK_ONE_LAUNCH 1
#endif
extern "C" void kernel_launch(void* const* d_in, const int* in_sizes, int n_in, void* d_out, int out_size, void* d_ws, size_t ws_size, hipStream_t stream) {
    static int grid = 0;
    if (grid == 0) {
        int dev = 0, cus = 0;
        hipError_t e = hipGetDevice(&dev); if (e == hipSuccess) e = hipDeviceGetAttribute(&cus, hipDeviceAttributeMultiprocessorCount, dev);
        if (e == hipSuccess) e = hipFuncSetAttribute((const void*)trunk_fwd, hipFuncAttributeMaxDynamicSharedMemorySize, LDS_BYTES);
        if (e != hipSuccess || n_in != 30 || ws_size < WS_END || cus < 1) { fprintf(stderr, "kernel_launch: setup failed (%s), n_in %d, ws %zu\n", hipGetErrorName(e), n_in, ws_size); grid = -1; }
        else grid = cus;
        (void)hipGetLastError();
    }
    if (grid < 0) { fill_k<<<1024, 256, 0, stream>>>((float*)d_out, (size_t)out_size, 7.0f); return; }
    (void)hipMemsetAsync((char*)d_ws + WS_CTL, 0, CTL_ZERO_BYTES, stream);
    Args a{};
    for (int i = 0; i < 30; ++i) a.in[i] = (const float*)d_in[i];
    a.out = (float*)d_out; a.ws = (unsigned char*)d_ws;
#if MK_ONE_LAUNCH
    a.ph_lo = 0; a.ph_hi = N_PHASES;
    hipLaunchKernelGGL(trunk_fwd, dim3(grid), dim3(512), LDS_BYTES, stream, a);
#else
    for (int p = 0; p < N_PHASES; ++p) { a.ph_lo = p; a.ph_hi = p + 1; hipLaunchKernelGGL(trunk_fwd, dim3(grid), dim3(512), LDS_BYTES, stream, a); }
#endif
}
```

```cpp
#include <hip/hip_runtime.h>
#include <cstdio>
#include <cstdint>

#define LAS __attribute__((address_space(3)))
#define GAS __attribute__((address_space(1)))
typedef unsigned short bf16_t;
typedef short bf16x8 __attribute__((ext_vector_type(8)));
typedef short s16x4 __attribute__((ext_vector_type(4)));
typedef float f32x4 __attribute__((ext_vector_type(4)));
typedef float f32x2 __attribute__((ext_vector_type(2)));
typedef unsigned u32x4 __attribute__((ext_vector_type(4)));
typedef unsigned u32x2 __attribute__((ext_vector_type(2)));
#define DI __device__ __forceinline__

constexpr int D = 2048, NSEQ = 20, NPROMPT = 16, TP = 2064, TS = 4112, LP = 2048, LS = 4096, NMETA = 16;
constexpr int MPROMPT = NPROMPT * TP;
constexpr int MTOK = MPROMPT + 4 * TS;
constexpr int MP = 49664;
constexpr int DFF = 5632;
constexpr float NORM_EPS = 1e-6f;
DI int seq_off(int b) { return b < NPROMPT ? b * TP : MPROMPT + (b - NPROMPT) * TS; }
DI int seq_len(int b) { return b < NPROMPT ? TP : TS; }
DI void row_bt(int R, int& b, int& t) { if (R < MPROMPT) { b = R / TP; t = R - b * TP; } else { const int q = (R - MPROMPT) / TS; b = NPROMPT + q; t = R - MPROMPT - q * TS; } }

typedef __bf16 bf16v2_ __attribute__((ext_vector_type(2)));
DI unsigned cvt_pk_bf16(float lo, float hi) { const bf16v2_ r = __builtin_convertvector((f32x2){lo, hi}, bf16v2_); return __builtin_bit_cast(unsigned, r); }
DI float bf_lo(unsigned w) { return __uint_as_float(w << 16); }
DI float bf_hi(unsigned w) { return __uint_as_float(w & 0xffff0000u); }
DI float bf2f(bf16_t h) { return __uint_as_float(((unsigned)h) << 16); }
DI bf16_t f2bf(float f) { return (bf16_t)(cvt_pk_bf16(f, 0.f) & 0xffffu); }
DI float fast_rcp(float x) { return __builtin_amdgcn_rcpf(x); }
DI float sigmoidf_(float x) { return fast_rcp(1.f + __expf(-x)); }
DI float siluf_(float x) { return x * sigmoidf_(x); }
DI float softplusf_(float x) { return x > 20.f ? x : log1pf(__expf(x)); }
DI float softplus_lite(float x) { const float e = __expf(x), u = 1.f + e, d = u - 1.f; return x > 20.f ? x : (d == 0.f ? e : __logf(u) * e * fast_rcp(d)); }
DI float gelu_tanh_(float x) { const float u = 1.5957691216057308f * (x + 0.044715f * x * x * x); return x * sigmoidf_(u); }
DI int lane_id() { int r; asm volatile("v_mbcnt_lo_u32_b32 %0, -1, 0\n\tv_mbcnt_hi_u32_b32 %0, -1, %0" : "=&v"(r)); return r; }
DI float wave_sum(float v) {
#pragma unroll
    for (int o = 1; o < 64; o <<= 1) v += __shfl_xor(v, o);
    return v;
}

#define XB_TMO      128
#define XB_XCNT(j)  (256  + 64 * (j))
#define XB_XSUB(j)  (1280 + 64 * (j))
#define XB_XGEN(j)  (2304 + 64 * (j))
#define XB_TOP      3328
#define XB_TOPGEN   3392
#define XCD_BAR_WORDS 3456
#define XB_SPIN_CAP (1u << 22)
DI unsigned xb_ld(unsigned* p)              { return __hip_atomic_load(p, __ATOMIC_RELAXED, __HIP_MEMORY_SCOPE_AGENT); }
DI unsigned xb_add(unsigned* p, unsigned v) { return __hip_atomic_fetch_add(p, v, __ATOMIC_RELAXED, __HIP_MEMORY_SCOPE_AGENT); }
DI unsigned xb_xcc_id() { return (unsigned)__builtin_amdgcn_s_getreg((3 << 11) | 20) & 0xFu; }
#define XB_SPIN(cond, bar) do { unsigned _sp = 0; while (cond) { __builtin_amdgcn_s_sleep(1); \
    if ((++_sp & 255u) == 0u) { if (xb_ld(&(bar)[XB_TMO])) break; if (_sp > XB_SPIN_CAP) { atomicAdd(&(bar)[XB_TMO], 1u); break; } } } } while (0)
struct XcdBarrier { unsigned* bar; unsigned x; volatile LAS unsigned* st; };
DI XcdBarrier xcd_barrier_post(unsigned* bar, volatile LAS unsigned* st, bool leader) {
    XcdBarrier b; b.bar = bar; b.x = xb_xcc_id(); b.st = st;
    if (leader) (void)xb_add(&bar[XB_XCNT(b.x)], 1u);
    return b;
}
DI void xcd_barrier_complete(unsigned* bar, unsigned x, unsigned& nloc, unsigned& nx) {
    const unsigned G = gridDim.x * gridDim.y * gridDim.z;
    unsigned sum, cnt, mine, sp = 0u;
    for (;;) {
        sum = 0u; cnt = 0u; mine = 0u;
#pragma unroll
        for (unsigned j = 0; j < 16; ++j) { const unsigned c = xb_ld(&bar[XB_XCNT(j)]); sum += c; cnt += (c > 0u) ? 1u : 0u; mine = (j == x) ? c : mine; }
        if (sum == G) break;
        __builtin_amdgcn_s_sleep(1);
        if ((++sp & 255u) == 0u) { if (xb_ld(&bar[XB_TMO])) break; if (sp > XB_SPIN_CAP) { atomicAdd(&bar[XB_TMO], 1u); break; } }
    }
    nloc = mine > 0u ? mine : 1u; nx = cnt > 0u ? cnt : 1u;
}
DI void xcd_barrier(const XcdBarrier& b, bool leader) {
    asm volatile("s_waitcnt vmcnt(0)" ::: "memory");
    __syncthreads();
    if (leader) {
        unsigned* bar = b.bar;
        __builtin_amdgcn_s_waitcnt(0);
        unsigned nloc = b.st[0], nx = b.st[1];
        if (nloc == 0u) { xcd_barrier_complete(bar, b.x, nloc, nx); b.st[0] = nloc; b.st[1] = nx; }
        const unsigned old = xb_add(&bar[XB_XSUB(b.x)], 1u);
        const unsigned gen = old / nloc;
        if (old + 1u == (gen + 1u) * nloc) {
            __builtin_amdgcn_fence(__ATOMIC_RELEASE, "agent");
            asm volatile("s_waitcnt vmcnt(0)" ::: "memory");
            const unsigned og = xb_add(&bar[XB_TOP], 1u);
            const unsigned tg = og / nx;
            if (og + 1u == (tg + 1u) * nx) xb_add(&bar[XB_TOPGEN], 1u);
            else XB_SPIN(xb_ld(&bar[XB_TOPGEN]) == tg, bar);
            __builtin_amdgcn_fence(__ATOMIC_ACQUIRE, "agent");
            xb_add(&bar[XB_XGEN(b.x)], 1u);
            asm volatile("s_waitcnt vmcnt(0)" ::: "memory");
        } else {
            XB_SPIN(xb_ld(&bar[XB_XGEN(b.x)]) == gen, bar);
            __builtin_amdgcn_fence(__ATOMIC_ACQUIRE, "agent");
            asm volatile("s_waitcnt vmcnt(0)" ::: "memory");
        }
    }
    __syncthreads();
}

namespace pg8 {
constexpr int BM = 256, BK = 64, HALF = 128, HTB = HALF * BK * 2, STAGE_BYTES = 8 * HTB, NXCD = 8;
__host__ __device__ __forceinline__ int lds_byte(int r, int c) { const int st = (r >> 4) * 2 + (c >> 5), rr = r & 15, cc = c & 31, ob = rr * 64 + cc * 2; return st * 1024 + (ob ^ (((ob >> 9) & 1) << 5)); }
__host__ __device__ __forceinline__ void stage_rc(int b, int& R, int& C) { const int st = b / 1024, sb = b % 1024, swz = sb ^ (((sb >> 9) & 1) << 5); R = (st >> 1) * 16 + swz / 64; C = (st & 1) * 32 + (swz % 64) / 2; }
__host__ __device__ __forceinline__ int perm32(int rho) { const int n = rho >> 4, i = rho & 15; return 8 * (i >> 2) + 4 * n + (i & 3); }

struct Unit { int pm, pn; long aoff, boff; int nt, sub; };
struct Gemm { const char* A; const char* B; unsigned lda, ldb; long hstepA, hstepB; int nt; };
struct TileOrder {
    int nM, nN, nwg, G, c, WGM;
    DI void init(int nM_, int nN_, int G_, int c_, int wgm_ = 4) { nM = nM_; nN = nN_; nwg = nM * nN; G = G_; c = c_; WGM = wgm_; }
    DI bool tile(int i, int& pm, int& pn) const {
        const long L = (long)i * G + c; if (L >= nwg) return false;
        int wgid = (int)L; { const int q = nwg / NXCD, r = nwg % NXCD, xcd = wgid % NXCD, off = wgid / NXCD; wgid = (xcd < r ? xcd * (q + 1) : r * (q + 1) + (xcd - r) * q) + off; }
        const int nig = WGM * nN, gid = wgid / nig, fm = gid * WGM, gsz = (nM - fm) < WGM ? (nM - fm) : WGM;
        pm = fm + ((wgid % nig) % gsz); pn = (wgid % nig) / gsz; return true;
    }
};

template <class Epi, class Sched, bool ALIGN_EPI>
DI void gemm_phase(LAS unsigned char* lds, const Gemm g, const Sched& S, const Epi& E, int wave_id) {
    int tid_ = wave_id * 64 + lane_id(); asm volatile("" : "+v"(tid_));
    const int tid = tid_, wid = __builtin_amdgcn_readfirstlane(tid >> 6), lane = tid & 63, wr = wid >> 2, wc = wid & 3, fr = lane & 15, fq = lane >> 4;
    unsigned voffA[2], voffB[2];
#pragma unroll
    for (int i = 0; i < 2; ++i) { int R, C; stage_rc(tid * 16 + i * 8192, R, C); const int Rb = Epi::PERM ? ((R & ~31) + perm32(R & 31)) : R;
        voffA[i] = (unsigned)R * g.lda + (unsigned)C * 2u; voffB[i] = (unsigned)Rb * g.ldb + (unsigned)C * 2u; }
    const long kstep = (long)(BK * 2);
    const long hA = g.hstepA, hB = g.hstepB;
    const unsigned ldsw = (unsigned)wid * 1024u;
    const int aoff = lds_byte(wr * 64 + fr, fq * 8), boff = lds_byte(wc * 32 + fr, fq * 8);
#define PG8_SA(b, h) (((b) * 2 + (h)) * HTB)
#define PG8_SB(b, h) ((4 + (b) * 2 + (h)) * HTB)
#define PG8_STAGE(bufoff, gbase, voff) do { _Pragma("unroll") for (int _i = 0; _i < 2; ++_i) \
        __builtin_amdgcn_global_load_lds((const unsigned*)((const char*)(gbase) + (voff)[_i]), (LAS unsigned*)(lds + (bufoff) + ldsw + _i * 8192), 16, 0, 0); } while (0)
#define PG8_LDA(dst, b, h) do { _Pragma("unroll") for (int m = 0; m < 4; ++m) _Pragma("unroll") for (int k = 0; k < 2; ++k) dst[m][k] = *(const LAS bf16x8*)(lds + PG8_SA(b, h) + aoff + m * 2048 + k * 1024); } while (0)
#define PG8_LDB(dst, b, h) do { _Pragma("unroll") for (int n = 0; n < 2; ++n) _Pragma("unroll") for (int k = 0; k < 2; ++k) dst[n][k] = *(const LAS bf16x8*)(lds + PG8_SB(b, h) + boff + n * 2048 + k * 1024); } while (0)
#define PG8_MMA(ai, bj, At, Bt) do { __builtin_amdgcn_s_setprio(1); _Pragma("unroll") for (int m = 0; m < 4; ++m) _Pragma("unroll") for (int n = 0; n < 2; ++n) _Pragma("unroll") for (int k = 0; k < 2; ++k) \
        acc[ai][bj][m][n] = __builtin_amdgcn_mfma_f32_16x16x32_bf16(Bt[n][k], At[m][k], acc[ai][bj][m][n], 0, 0, 0); __builtin_amdgcn_s_setprio(0); } while (0)
#define PG8_WAIT_V(n) asm volatile("s_waitcnt vmcnt(" #n ")" ::: "memory")
#define PG8_WAIT_L(n) asm volatile("s_waitcnt lgkmcnt(" #n ")" ::: "memory")
#define PG8_BAR __builtin_amdgcn_s_barrier()
#define PG8_SCHED __builtin_amdgcn_sched_barrier(0)
    Unit cur, nxt; int ui = 0;
    if (!S.next(0, cur)) return;
    f32x4 acc[2][2][4][2];
#pragma unroll
    for (int a = 0; a < 2; ++a)
#pragma unroll
        for (int b = 0; b < 2; ++b)
#pragma unroll
            for (int m = 0; m < 4; ++m)
#pragma unroll
                for (int n = 0; n < 2; ++n) acc[a][b][m][n] = (f32x4){0.f, 0.f, 0.f, 0.f};
    bf16x8 At[4][2], B0[2][2], B1[2][2];
    const char* cA = g.A + cur.aoff; const char* cB = g.B + cur.boff;
    PG8_STAGE(PG8_SB(0, 0), cB, voffB); PG8_STAGE(PG8_SB(0, 1), cB + hB, voffB); PG8_STAGE(PG8_SA(0, 0), cA, voffA); PG8_STAGE(PG8_SA(0, 1), cA + hA, voffA);
    if (wr == 1) PG8_BAR;
    PG8_WAIT_V(2); PG8_BAR;
    PG8_STAGE(PG8_SB(1, 0), cB + kstep, voffB); PG8_STAGE(PG8_SA(1, 0), cA + kstep, voffA); PG8_STAGE(PG8_SB(1, 1), cB + hB + kstep, voffB);
    PG8_WAIT_V(6); PG8_BAR;
    for (;;) {
        const bool has_next = S.next(ui + 1, nxt);
        const char* nA = has_next ? g.A + nxt.aoff : cA; const char* nB = has_next ? g.B + nxt.boff : cB;
        const int nt = cur.nt;
        for (int t = 0; t < nt; t += 2) {
            const bool last = (t == nt - 2);
            const char* a1 = cA + (long)(t + 1) * kstep;
            const char* a2 = last ? nA : cA + (long)(t + 2) * kstep; const char* b2 = last ? nB : cB + (long)(t + 2) * kstep;
            const char* a3 = a2 + kstep; const char* b3 = b2 + kstep;
            PG8_LDB(B0, 0, 0); PG8_LDB(B1, 0, 1); PG8_SCHED; PG8_LDA(At, 0, 0); PG8_STAGE(PG8_SA(1, 1), a1 + hA, voffA);
            PG8_WAIT_V(8); PG8_WAIT_L(0); PG8_BAR; PG8_MMA(0, 0, At, B0); PG8_MMA(0, 1, At, B1); PG8_BAR; PG8_SCHED;
            PG8_LDA(At, 0, 1); PG8_STAGE(PG8_SB(0, 0), b2, voffB); PG8_STAGE(PG8_SB(0, 1), b2 + hB, voffB); PG8_STAGE(PG8_SA(0, 0), a2, voffA);
            PG8_WAIT_V(8); PG8_WAIT_L(0); PG8_BAR; PG8_MMA(1, 0, At, B0); PG8_MMA(1, 1, At, B1); PG8_BAR; PG8_SCHED;
            PG8_LDB(B0, 1, 0); PG8_LDB(B1, 1, 1); PG8_SCHED; PG8_LDA(At, 1, 0); PG8_STAGE(PG8_SA(0, 1), a2 + hA, voffA);
            PG8_WAIT_V(8); PG8_WAIT_L(0); PG8_BAR; PG8_MMA(0, 0, At, B0); PG8_MMA(0, 1, At, B1); PG8_BAR; PG8_SCHED;
            PG8_LDA(At, 1, 1); PG8_STAGE(PG8_SB(1, 0), b3, voffB); PG8_STAGE(PG8_SB(1, 1), b3 + hB, voffB); PG8_STAGE(PG8_SA(1, 0), a3, voffA);
            PG8_WAIT_V(8); PG8_WAIT_L(0); PG8_BAR; PG8_MMA(1, 0, At, B0); PG8_MMA(1, 1, At, B1); PG8_BAR; PG8_SCHED;
        }
        if constexpr (ALIGN_EPI) { if (wr == 0) PG8_BAR; }
        E(acc, cur, ui, wr, wc, fr, fq);
        if (!has_next) break;
#pragma unroll
        for (int a = 0; a < 2; ++a)
#pragma unroll
            for (int b = 0; b < 2; ++b)
#pragma unroll
                for (int m = 0; m < 4; ++m)
#pragma unroll
                    for (int n = 0; n < 2; ++n) acc[a][b][m][n] = (f32x4){0.f, 0.f, 0.f, 0.f};
        cur = nxt; cA = nA; cB = nB; ++ui;
        if constexpr (ALIGN_EPI) { if (wr == 1) PG8_BAR; }
    }
    PG8_WAIT_V(0);
    if constexpr (!ALIGN_EPI) { if (wr == 0) PG8_BAR; }
    PG8_BAR;
#undef PG8_SA
#undef PG8_SB
#undef PG8_STAGE
#undef PG8_LDA
#undef PG8_LDB
#undef PG8_MMA
#undef PG8_WAIT_V
#undef PG8_WAIT_L
#undef PG8_BAR
#undef PG8_SCHED
}
}
constexpr size_t MiB = (size_t)1 << 20;
constexpr size_t WS_CTL = 0, CTL_ZERO_BYTES = 64 * 1024;
constexpr size_t WS_WMIX = 1 * MiB, WS_WFFN = 67 * MiB, WS_XN = 133 * MiB, WS_H = 328 * MiB, WS_SCR = 716 * MiB, WS_END = 1524 * MiB;
constexpr size_t B194 = (size_t)MP * D * 2;
static_assert(B194 == 194 * MiB, "buffer size");
static_assert(WS_XN + 4096 + B194 <= WS_H && WS_H + 2 * B194 <= WS_SCR && WS_SCR + 4 * B194 <= WS_END, "ws map");
static_assert((size_t)MP * DFF * 2 <= WS_END - WS_SCR && (size_t)MP * 6144 * 2 <= WS_END - WS_SCR && WS_SCR + 4 * B194 + (size_t)MP * 128 <= WS_END, "scratch");
constexpr int CW_BAR = 1024;
constexpr int MISC_OFF = 163840 - 256, RING_BYTES = 131072, EDGE_OFF = 131072, EDGE_BYTES = 8192, LDS_BYTES = 163840;

struct Args { const float* in[30]; float* out; unsigned char* ws; int ph_lo, ph_hi; };

struct Frame {
    LAS unsigned char* lds;
    int wave, G, bid;
    DI int lane() const { return lane_id(); }
    DI int tid() const { return wave * 64 + lane_id(); }
    const float* const* in;
    float* out; unsigned char* ws;
    DI const float* I(int i) const { return in[i]; }
    DI bf16_t* XN() const { return (bf16_t*)(ws + WS_XN + 4096); }
    DI bf16_t* XC() const { return (bf16_t*)(ws + WS_H); }
    DI unsigned char* SCR() const { return ws + WS_SCR; }
    DI unsigned char* WMIX() const { return ws + WS_WMIX; }
    DI unsigned char* WFFN() const { return ws + WS_WFFN; }
};

struct SchedLin {
    pg8::TileOrder o; long a_base, a_tile, b_base, b_tile; int nt;
    DI bool next(int i, pg8::Unit& u) const { if (!o.tile(i, u.pm, u.pn)) return false; u.aoff = a_base + (long)u.pm * a_tile; u.boff = b_base + (long)u.pn * b_tile; u.nt = nt; u.sub = -1; return true; }
};
struct SchedGates {
    pg8::TileOrder o;
    DI bool next(int i, pg8::Unit& u) const { if (!o.tile(i, u.pm, u.pn)) return false; const int dir = u.pn >> 4, blk = (u.pn >> 1) & 7, hh = u.pn & 1;
        u.aoff = (long)u.pm * 256 * (D * 2) + blk * 512; u.boff = (long)((dir * 2) * 8 + blk) * 131072 + hh * 65536; u.nt = 4; u.sub = -1; return true; }
};

constexpr int RES_MAIN_PM = 192, RES_ROW0 = RES_MAIN_PM * 256, RES_NSPLIT = 4;
struct SchedRes {
    pg8::TileOrder o; long a_tile, b_base, b_tile; int nt; int G, c;
    DI void init(int G_, int c_, long a_tile_, long b_base_, long b_tile_, int nt_, int wgm_ = 4) { o.init(RES_MAIN_PM, 8, G_, c_, wgm_); G = G_; c = c_; a_tile = a_tile_; b_base = b_base_; b_tile = b_tile_; nt = nt_; }
    DI bool next(int i, pg8::Unit& u) const {
        const long L = (long)i * G + c;
        if (L < RES_MAIN_PM * 8) { o.tile(i, u.pm, u.pn); u.aoff = (long)u.pm * a_tile; u.boff = b_base + (long)u.pn * b_tile; u.nt = nt; u.sub = -1; return true; }
        const int r = (int)(L - RES_MAIN_PM * 8); if (r >= 16 * RES_NSPLIT) return false;
        const int s = r % RES_NSPLIT, t = r / RES_NSPLIT, nts = nt / RES_NSPLIT;
        u.pm = RES_MAIN_PM + (t >> 3); u.pn = t & 7; u.aoff = (long)u.pm * a_tile + (long)s * nts * 128; u.boff = b_base + (long)u.pn * b_tile + (long)s * nts * 128; u.nt = nts; u.sub = s; return true; }
};

DI float row_rs(const float* rsv, int row, int) { return rsv[row]; }
#ifndef NT_STORES
#define NT_STORES 0
#endif
template <class T> DI void st_stream(T* p, const T v) { if (NT_STORES) __builtin_nontemporal_store(v, p); else *p = v; }
DI u32x4 pack8(const f32x4 v0, const f32x4 v1) { u32x4 w; w.x = cvt_pk_bf16(v0[0], v0[1]); w.y = cvt_pk_bf16(v0[2], v0[3]); w.z = cvt_pk_bf16(v1[0], v1[1]); w.w = cvt_pk_bf16(v1[2], v1[3]); return w; }

struct EpiRgIn {
    static constexpr bool PERM = true;
    bf16_t* ygate; bf16_t* yrec; const float* ss;
    DI void operator()(const f32x4 (&acc)[2][2][4][2], const pg8::Unit& u, int, int wr, int wc, int fr, int fq) const {
        const bool isg = u.pn < 8; bf16_t* base = isg ? ygate : yrec; const int colt = (isg ? u.pn : u.pn - 8) * 256;
        const int row0 = u.pm * 256 + wr * 64 + fr, col0 = colt + wc * 32 + 8 * fq;
        float rs8[2][4];
#pragma unroll
        for (int ai = 0; ai < 2; ++ai)
#pragma unroll
            for (int m = 0; m < 4; ++m) rs8[ai][m] = row_rs(ss, row0 + ai * 128 + m * 16, fq);
#pragma unroll
        for (int ai = 0; ai < 2; ++ai)
#pragma unroll
            for (int m = 0; m < 4; ++m) { bf16_t* rowp = base + (size_t)(row0 + ai * 128 + m * 16) * D + col0; const float rs = rs8[ai][m];
#pragma unroll
                for (int bj = 0; bj < 2; ++bj) { f32x4 v0 = acc[ai][bj][m][0] * rs, v1 = acc[ai][bj][m][1] * rs;
                    if (isg) {
#pragma unroll
                        for (int j = 0; j < 4; ++j) { v0[j] = gelu_tanh_(v0[j]); v1[j] = gelu_tanh_(v1[j]); } }
                    st_stream((u32x4*)(rowp + bj * 128), pack8(v0, v1)); } }
    }
};
struct EpiPlainBf16 {
    static constexpr bool PERM = true;
    bf16_t* O; int ldc; const float* ss;
    DI void operator()(const f32x4 (&acc)[2][2][4][2], const pg8::Unit& u, int, int wr, int wc, int fr, int fq) const {
        const int row0 = u.pm * 256 + wr * 64 + fr, col0 = u.pn * 256 + wc * 32 + 8 * fq;
        float rs8[2][4];
#pragma unroll
        for (int ai = 0; ai < 2; ++ai)
#pragma unroll
            for (int m = 0; m < 4; ++m) rs8[ai][m] = row_rs(ss, row0 + ai * 128 + m * 16, fq);
#pragma unroll
        for (int ai = 0; ai < 2; ++ai)
#pragma unroll
            for (int m = 0; m < 4; ++m) { bf16_t* rowp = O + (size_t)(row0 + ai * 128 + m * 16) * ldc + col0; const float rs = rs8[ai][m];
#pragma unroll
                for (int bj = 0; bj < 2; ++bj) st_stream((u32x4*)(rowp + bj * 128), pack8(acc[ai][bj][m][0] * rs, acc[ai][bj][m][1] * rs)); }
    }
};
struct EpiGdnProj {
    static constexpr bool PERM = true;
    bf16_t* qkv; bf16_t* z; float* bg; const float* a_log; const float* dt_bias; bf16_t* halo; const float* ss;
    DI void operator()(const f32x4 (&acc)[2][2][4][2], const pg8::Unit& u, int, int wr, int wc, int fr, int fq) const {
        const int row0 = u.pm * 256 + wr * 64 + fr;
        float rs8[2][4];
#pragma unroll
        for (int ai = 0; ai < 2; ++ai)
#pragma unroll
            for (int m = 0; m < 4; ++m) rs8[ai][m] = row_rs(ss, row0 + ai * 128 + m * 16, fq);
        if (u.pn < 24) {
            bf16_t* base; int ldc, colt; if (u.pn < 16) { base = qkv; ldc = 4096; colt = u.pn * 256; } else { base = z; ldc = 2048; colt = (u.pn - 16) * 256; }
            const int col0 = colt + wc * 32 + 8 * fq;
#pragma unroll
            for (int ai = 0; ai < 2; ++ai)
#pragma unroll
                for (int m = 0; m < 4; ++m) { const int row = row0 + ai * 128 + m * 16; bf16_t* rowp = base + (size_t)row * ldc + col0;
                    const int r64 = row & 63, rb = row >> 6;
                    bf16_t* hp = nullptr;
                    if (u.pn < 16) { if (r64 == 63) hp = halo + ((size_t)(rb + 1) * 3 + 0) * 4096 + col0; else if (r64 == 0 && rb > 0) hp = halo + ((size_t)(rb - 1) * 3 + 1) * 4096 + col0; else if (r64 == 1 && rb > 0) hp = halo + ((size_t)(rb - 1) * 3 + 2) * 4096 + col0; }
                    const float rs = rs8[ai][m];
#pragma unroll
                    for (int bj = 0; bj < 2; ++bj) { const u32x4 w = pack8(acc[ai][bj][m][0] * rs, acc[ai][bj][m][1] * rs); st_stream((u32x4*)(rowp + bj * 128), w); if (hp) *(u32x4*)(hp + bj * 128) = w; } }
        } else {
            const int c0 = wc * 32 + 8 * fq;
            float al[8], db[8];
#pragma unroll
            for (int j = 0; j < 8; ++j) { const int c = c0 + j; al[j] = c >= 64 ? __expf(a_log[c - 64]) : 0.f; db[j] = c >= 64 ? dt_bias[c - 64] : 0.f; }
#pragma unroll
            for (int ai = 0; ai < 2; ++ai)
#pragma unroll
                for (int m = 0; m < 4; ++m) { float* rowp = bg + (size_t)(row0 + ai * 128 + m * 16) * 128 + c0; const float rs = rs8[ai][m];
                    f32x4 o[2];
#pragma unroll
                    for (int n = 0; n < 2; ++n)
#pragma unroll
                        for (int j = 0; j < 4; ++j) { const float x = acc[ai][0][m][n][j] * rs; const int jj = n * 4 + j;
                            o[n][j] = (c0 >= 64) ? -al[jj] * softplusf_(x + db[jj]) : sigmoidf_(x); }
                    *(f32x4*)(rowp) = o[0]; *(f32x4*)(rowp + 4) = o[1]; }
        }
    }
};
struct EpiResAdd {
    static constexpr bool PERM = true;
    const bf16_t* xin; bf16_t* xn; float* ss; float* slab;
    DI void operator()(const f32x4 (&acc)[2][2][4][2], const pg8::Unit& u, int, int wr, int wc, int fr, int fq) const {
        const int row0 = u.pm * 256 + wr * 64 + fr, col0 = u.pn * 256 + wc * 32 + 8 * fq;
        if (u.sub >= 0) {
#pragma unroll
            for (int ai = 0; ai < 2; ++ai)
#pragma unroll
                for (int m = 0; m < 4; ++m) { float* sp = slab + ((size_t)u.sub * 512 + (row0 + ai * 128 + m * 16 - RES_ROW0)) * D + col0;
#pragma unroll
                    for (int bj = 0; bj < 2; ++bj) { *(f32x4*)(sp + bj * 128) = acc[ai][bj][m][0]; *(f32x4*)(sp + bj * 128 + 4) = acc[ai][bj][m][1]; } }
            return; }
        const int l_ = lane_id(); const unsigned voff = (unsigned)((l_ & 15) * D + 8 * (l_ >> 4)) * 2u;
        const char* xi_u = (const char*)xin + ((size_t)(u.pm * 256 + wr * 64) * D + u.pn * 256 + wc * 32) * 2;
        char* xn_u = (char*)xn + ((size_t)(u.pm * 256 + wr * 64) * D + u.pn * 256 + wc * 32) * 2;
        u32x4 v[2][4][2];
#pragma unroll
        for (int ai = 0; ai < 2; ++ai)
#pragma unroll
            for (int m = 0; m < 4; ++m)
#pragma unroll
                for (int bj = 0; bj < 2; ++bj) v[ai][m][bj] = *(const u32x4*)(xi_u + (size_t)(ai * 128 + m * 16) * (D * 2) + bj * 256 + voff);
#pragma unroll
        for (int ai = 0; ai < 2; ++ai) {
#pragma unroll
            for (int m = 0; m < 4; ++m) { const int row = row0 + ai * 128 + m * 16; char* rowp = xn_u + (size_t)(ai * 128 + m * 16) * (D * 2);
                float sq = 0.f;
#pragma unroll
                for (int bj = 0; bj < 2; ++bj) { const u32x4 vv = v[ai][m][bj];
                    const f32x4 h0 = (f32x4){bf_lo(vv.x), bf_hi(vv.x), bf_lo(vv.y), bf_hi(vv.y)} + acc[ai][bj][m][0], h1 = (f32x4){bf_lo(vv.z), bf_hi(vv.z), bf_lo(vv.w), bf_hi(vv.w)} + acc[ai][bj][m][1];
                    const u32x4 w = pack8(h0, h1); *(u32x4*)(rowp + bj * 256 + voff) = w;
                    if (ss) { const float r0 = bf_lo(w.x), r1 = bf_hi(w.x), r2 = bf_lo(w.y), r3 = bf_hi(w.y), r4 = bf_lo(w.z), r5 = bf_hi(w.z), r6 = bf_lo(w.w), r7 = bf_hi(w.w);
                        sq += ((r0 * r0 + r1 * r1) + (r2 * r2 + r3 * r3)) + ((r4 * r4 + r5 * r5) + (r6 * r6 + r7 * r7)); } }
                if (ss) { sq += __shfl_xor(sq, 16); sq += __shfl_xor(sq, 32); if (fq == 0) ss[((size_t)u.pm * 32 + u.pn * 4 + wc) * 256 + (row & 255)] = sq; } }
        }
    }
};
#ifndef GATES_TOP
#define GATES_TOP 4
#endif
struct EpiGates {
    static constexpr bool PERM = true;
    const bf16_t* xc; bf16_t* la; bf16_t* uu;
    size_t dstride; const float* b_a; const float* b_i; const float* lam;
    LAS float* cl;
    DI void operator()(const f32x4 (&acc)[2][2][4][2], const pg8::Unit& u, int, int wr, int wc, int fr, int fq) const {
        const int dir = u.pn >> 4, blk = (u.pn >> 1) & 7, hh = u.pn & 1;
        const int row0 = u.pm * 256 + wr * 64 + fr, c0 = blk * 256 + hh * 128 + wc * 32 + 8 * fq;
        LAS float* cw_ = cl + (wr * 4 + wc) * 96;
        { const int lane = lane_id(); if (lane < 32) { const int c = dir * D + blk * 256 + hh * 128 + wc * 32 + lane;
            cw_[lane] = b_a[c]; cw_[32 + lane] = b_i[c]; cw_[64 + lane] = -8.0f * softplus_lite(-lam[c]); } }
        const int l_ = lane_id(); const unsigned voff = (unsigned)((l_ & 15) * D + 8 * (l_ >> 4)) * 2u;
        const size_t uoff = ((size_t)(u.pm * 256 + wr * 64) * D + blk * 256 + hh * 128 + wc * 32) * 2;
        const char* xc_u = (const char*)xc + uoff; char* la_u = (char*)(la + dir * dstride) + uoff; char* uu_u = (char*)(uu + dir * dstride) + uoff;
        u32x4 xw4[2][4];
#pragma unroll
        for (int g = 0; g < GATES_TOP; ++g) xw4[g >> 2][g & 3] = *(const u32x4*)(xc_u + (size_t)((g >> 2) * 128 + (g & 3) * 16) * (D * 2) + voff);
#pragma unroll
        for (int ai = 0; ai < 2; ++ai) {
#pragma unroll
            for (int m = 0; m < 4; ++m) { const size_t off = (size_t)(ai * 128 + m * 16) * (D * 2);
                const u32x4 xw = xw4[ai][m];
                float xv[8]; xv[0] = bf_lo(xw.x); xv[1] = bf_hi(xw.x); xv[2] = bf_lo(xw.y); xv[3] = bf_hi(xw.y); xv[4] = bf_lo(xw.z); xv[5] = bf_hi(xw.z); xv[6] = bf_lo(xw.w); xv[7] = bf_hi(xw.w);
                f32x4 lo[2], uo[2];
#pragma unroll
                for (int n = 0; n < 2; ++n) { LAS float* cp = cw_ + 8 * fq; asm volatile("" : "+v"(cp));
                    const f32x4 ba = *(const LAS f32x4*)(cp + 4 * n), bi = *(const LAS f32x4*)(cp + 32 + 4 * n), sp = *(const LAS f32x4*)(cp + 64 + 4 * n);
#pragma unroll
                    for (int j = 0; j < 4; ++j) { const int jj = n * 4 + j;
                        const float r = sigmoidf_(acc[ai][0][m][n][j] + ba[j]), ig = sigmoidf_(acc[ai][1][m][n][j] + bi[j]);
                        const float l = sp[j] * r;
                        lo[n][j] = l; const float x2 = 2.0f * l;
                        const float om_e = 1.0f - __expf(x2), om_s = -x2 * (1.0f + 0.5f * x2);
                        const float om = x2 > -0.0009765625f ? om_s : om_e;
                        uo[n][j] = __builtin_amdgcn_sqrtf(fmaxf(om, 0.f)) * (ig * xv[jj]); }
                    __builtin_amdgcn_sched_barrier(0); }
                *(u32x4*)(la_u + off + voff) = pack8(lo[0], lo[1]);
                *(u32x4*)(uu_u + off + voff) = pack8(uo[0], uo[1]);
                __builtin_amdgcn_sched_barrier(0);
                if (ai == 0 && m == 0) {
#pragma unroll
                    for (int g = GATES_TOP; g < 8; ++g) xw4[g >> 2][g & 3] = *(const u32x4*)(xc_u + (size_t)((g >> 2) * 128 + (g & 3) * 16) * (D * 2) + voff);
                    __builtin_amdgcn_sched_barrier(0); } }
        }
    }
};
struct EpiFfnUp {
    static constexpr bool PERM = true;
    bf16_t* act; const float* cw; const float* cb; LAS float* edge; const float* ss; const unsigned char* rflag;
    DI void operator()(f32x4 (&acc)[2][2][4][2], const pg8::Unit& u, int ui, int wr, int wc, int fr, int fq) const {
        const int lane = fq * 16 + fr;
        LAS float* ef = edge + (ui & 1) * 1024, * el = ef + 512;
        LAS float* tapl = edge + 2048 + (wr * 4 + wc) * 128;
        const int cg0 = wc * 32 + 8 * fq;
        float rs8[2][4]; unsigned flp[2] = {0u, 0u};
#pragma unroll
        for (int ai = 0; ai < 2; ++ai)
#pragma unroll
            for (int m = 0; m < 4; ++m) { const int r = 128 * ai + 64 * wr + 16 * m + fr; const int R = 254 * u.pm - 1 + r; const int Rc = R < 0 ? 0 : R;
                rs8[ai][m] = row_rs(ss, Rc, fq); flp[ai] |= ((__float_as_uint(rs8[ai][m]) & 3u) | ((r >= 1 && r <= 254 && R < MTOK) ? 4u : 0u)) << (8 * m); }
        if (lane < 32) { const int a = lane >> 3, c = lane & 7; const float* src = (a < 3 ? cw + (size_t)a * DFF : cb) + u.pn * 128 + wc * 32 + 4 * c;
            *(LAS f32x4*)(tapl + a * 32 + 4 * c) = *(const f32x4*)src; }
#pragma unroll
        for (int ai = 0; ai < 2; ++ai)
#pragma unroll
            for (int m = 0; m < 4; ++m)
#pragma unroll
                for (int bj = 0; bj < 2; ++bj)
#pragma unroll
                    for (int n = 0; n < 2; ++n) acc[ai][bj][m][n] = acc[ai][bj][m][n] * rs8[ai][m];
        __builtin_amdgcn_sched_barrier(0);
#pragma unroll
        for (int ai = 0; ai < 2; ++ai) { const int sg = 2 * ai + wr;
            if (fr == 0) { *(LAS f32x4*)(ef + sg * 128 + cg0) = acc[ai][0][0][0]; *(LAS f32x4*)(ef + sg * 128 + cg0 + 4) = acc[ai][0][0][1]; }
            if (fr == 15) { *(LAS f32x4*)(el + sg * 128 + cg0) = acc[ai][0][3][0]; *(LAS f32x4*)(el + sg * 128 + cg0 + 4) = acc[ai][0][3][1]; } }
        asm volatile("s_waitcnt lgkmcnt(0)" ::: "memory"); __builtin_amdgcn_s_barrier(); asm volatile("" ::: "memory");
        const int cf0 = u.pn * 128 + cg0;
#ifdef FFU_EPI_REP
        int reps_ = FFU_EPI_REP; asm volatile("" : "+s"(reps_));
        for (int rep_ = 0; rep_ < reps_; ++rep_)
#endif
#pragma unroll
        for (int ai = 0; ai < 2; ++ai) { const int sg = 2 * ai + wr;
#pragma unroll
            for (int n = 0; n < 2; ++n) {
                const f32x4 w0 = *(const LAS f32x4*)(tapl + 8 * fq + 4 * n), w1 = *(const LAS f32x4*)(tapl + 32 + 8 * fq + 4 * n), w2 = *(const LAS f32x4*)(tapl + 64 + 8 * fq + 4 * n), bb = *(const LAS f32x4*)(tapl + 96 + 8 * fq + 4 * n);
                const f32x4 htop = sg > 0 ? *(LAS f32x4*)(el + (sg - 1) * 128 + cg0 + 4 * n) : (f32x4){0.f, 0.f, 0.f, 0.f};
                const f32x4 hbot = sg < 3 ? *(LAS f32x4*)(ef + (sg + 1) * 128 + cg0 + 4 * n) : (f32x4){0.f, 0.f, 0.f, 0.f};
                unsigned pk[4][2];
#pragma unroll
                for (int jp = 0; jp < 2; ++jp) {
                    float rr[2][4];
#pragma unroll
                    for (int j2 = 0; j2 < 2; ++j2) { const int j = 2 * jp + j2;
                        float v[4], upv[4], dnv[4];
#pragma unroll
                        for (int m = 0; m < 4; ++m) { v[m] = acc[ai][0][m][n][j];
                            upv[m] = __int_as_float(__builtin_amdgcn_update_dpp(0, __float_as_int(v[m]), 0x121, 0xf, 0xf, false));
                            dnv[m] = __int_as_float(__builtin_amdgcn_update_dpp(0, __float_as_int(v[m]), 0x12F, 0xf, 0xf, false)); }
#pragma unroll
                        for (int m = 0; m < 4; ++m) {
                            float pv = fr > 0 ? upv[m] : (m > 0 ? upv[m > 0 ? m - 1 : 0] : htop[j]);
                            float nv = fr < 15 ? dnv[m] : (m < 3 ? dnv[m < 3 ? m + 1 : 3] : hbot[j]);
                            pv = (flp[ai] & (1u << (8 * m))) ? 0.f : pv; nv = (flp[ai] & (2u << (8 * m))) ? 0.f : nv;
                            const float a = w0[j] * pv + w1[j] * v[m] + w2[j] * nv + bb[j];
                            rr[j2][m] = siluf_(a) * acc[ai][1][m][n][j]; } }
#pragma unroll
                    for (int m = 0; m < 4; ++m) pk[m][jp] = cvt_pk_bf16(rr[0][m], rr[1][m]);
                    __builtin_amdgcn_sched_barrier(0);
                }
#pragma unroll
                for (int m = 0; m < 4; ++m) if (flp[ai] & (4u << (8 * m))) { u32x2 w; w.x = pk[m][0]; w.y = pk[m][1];
                    st_stream((u32x2*)(act + (size_t)(254 * u.pm - 1 + 128 * ai + 64 * wr + 16 * m + fr) * DFF + cf0 + 4 * n), w); }
                __builtin_amdgcn_sched_barrier(0);
            }
        }
    }
};
#define LDS_WAIT() asm volatile("s_waitcnt lgkmcnt(0)" ::: "memory")
DI void cvt_item(const float* W, int ldw, int col0, bf16_t* WT, int ldt, int k0, int n0, LAS float* scr, int lane, const float* gain = nullptr) {
    { float w[32]; const float* wp = W + (size_t)(k0 + (lane >> 5)) * ldw + col0 + n0 + (lane & 31);
#pragma unroll
        for (int i = 0; i < 32; ++i) w[i] = wp[(size_t)(2 * i) * ldw];
        if (gain) {
#pragma unroll
            for (int i = 0; i < 32; ++i) w[i] *= gain[k0 + 2 * i + (lane >> 5)]; }
#pragma unroll
        for (int i = 0; i < 32; ++i) scr[(2 * i + (lane >> 5)) * 33 + (lane & 31)] = w[i]; }
    LDS_WAIT(); asm volatile("" ::: "memory");
    const int c = lane & 7;
#pragma unroll
    for (int j = 0; j < 4; ++j) { const int n = (lane >> 3) + 8 * j; const LAS float* s = scr + (8 * c) * 33 + n;
        u32x4 o; o.x = cvt_pk_bf16(s[0 * 33], s[1 * 33]); o.y = cvt_pk_bf16(s[2 * 33], s[3 * 33]); o.z = cvt_pk_bf16(s[4 * 33], s[5 * 33]); o.w = cvt_pk_bf16(s[6 * 33], s[7 * 33]);
        *(u32x4*)(WT + (size_t)(n0 + n) * ldt + k0 + 8 * c) = o; }
    LDS_WAIT(); asm volatile("" ::: "memory");
}
struct CvtCursor { int cur, base, step; };
DI void cvt_job(CvtCursor& cc, const float* W, int ldw, int col0, int ncols, int K, bf16_t* WT, int ldt, LAS float* scr, int lane, const float* gain = nullptr) {
    const int nb = ncols / 32, n = (K / 64) * nb;
    while (cc.cur < cc.base + n) { const int it = cc.cur - cc.base; cvt_item(W, ldw, col0, WT, ldt, 64 * (it / nb), 32 * (it % nb), scr, lane, gain); cc.cur += cc.step; }
    cc.base += n;
}
DI void cvt_ffn(Frame& F, CvtCursor& cc, int li, LAS float* scr) {
    bf16_t* wg = (bf16_t*)F.WFFN(); bf16_t* wu = wg + (size_t)DFF * D; bf16_t* wd = wu + (size_t)DFF * D;
    cvt_job(cc, F.I(25) + (size_t)li * D * DFF, DFF, 0, DFF, D, wg, D, scr, F.lane(), F.I(4) + (size_t)li * D);
    cvt_job(cc, F.I(26) + (size_t)li * D * DFF, DFF, 0, DFF, D, wu, D, scr, F.lane(), F.I(4) + (size_t)li * D);
    cvt_job(cc, F.I(29) + (size_t)li * DFF * D, D, 0, D, DFF, wd, DFF, scr, F.lane());
}
DI void cvt_rg(Frame& F, CvtCursor& cc, int j, int li, LAS float* scr) {
    bf16_t* win = (bf16_t*)F.WMIX(); bf16_t* gates = win + (size_t)4096 * D; bf16_t* wout = gates + (size_t)32 * 65536;
    cvt_job(cc, F.I(6) + (size_t)j * D * 4096, 4096, 0, 4096, D, win, D, scr, F.lane(), F.I(3) + (size_t)li * D);
    {
        const int n = 32 * 32;
        while (cc.cur < cc.base + n) { const int it = cc.cur - cc.base; const int bid = it >> 5, sub = it & 31; const int gate = bid >> 4, dir = (bid >> 3) & 1, blk = bid & 7;
            const float* src = F.I(gate ? 11 : 9) + (size_t)((j * 2 + dir) * 8 + blk) * 65536;
            cvt_item(src, 256, 0, gates + (size_t)((dir * 2 + gate) * 8 + blk) * 65536, 256, 64 * (sub >> 3), 32 * (sub & 7), scr, F.lane()); cc.cur += cc.step; }
        cc.base += n; }
    cvt_job(cc, F.I(14) + (size_t)j * D * D, D, 0, D, D, wout, D, scr, F.lane());
}
DI void cvt_na(Frame& F, CvtCursor& cc, LAS float* scr) {
    bf16_t* wqkv = (bf16_t*)F.WMIX(); bf16_t* wo = wqkv + (size_t)6144 * D;
    cvt_job(cc, F.I(15), 6144, 0, 6144, D, wqkv, D, scr, F.lane(), F.I(3) + (size_t)1 * D);
    cvt_job(cc, F.I(18), D, 0, D, D, wo, D, scr, F.lane());
}
DI void cvt_gdn(Frame& F, CvtCursor& cc, LAS float* scr) {
    bf16_t* w0 = (bf16_t*)F.WMIX(); bf16_t* w1 = w0 + (size_t)6400 * D; bf16_t* wout = w1 + (size_t)6144 * D;
    const float* W = F.I(19);
    for (int g = 0; g < 2; ++g) { bf16_t* w = g ? w1 : w0;
        cvt_job(cc, W, 12416, g * 1024, 1024, D, w, D, scr, F.lane(), F.I(3) + (size_t)2 * D);
        cvt_job(cc, W, 12416, 2048 + g * 1024, 1024, D, w + (size_t)1024 * D, D, scr, F.lane(), F.I(3) + (size_t)2 * D);
        cvt_job(cc, W, 12416, 4096 + g * 2048, 2048, D, w + (size_t)2048 * D, D, scr, F.lane(), F.I(3) + (size_t)2 * D);
        cvt_job(cc, W, 12416, 8192 + g * 2048, 2048, D, w + (size_t)4096 * D, D, scr, F.lane(), F.I(3) + (size_t)2 * D); }
    cvt_job(cc, W, 12416, 12288, 128, D, w0 + (size_t)6144 * D, D, scr, F.lane(), F.I(3) + (size_t)2 * D);
    cvt_job(cc, F.I(24), D, 0, D, 4096, wout, 4096, scr, F.lane());
}

DI float rs_tag(int R, float rs) { int b, t; row_bt(R, b, t); const unsigned f = (t == 0 ? 1u : 0u) | ((b < NSEQ && t == seq_len(b) - 1) ? 2u : 0u); return __uint_as_float((__float_as_uint(rs) & ~3u) | f); }
template <int MODE> DI void norm_phase(Frame& F, bf16_t* X, const float* gain, float* rsv, const bf16_t* xin2 = nullptr, const float* slab = nullptr) {
    const int gw = F.bid * 8 + F.wave, NGW = F.G * 8, lane = F.lane();
    if (MODE == 1) {
        for (int i = F.bid * 512 + F.tid(); i < (MP - MTOK + 1) * (D / 8); i += F.G * 512) { const int r = i / (D / 8), c = i % (D / 8); const int R = r == 0 ? -1 : MTOK + r - 1;
            *(u32x4*)(X + (long)R * D + c * 8) = (u32x4){0u, 0u, 0u, 0u}; }
        for (int i = F.bid * 512 + F.tid(); i < MP - MTOK; i += F.G * 512) rsv[MTOK + i] = 0.f;
    }
    for (int R = gw; R < MTOK; R += NGW) {
        int b, t; row_bt(R, b, t);
        bf16_t* xr = X + (size_t)R * D;
        if (MODE == 2 && t < NMETA) continue;
        f32x4 v[8]; float s = 0.f;
        if (MODE == 1) {
            const float* src; if (t < NMETA) src = F.I(2) + (size_t)t * D; else if (b < NPROMPT) src = F.I(0) + ((size_t)b * LP + (t - NMETA)) * D; else src = F.I(1) + ((size_t)(b - NPROMPT) * LS + (t - NMETA)) * D;
#pragma unroll
            for (int j = 0; j < 8; ++j) { const f32x4 x = *(const f32x4*)(src + 4 * (lane + 64 * j)); u32x2 w; w.x = cvt_pk_bf16(x[0], x[1]); w.y = cvt_pk_bf16(x[2], x[3]); *(u32x2*)(xr + 4 * (lane + 64 * j)) = w;
                v[j] = (f32x4){bf_lo(w.x), bf_hi(w.x), bf_lo(w.y), bf_hi(w.y)}; }
        } else {
#pragma unroll
            for (int j = 0; j < 8; ++j) { const u32x2 w = *(const u32x2*)((R >= RES_ROW0 && xin2 ? xin2 + (size_t)R * D : xr) + 4 * (lane + 64 * j)); v[j] = (f32x4){bf_lo(w.x), bf_hi(w.x), bf_lo(w.y), bf_hi(w.y)}; }
            if (R >= RES_ROW0 && slab) {
#pragma unroll
                for (int s = 0; s < RES_NSPLIT; ++s)
#pragma unroll
                    for (int j = 0; j < 8; ++j) v[j] += *(const f32x4*)(slab + ((size_t)s * 512 + (R - RES_ROW0)) * D + 4 * (lane + 64 * j));
#pragma unroll
                for (int j = 0; j < 8; ++j) { const unsigned w0 = cvt_pk_bf16(v[j][0], v[j][1]), w1 = cvt_pk_bf16(v[j][2], v[j][3]); v[j] = (f32x4){bf_lo(w0), bf_hi(w0), bf_lo(w1), bf_hi(w1)}; } }
        }
#pragma unroll
        for (int j = 0; j < 8; ++j) s += (v[j][0] * v[j][0] + v[j][1] * v[j][1]) + (v[j][2] * v[j][2] + v[j][3] * v[j][3]);
        const float rs = 1.0f / sqrtf(wave_sum(s) * (1.0f / D) + NORM_EPS);
        if (MODE == 1) { if (lane == 0) rsv[R] = rs_tag(R, rs); }
        else {
            float* orow = F.out + (b < NPROMPT ? ((size_t)b * LP + (t - NMETA)) : ((size_t)NPROMPT * LP + (size_t)(b - NPROMPT) * LS + (t - NMETA))) * D;
#pragma unroll
            for (int j = 0; j < 8; ++j) { const f32x4 gv = *(const f32x4*)(gain + 4 * (lane + 64 * j)); *(f32x4*)(orow + 4 * (lane + 64 * j)) = v[j] * rs * gv; }
        }
    }
}
DI void ss_final_phase(Frame& F, const float* ssp, float* rsv, const bf16_t* xin, bf16_t* xout, const float* slab0, const float* slab1) {
    for (int R = F.bid * 512 + F.tid(); R < RES_ROW0; R += F.G * 512) { const float* p = ssp + (size_t)(R >> 8) * 32 * 256 + (R & 255); float s = 0.f;
#pragma unroll
        for (int i = 0; i < 8; ++i) s += (p[(4 * i) * 256] + p[(4 * i + 1) * 256]) + (p[(4 * i + 2) * 256] + p[(4 * i + 3) * 256]);
        rsv[R] = rs_tag(R, 1.0f / sqrtf(s * (1.0f / D) + NORM_EPS)); }
    const int lane = F.lane();
    for (int R = RES_ROW0 + F.bid * 8 + F.wave; R < MP; R += F.G * 8) {
        float v[32];
#pragma unroll
        for (int i = 0; i < 4; ++i) { const u32x4 x = *(const u32x4*)(xin + (size_t)R * D + lane * 32 + 8 * i); const unsigned w[4] = {x.x, x.y, x.z, x.w};
#pragma unroll
            for (int k = 0; k < 4; ++k) { v[8 * i + 2 * k] = bf_lo(w[k]); v[8 * i + 2 * k + 1] = bf_hi(w[k]); } }
#pragma unroll
        for (int set = 0; set < 2; ++set) { const float* sl = set ? slab1 : slab0; if (!sl) continue;
#pragma unroll
            for (int s = 0; s < RES_NSPLIT; ++s) { const float* p = sl + ((size_t)s * 512 + (R - RES_ROW0)) * D + lane * 32;
#pragma unroll
                for (int i = 0; i < 8; ++i) { const f32x4 a = *(const f32x4*)(p + 4 * i); v[4 * i] += a[0]; v[4 * i + 1] += a[1]; v[4 * i + 2] += a[2]; v[4 * i + 3] += a[3]; } } }
        float sq = 0.f;
#pragma unroll
        for (int i = 0; i < 4; ++i) { u32x4 w; unsigned ww[4];
#pragma unroll
            for (int k = 0; k < 4; ++k) { ww[k] = cvt_pk_bf16(v[8 * i + 2 * k], v[8 * i + 2 * k + 1]); const float a = bf_lo(ww[k]), b = bf_hi(ww[k]); sq += a * a + b * b; }
            w.x = ww[0]; w.y = ww[1]; w.z = ww[2]; w.w = ww[3]; *(u32x4*)(xout + (size_t)R * D + lane * 32 + 8 * i) = w; }
        const float tot = wave_sum(sq);
        if (lane == 0) rsv[R] = rs_tag(R, 1.0f / sqrtf(tot * (1.0f / D) + NORM_EPS));
    }
}
DI void fill_rflag(Frame& F, unsigned char* rf) { for (int R = F.bid * 512 + F.tid(); R < MP; R += F.G * 512) { int b, t; row_bt(R, b, t); rf[R] = (unsigned char)((t == 0 ? 1 : 0) | ((b < NSEQ && t == seq_len(b) - 1) ? 2 : 0)); } }

DI void rg_conv_phase(Frame& F, const bf16_t* yrec, bf16_t* xc, const float* cw, const float* cb) {
    const int tid = F.tid(), cg = tid & 255, c0 = cg * 8;
    float w[4][8], bb[8];
#pragma unroll
    for (int j = 0; j < 4; ++j)
#pragma unroll
        for (int e = 0; e < 8; ++e) w[j][e] = cw[j * D + c0 + e];
#pragma unroll
    for (int e = 0; e < 8; ++e) bb[e] = cb[c0 + e];
    for (int s = F.bid * 2 + (tid >> 8); s < MTOK / 16; s += F.G * 2) {
        const int R0 = 16 * s; int b, t0; row_bt(R0, b, t0); const int T = seq_len(b);
        const bf16_t* yp = yrec + (size_t)R0 * D + c0;
        u32x4 x0 = (u32x4){0u, 0u, 0u, 0u}, x1, x2, x3;
        if (t0 > 0) x0 = *(const u32x4*)(yp - D);
        x1 = *(const u32x4*)(yp); x2 = *(const u32x4*)(yp + D); x3 = *(const u32x4*)(yp + 2 * D);
#pragma unroll
        for (int i = 0; i < 16; ++i) {
            u32x4 xn = (u32x4){0u, 0u, 0u, 0u};
            if (i < 15 && t0 + i + 3 < T) xn = *(const u32x4*)(yp + (size_t)(i + 3) * D);
            float a[8];
#pragma unroll
            for (int e = 0; e < 8; ++e) a[e] = bb[e];
            const u32x4 xs[4] = {x0, x1, x2, x3};
#pragma unroll
            for (int j = 0; j < 4; ++j) { const u32x4 x = xs[j];
                a[0] += w[j][0] * bf_lo(x.x); a[1] += w[j][1] * bf_hi(x.x); a[2] += w[j][2] * bf_lo(x.y); a[3] += w[j][3] * bf_hi(x.y);
                a[4] += w[j][4] * bf_lo(x.z); a[5] += w[j][5] * bf_hi(x.z); a[6] += w[j][6] * bf_lo(x.w); a[7] += w[j][7] * bf_hi(x.w); }
            u32x4 o; o.x = cvt_pk_bf16(a[0], a[1]); o.y = cvt_pk_bf16(a[2], a[3]); o.z = cvt_pk_bf16(a[4], a[5]); o.w = cvt_pk_bf16(a[6], a[7]);
            *(u32x4*)(xc + (size_t)(R0 + i) * D + c0) = o;
            x0 = x1; x1 = x2; x2 = x3; x3 = xn;
        }
    }
}

template <int N, bool REV> DI void rg_ld(const bf16_t* p, size_t base, int t0, unsigned (&w)[8]) {
#pragma unroll
    for (int i = 0; i < 8; ++i) if (i < N) w[i] = *(const unsigned*)(p + base + (size_t)(REV ? t0 - i : t0 + i) * D);
}
struct ScanBuf { unsigned lf[8], uf[8], lb[8], ub[8]; };
DI void scan_fetch(ScanBuf& B, int cn, int NC, int seg, int l32, const bf16_t* laf, const bf16_t* uf, const bf16_t* lab, const bf16_t* ub, size_t ubase) {
#pragma unroll
    for (int i = 0; i < 8; ++i) { B.lf[i] = 0u; B.uf[i] = 0u; B.lb[i] = 0u; B.ub[i] = 0u; }
    if (cn < NC) { const unsigned vo = (unsigned)(8 * seg * D + 2 * l32) * 2u; const size_t ro = (ubase + (size_t)(128 * cn) * D) * 2;
#pragma unroll
        for (int i = 0; i < 8; ++i) { const size_t o = ro + (size_t)i * (D * 2);
            B.lf[i] = *(const unsigned*)((const char*)laf + o + vo); B.uf[i] = *(const unsigned*)((const char*)uf + o + vo); B.lb[i] = *(const unsigned*)((const char*)lab + o + vo);
            B.ub[i] = *(const unsigned*)((const char*)ub + o + vo); } }
    else if (cn == NC) { const unsigned vo = (unsigned)(seg * D + 2 * l32) * 2u; const size_t o = (ubase + (size_t)(128 * NC) * D) * 2;
        B.lf[0] = *(const unsigned*)((const char*)laf + o + vo); B.uf[0] = *(const unsigned*)((const char*)uf + o + vo); B.lb[0] = *(const unsigned*)((const char*)lab + o + vo);
        B.ub[0] = *(const unsigned*)((const char*)ub + o + vo); }
}
DI void scan_gate(unsigned (&g)[8], int c, int NC, int seg, int l32, const bf16_t* ygate, size_t ubase) {
#pragma unroll
    for (int i = 0; i < 8; ++i) g[i] = 0u;
    if (c < NC) { const unsigned vo = (unsigned)(8 * seg * D + 2 * l32) * 2u; const size_t ro = (ubase + (size_t)(128 * c) * D) * 2;
#pragma unroll
        for (int i = 0; i < 8; ++i) g[i] = *(const unsigned*)((const char*)ygate + ro + (size_t)i * (D * 2) + vo); }
    else { const unsigned vo = (unsigned)(seg * D + 2 * l32) * 2u; g[0] = *(const unsigned*)((const char*)ygate + (ubase + (size_t)(128 * NC) * D) * 2 + vo); }
}
DI void scan_chunk(const ScanBuf& A, const unsigned (&Ag)[8], int c, int NC, int seg, int l32, LAS float* AGG, const LAS float* CB, float& CF0, float& CF1, bf16_t* ub, size_t ubase) {
    const bool tail = (c == NC);
    float slf0 = 0.f, slf1 = 0.f, hf0 = 0.f, hf1 = 0.f, slb0 = 0.f, slb1 = 0.f, hb0 = 0.f, hb1 = 0.f;
#pragma unroll
    for (int i = 0; i < 8; ++i) { const float a0 = bf_lo(A.lf[i]), a1 = bf_hi(A.lf[i]); slf0 += a0; slf1 += a1; hf0 = __expf(a0) * hf0 + bf_lo(A.uf[i]); hf1 = __expf(a1) * hf1 + bf_hi(A.uf[i]); }
#pragma unroll
    for (int i = 7; i >= 0; --i) { const float c0 = bf_lo(A.lb[i]), c1 = bf_hi(A.lb[i]); slb0 += c0; slb1 += c1; hb0 = __expf(c0) * hb0 + bf_lo(A.ub[i]); hb1 = __expf(c1) * hb1 + bf_hi(A.ub[i]); }
    __builtin_amdgcn_sched_barrier(0);
    LAS float* ag = AGG + (c & 1) * 4096;
    { LAS float* a = ag + seg * 256 + 2 * l32; *(LAS f32x2*)(a) = (f32x2){slf0, slf1}; *(LAS f32x2*)(a + 64) = (f32x2){hf0, hf1}; *(LAS f32x2*)(a + 128) = (f32x2){slb0, slb1}; *(LAS f32x2*)(a + 192) = (f32x2){hb0, hb1}; }
    __syncthreads();
    float cf0 = CF0, cf1 = CF1;
    for (int v = 0; v < seg; ++v) { const LAS float* a = ag + v * 256 + 2 * l32; const f32x2 sl = *(const LAS f32x2*)(a), hh = *(const LAS f32x2*)(a + 64); cf0 = hh[0] + __expf(sl[0]) * cf0; cf1 = hh[1] + __expf(sl[1]) * cf1; }
    { float e0 = cf0, e1 = cf1;
        for (int v = seg; v < 16; ++v) { const LAS float* a = ag + v * 256 + 2 * l32; const f32x2 sl = *(const LAS f32x2*)(a), hh = *(const LAS f32x2*)(a + 64); e0 = hh[0] + __expf(sl[0]) * e0; e1 = hh[1] + __expf(sl[1]) * e1; }
        CF0 = e0; CF1 = e1; }
    float cb0 = 0.f, cb1 = 0.f;
    if (!tail) { const f32x2 r = *(const LAS f32x2*)(CB + (c + 1) * 64 + 2 * l32); cb0 = r[0]; cb1 = r[1]; }
    for (int v = 15; v > seg; --v) { const LAS float* a = ag + v * 256 + 2 * l32; const f32x2 sl = *(const LAS f32x2*)(a + 128), hh = *(const LAS f32x2*)(a + 192); cb0 = hh[0] + __expf(sl[0]) * cb0; cb1 = hh[1] + __expf(sl[1]) * cb1; }
    float f0[8], f1[8];
#pragma unroll
    for (int i = 0; i < 8; ++i) { cf0 = __expf(bf_lo(A.lf[i])) * cf0 + bf_lo(A.uf[i]); cf1 = __expf(bf_hi(A.lf[i])) * cf1 + bf_hi(A.uf[i]); f0[i] = cf0; f1[i] = cf1; }
#pragma unroll
    for (int i = 7; i >= 0; --i) { cb0 = __expf(bf_lo(A.lb[i])) * cb0 + bf_lo(A.ub[i]); cb1 = __expf(bf_hi(A.lb[i])) * cb1 + bf_hi(A.ub[i]);
        f0[i] = bf_lo(Ag[i]) * (f0[i] + cb0); f1[i] = bf_hi(Ag[i]) * (f1[i] + cb1); }
    if (!tail) { const unsigned vo = (unsigned)(8 * seg * D + 2 * l32) * 2u; char* ro = (char*)ub + (ubase + (size_t)(128 * c) * D) * 2;
#pragma unroll
        for (int i = 0; i < 8; ++i) *(unsigned*)(ro + (size_t)i * (D * 2) + vo) = cvt_pk_bf16(f0[i], f1[i]);
    } else { const unsigned vo = (unsigned)(seg * D + 2 * l32) * 2u; *(unsigned*)((char*)ub + (ubase + (size_t)(128 * NC) * D) * 2 + vo) = cvt_pk_bf16(f0[0], f1[0]); }
}
DI void rg_scan_phase(Frame& F, const bf16_t* laf, const bf16_t* uf, const bf16_t* lab, bf16_t* ub, const bf16_t* ygate) {
    int tid_ = F.wave * 64 + lane_id(); asm volatile("" : "+v"(tid_));
    const int tid = tid_, lane = tid & 63, wave = __builtin_amdgcn_readfirstlane(tid >> 6), seg = 2 * wave + (lane >> 5), l32 = lane & 31;
    LAS float* AGG = (LAS float*)F.lds;
    LAS float* CB = AGG + 2 * 16 * 256;
    int items[3]; int ni = 0;
    if (F.G == 256) { if (F.bid < 128) { items[0] = F.bid; items[1] = 128 + F.bid; items[2] = 0; ni = 2; } else { const int b0 = 256 + 3 * (F.bid - 128); items[0] = b0; items[1] = b0 + 1; items[2] = b0 + 2; ni = 3; } }
    for (int ii = 0; ; ++ii) {
        int id;
        if (F.G == 256) { if (ii >= ni) break; id = ii == 0 ? items[0] : (ii == 1 ? items[1] : items[2]); } else { id = F.bid + ii * F.G; if (id >= 640) break; }
        const int b = id < 128 ? NPROMPT + (id >> 5) : ((id - 128) >> 5), cg = id & 31;
        const int T = seq_len(b), SL = T >> 4, NC = T >> 7, nb = NC >> 4;
        const size_t ubase = (size_t)seq_off(b) * D + cg * 64, base = ubase + l32 * 2;
        {
            const int s1 = seg * SL + SL - 1;
            float slb0 = 0.f, slb1 = 0.f, hb0 = 0.f, hb1 = 0.f, r1s0 = 0.f, r1s1 = 0.f, r1h0 = 0.f, r1h1 = 0.f, r2s0 = 0.f, r2s1 = 0.f, r2h0 = 0.f, r2h1 = 0.f;
            const int w1 = seg, w2 = 128 + seg;
            unsigned lb[8], ub_[8], lr[8], ur[8];
            rg_ld<1, true>(lab, base, s1 - (SL - 1), lr); rg_ld<1, true>(ub, base, s1 - (SL - 1), ur);
            rg_ld<8, true>(lab, base, s1, lb); rg_ld<8, true>(ub, base, s1, ub_);
            for (int i0 = 0; i0 + 8 <= SL; i0 += 8) {
                unsigned lbn[8], ubn[8];
#pragma unroll
                for (int i = 0; i < 8; ++i) { lbn[i] = 0u; ubn[i] = 0u; }
                if (i0 + 16 <= SL) { rg_ld<8, true>(lab, base, s1 - i0 - 8, lbn); rg_ld<8, true>(ub, base, s1 - i0 - 8, ubn); }
#pragma unroll
                for (int i = 0; i < 8; ++i) { const float c0 = bf_lo(lb[i]), c1 = bf_hi(lb[i]); slb0 += c0; slb1 += c1; hb0 = __expf(c0) * hb0 + bf_lo(ub_[i]); hb1 = __expf(c1) * hb1 + bf_hi(ub_[i]);
                    const bool q1 = (i0 + i == w1), q2 = (i0 + i == w2);
                    r1s0 = q1 ? slb0 : r1s0; r1s1 = q1 ? slb1 : r1s1; r1h0 = q1 ? hb0 : r1h0; r1h1 = q1 ? hb1 : r1h1;
                    r2s0 = q2 ? slb0 : r2s0; r2s1 = q2 ? slb1 : r2s1; r2h0 = q2 ? hb0 : r2h0; r2h1 = q2 ? hb1 : r2h1; }
#pragma unroll
                for (int i = 0; i < 8; ++i) { lb[i] = lbn[i]; ub_[i] = ubn[i]; }
            }
            { const float c0 = bf_lo(lr[0]), c1 = bf_hi(lr[0]); slb0 += c0; slb1 += c1; hb0 = __expf(c0) * hb0 + bf_lo(ur[0]); hb1 = __expf(c1) * hb1 + bf_hi(ur[0]);
                const bool q1 = (SL - 1 == w1), q2 = (SL - 1 == w2);
                r1s0 = q1 ? slb0 : r1s0; r1s1 = q1 ? slb1 : r1s1; r1h0 = q1 ? hb0 : r1h0; r1h1 = q1 ? hb1 : r1h1;
                r2s0 = q2 ? slb0 : r2s0; r2s1 = q2 ? slb1 : r2s1; r2h0 = q2 ? hb0 : r2h0; r2h1 = q2 ? hb1 : r2h1; }
            __syncthreads();
            { LAS float* a = AGG + seg * 256 + 2 * l32; *(LAS f32x2*)(a) = (f32x2){slb0, slb1}; *(LAS f32x2*)(a + 64) = (f32x2){hb0, hb1}; }
            __syncthreads();
            float cb0 = 0.f, cb1 = 0.f;
            for (int v = 15; v > seg; --v) { const LAS float* a = AGG + v * 256 + 2 * l32; const f32x2 sl = *(const LAS f32x2*)(a), hh = *(const LAS f32x2*)(a + 64); cb0 = hh[0] + __expf(sl[0]) * cb0; cb1 = hh[1] + __expf(sl[1]) * cb1; }
            *(LAS f32x2*)(CB + (nb * seg + nb) * 64 + 2 * l32) = (f32x2){r1h0 + __expf(r1s0) * cb0, r1h1 + __expf(r1s1) * cb1};
            if (nb == 2) *(LAS f32x2*)(CB + (nb * seg + nb - 1) * 64 + 2 * l32) = (f32x2){r2h0 + __expf(r2s0) * cb0, r2h1 + __expf(r2s1) * cb1};
            __syncthreads();
        }
        float CF0 = 0.f, CF1 = 0.f;
        ScanBuf X0, X1, X2; unsigned G[8];
        scan_fetch(X0, 0, NC, seg, l32, laf, uf, lab, ub, ubase); scan_fetch(X1, 1, NC, seg, l32, laf, uf, lab, ub, ubase);
        for (int c = 0; c <= NC; c += 3) {
            scan_gate(G, c, NC, seg, l32, ygate, ubase); scan_fetch(X2, c + 2, NC, seg, l32, laf, uf, lab, ub, ubase); scan_chunk(X0, G, c, NC, seg, l32, AGG, CB, CF0, CF1, ub, ubase);
            if (c + 1 > NC) break;
            scan_gate(G, c + 1, NC, seg, l32, ygate, ubase); scan_fetch(X0, c + 3, NC, seg, l32, laf, uf, lab, ub, ubase); scan_chunk(X1, G, c + 1, NC, seg, l32, AGG, CB, CF0, CF1, ub, ubase);
            if (c + 2 > NC) break;
            scan_gate(G, c + 2, NC, seg, l32, ygate, ubase); scan_fetch(X1, c + 4, NC, seg, l32, laf, uf, lab, ub, ubase); scan_chunk(X2, G, c + 2, NC, seg, l32, AGG, CB, CF0, CF1, ub, ubase);
        }
    }
}
constexpr int NA_VPITCH = 136;
constexpr int NA_WAVE_LDS = 32 * NA_VPITCH * 2 + 2048;
DI void na_attn_phase(Frame& F, const bf16_t* qkv, bf16_t* O, const float* rpb, const float* mbias) {
    int tid_ = F.wave * 64 + lane_id(); asm volatile("" : "+v"(tid_));
    const int lane = tid_ & 63, l15 = lane & 15, quad = lane >> 4;
    LAS unsigned char* wl = F.lds + F.wave * NA_WAVE_LDS;
    LAS bf16_t* vt = (LAS bf16_t*)wl;
    LAS float* rp = (LAS float*)(wl + 32 * NA_VPITCH * 2);
    int cached_h = -1;
    const float scale = 0.08838834764831845f;
    const int NITEMS = MTOK;
    for (int id = F.bid * 8 + F.wave; id < NITEMS; id += F.G * 8) {
        int b, h, it, rows;
        if (id < MPROMPT) { const int bh = id / 129; it = id - bh * 129; b = bh >> 4; h = bh & 15; rows = 32; }
        else { const int i2 = id - MPROMPT; const int bh = i2 / 257; it = i2 - bh * 257; b = NPROMPT + (bh >> 4); h = bh & 15; rows = 64; }
        const bool is_meta = (it == rows * 4);
        const int r = it >> 2, n = it & 3;
        const int so = seq_off(b);
        if (h != cached_h) {
            __builtin_amdgcn_wave_barrier();
            for (int i = lane; i < 465; i += 64) rp[i] = rpb[h * 465 + i];
            if (lane < 16) rp[480 + lane] = mbias[h * 16 + lane];
            cached_h = h; LDS_WAIT(); __builtin_amdgcn_wave_barrier(); asm volatile("" ::: "memory");
        }
        int rs = r - 4; rs = rs < 0 ? 0 : (rs > rows - 8 ? rows - 8 : rs);
        int ks = 16 * n - 8; ks = ks < 0 ? 0 : (ks > 32 ? 32 : ks);
        const int qrow = is_meta ? so + l15 : so + NMETA + 64 * r + 16 * n + l15;
        const int qcol = 16 * n + l15; int cs = qcol - 8; cs = cs < 0 ? 0 : (cs > 48 ? 48 : cs);
        bf16x8 qf[4];
#pragma unroll
        for (int s = 0; s < 4; ++s) qf[s] = *(const bf16x8*)(qkv + (size_t)qrow * 6144 + h * 128 + 32 * s + 8 * quad);
        f32x4 sv[17];
#pragma unroll
        for (int kb = 0; kb < 17; ++kb) sv[kb] = (f32x4){-1e30f, -1e30f, -1e30f, -1e30f};
        if (!is_meta) {
#pragma unroll
            for (int kb0 = 0; kb0 < 16; kb0 += 8) {
                bf16x8 kf[8][4];
#pragma unroll
                for (int i = 0; i < 8; ++i) { const int kb = kb0 + i, kr = kb >> 1; const int krow = so + NMETA + 64 * (rs + kr) + ks + 16 * (kb & 1) + l15;
#pragma unroll
                    for (int s = 0; s < 4; ++s) kf[i][s] = *(const bf16x8*)(qkv + (size_t)krow * 6144 + 2048 + h * 128 + 32 * s + 8 * quad); }
#pragma unroll
                for (int i = 0; i < 8; ++i) { const int kb = kb0 + i, kr = kb >> 1;
                    f32x4 st = (f32x4){0.f, 0.f, 0.f, 0.f};
#pragma unroll
                    for (int s = 0; s < 4; ++s) st = __builtin_amdgcn_mfma_f32_16x16x32_bf16(kf[i][s], qf[s], st, 0, 0, 0);
                    const int roff = (rs + kr) - r + 7;
#pragma unroll
                    for (int g = 0; g < 4; ++g) { const int keycol = ks + 16 * (kb & 1) + 4 * quad + g; const bool valid = (keycol >= cs) && (keycol < cs + 16);
                        int coff = keycol - qcol; coff = coff < -15 ? -15 : (coff > 15 ? 15 : coff);
                        sv[kb][g] = valid ? st[g] * scale + rp[roff * 31 + coff + 15] : -1e30f; }
                }
            }
        }
        {
            const int krow = so + l15;
            f32x4 st = (f32x4){0.f, 0.f, 0.f, 0.f};
#pragma unroll
            for (int s = 0; s < 4; ++s) { const bf16x8 kf = *(const bf16x8*)(qkv + (size_t)krow * 6144 + 2048 + h * 128 + 32 * s + 8 * quad);
                st = __builtin_amdgcn_mfma_f32_16x16x32_bf16(kf, qf[s], st, 0, 0, 0); }
#pragma unroll
            for (int g = 0; g < 4; ++g) sv[16][g] = st[g] * scale + rp[480 + 4 * quad + g];
        }
        float mx = -1e30f;
#pragma unroll
        for (int kb = 0; kb < 17; ++kb)
#pragma unroll
            for (int g = 0; g < 4; ++g) mx = fmaxf(mx, sv[kb][g]);
        mx = fmaxf(mx, __shfl_xor(mx, 16)); mx = fmaxf(mx, __shfl_xor(mx, 32));
        float sum = 0.f;
#pragma unroll
        for (int kb = 0; kb < 17; ++kb)
#pragma unroll
            for (int g = 0; g < 4; ++g) { const float p = __expf(sv[kb][g] - mx); sv[kb][g] = p; sum += p; }
        sum += __shfl_xor(sum, 16); sum += __shfl_xor(sum, 32);
        const float inv = 1.0f / sum;
        f32x4 ot[8];
#pragma unroll
        for (int d = 0; d < 8; ++d) ot[d] = (f32x4){0.f, 0.f, 0.f, 0.f};
        u32x4 vcur[8];
        {   const int kr0 = is_meta ? 8 : 0;
#pragma unroll
            for (int i = 0; i < 8; ++i) { const int cid = i * 64 + lane, vr = cid >> 4, c16 = cid & 15; vcur[i] = (u32x4){0u, 0u, 0u, 0u};
                if (kr0 < 8) vcur[i] = *(const u32x4*)(qkv + (size_t)(so + NMETA + 64 * rs + ks + vr) * 6144 + 4096 + h * 128 + 8 * c16);
                else if (vr < 16) vcur[i] = *(const u32x4*)(qkv + (size_t)(so + vr) * 6144 + 4096 + h * 128 + 8 * c16); } }
#pragma unroll
        for (int kr = 0; kr < 9; ++kr) {
            if (!(is_meta && kr < 8)) {
            __builtin_amdgcn_wave_barrier(); asm volatile("" ::: "memory");
#pragma unroll
            for (int i = 0; i < 8; ++i) { const int cid = i * 64 + lane, vr = cid >> 4, c16 = cid & 15; *(LAS u32x4*)(vt + vr * NA_VPITCH + 8 * c16) = vcur[i]; }
            LDS_WAIT(); __builtin_amdgcn_wave_barrier(); asm volatile("" ::: "memory");
            u32x4 vnext[8];
#pragma unroll
            for (int i = 0; i < 8; ++i) { const int cid = i * 64 + lane, vr = cid >> 4, c16 = cid & 15; vnext[i] = (u32x4){0u, 0u, 0u, 0u};
                if (kr + 1 < 8) vnext[i] = *(const u32x4*)(qkv + (size_t)(so + NMETA + 64 * (rs + kr + 1) + ks + vr) * 6144 + 4096 + h * 128 + 8 * c16);
                else if (kr + 1 == 8 && vr < 16) vnext[i] = *(const u32x4*)(qkv + (size_t)(so + vr) * 6144 + 4096 + h * 128 + 8 * c16); }
            f32x4 p0, p1;
            if (kr < 8) { p0 = sv[2 * kr]; p1 = sv[2 * kr + 1]; } else { p0 = sv[16]; p1 = (f32x4){0.f, 0.f, 0.f, 0.f}; }
            u32x4 pw; pw.x = cvt_pk_bf16(p0[0] * inv, p0[1] * inv); pw.y = cvt_pk_bf16(p0[2] * inv, p0[3] * inv); pw.z = cvt_pk_bf16(p1[0] * inv, p1[1] * inv); pw.w = cvt_pk_bf16(p1[2] * inv, p1[3] * inv);
            const bf16x8 pf = __builtin_bit_cast(bf16x8, pw);
#pragma unroll
            for (int d = 0; d < 8; ++d) {
                bf16x8 vf;
#pragma unroll
                for (int j = 0; j < 8; ++j) vf[j] = (short)vt[(16 * (j >> 2) + 4 * quad + (j & 3)) * NA_VPITCH + 16 * d + l15];
                ot[d] = __builtin_amdgcn_mfma_f32_16x16x32_bf16(vf, pf, ot[d], 0, 0, 0);
            }
#pragma unroll
            for (int i = 0; i < 8; ++i) vcur[i] = vnext[i];
            }
        }
#pragma unroll
        for (int d = 0; d < 8; ++d) { u32x2 w; w.x = cvt_pk_bf16(ot[d][0], ot[d][1]); w.y = cvt_pk_bf16(ot[d][2], ot[d][3]);
            *(u32x2*)(O + (size_t)qrow * D + h * 128 + 16 * d + 4 * quad) = w; }
    }
}
constexpr int GD_QS = 0, GD_KS = 17408, GD_VS = 34816, GD_ABF = 52224, GD_ADG = 61440, GD_TIB = 66560, GD_KST = 68608, GD_QKM = 87040, GD_WB = 96256, GD_VEC = 113664, GD_CW = 114944, GD_END = 121088;
constexpr int GD_O = 114944;
constexpr int P_QS = 136, P_KST = 72, P_ADG = 20, P_O = 132;
typedef short bf16x4 __attribute__((ext_vector_type(4)));

DI void gdn_conv_phase(Frame& F, int half, bf16_t* qkvp, const bf16_t* halo, const float* conv_w) {
    int tid_ = F.wave * 64 + lane_id(); asm volatile("" : "+v"(tid_));
    const int tid = tid_, piece = tid & 63, tg = tid >> 6;
    constexpr int NIT = (MTOK / 64) * 8;
    for (int item = F.bid; item < NIT; item += F.G) {
        const bool ivld = true;
        const int rb = item >> 3, cs = item & 7, col = cs * 512 + piece * 8;
        const int X = col < 1024 ? 0 : (col < 2048 ? 1 : 2);
        const int wcol = X == 0 ? half * 1024 + col : (X == 1 ? 2048 + half * 1024 + (col - 1024) : 4096 + half * 2048 + (col - 2048));
        const int r0 = 64 * rb + 8 * tg; int b, t0; row_bt(r0, b, t0); const int T = seq_len(b);
        u32x4 xr[11];
#pragma unroll
        for (int r = 0; r < 11; ++r) { const int tt = t0 - 1 + r, w = r0 - 1 + r; xr[r] = (u32x4){0u, 0u, 0u, 0u};
            if (ivld && tt >= 0 && tt < T) { const bf16_t* p;
                if (w < 64 * rb) p = halo + ((size_t)rb * 3 + 0) * 4096 + col; else if (w >= 64 * rb + 64) p = halo + ((size_t)rb * 3 + 1 + (w - 64 * rb - 64)) * 4096 + col; else p = qkvp + (size_t)w * 4096 + col;
                xr[r] = *(const u32x4*)p; } }
        f32x4 wlo[4], whi[4];
#pragma unroll
        for (int j = 0; j < 4; ++j) { wlo[j] = *(const f32x4*)(conv_w + j * 8192 + wcol); whi[j] = *(const f32x4*)(conv_w + j * 8192 + wcol + 4); }
        u32x4 res[8];
#pragma unroll
        for (int ro = 0; ro < 8; ++ro) {
            float a[8];
#pragma unroll
            for (int e = 0; e < 8; ++e) a[e] = 0.f;
#pragma unroll
            for (int j = 0; j < 4; ++j) { const u32x4 x = xr[ro + j];
                a[0] += wlo[j][0] * bf_lo(x.x); a[1] += wlo[j][1] * bf_hi(x.x); a[2] += wlo[j][2] * bf_lo(x.y); a[3] += wlo[j][3] * bf_hi(x.y);
                a[4] += whi[j][0] * bf_lo(x.z); a[5] += whi[j][1] * bf_hi(x.z); a[6] += whi[j][2] * bf_lo(x.w); a[7] += whi[j][3] * bf_hi(x.w); }
            float ss = 0.f;
#pragma unroll
            for (int e = 0; e < 8; ++e) { a[e] = siluf_(a[e]); ss += a[e] * a[e]; }
            ss += __shfl_xor(ss, 1); ss += __shfl_xor(ss, 2); ss += __shfl_xor(ss, 4); ss += __shfl_xor(ss, 8);
            const float sc = X == 2 ? 1.0f : (1.0f / sqrtf(ss + 1e-6f)) * (X == 0 ? 0.08838834764831845f : 1.0f);
            res[ro] = (u32x4){cvt_pk_bf16(a[0] * sc, a[1] * sc), cvt_pk_bf16(a[2] * sc, a[3] * sc), cvt_pk_bf16(a[4] * sc, a[5] * sc), cvt_pk_bf16(a[6] * sc, a[7] * sc)};
        }
        __syncthreads();
        if (ivld) {
#pragma unroll
            for (int ro = 0; ro < 8; ++ro) *(u32x4*)(qkvp + (size_t)(r0 + ro) * 4096 + col) = res[ro]; }
    }
}
DI bf16x8 frag_perm(const LAS bf16_t* rowp, int kbase, int quad) {
    const s16x4 a = *(const LAS s16x4*)(rowp + kbase + 4 * quad), b = *(const LAS s16x4*)(rowp + kbase + 16 + 4 * quad);
    bf16x8 r; r[0] = a[0]; r[1] = a[1]; r[2] = a[2]; r[3] = a[3]; r[4] = b[0]; r[5] = b[1]; r[6] = b[2]; r[7] = b[3]; return r;
}
DI bf16x8 pack_acc(const f32x4 a, const f32x4 b) { const u32x4 w = pack8(a, b); return __builtin_bit_cast(bf16x8, w); }
DI bf16x4 pack4(const f32x4 a) { u32x2 w; w.x = cvt_pk_bf16(a[0], a[1]); w.y = cvt_pk_bf16(a[2], a[3]); return __builtin_bit_cast(bf16x4, w); }
#define MFMA16(a, b, c) __builtin_amdgcn_mfma_f32_16x16x16bf16_1k((a), (b), (c), 0, 0, 0)


DI void gd_tok_ab(int n, int dir, int& A, int& sg) { sg = dir ? -1 : 1; A = n == 0 ? (dir ? 15 : -48) : NMETA + 64 * (n - 1) + (dir ? 63 : 0); }
DI int gd_tok(int n, int dir, int slot) { int A, sg; gd_tok_ab(n, dir, A, sg); return A + sg * slot; }
DI void gd_fetch(const bf16_t* qkvp, const float* bg, int so, int hl, int ql, int hv, int n, int dir, int tid, int wave, u32x4 (&pf)[6], float& gv, float& bv) {
    int A, sg; gd_tok_ab(n, dir, A, sg);
    const int pc = tid & 15, cq = ql * 128 + 8 * pc, ck = 1024 + cq, cv = 2048 + hl * 128 + 8 * pc;
#pragma unroll
    for (int h2 = 0; h2 < 2; ++h2) { const int t = A + sg * ((tid >> 4) + 32 * h2);
        pf[h2] = pf[2 + h2] = pf[4 + h2] = (u32x4){0u, 0u, 0u, 0u};
        if (t >= 0) { const bf16_t* rp = qkvp + (size_t)(so + t) * 4096; pf[h2] = *(const u32x4*)(rp + cq); pf[2 + h2] = *(const u32x4*)(rp + ck); pf[4 + h2] = *(const u32x4*)(rp + cv); } }
    gv = 0.f; bv = 0.f;
    if (wave == 0) { const int t1 = A + sg * (tid & 63); if (t1 >= 0) { const float* p = bg + (size_t)(so + t1) * 128 + dir * 32 + hv; bv = p[0]; gv = p[64]; } }
}
#define GD_BAR() asm volatile("s_waitcnt lgkmcnt(0)\n\ts_barrier" ::: "memory")
#define GD_IDS() int tq_ = tid0; asm volatile("" : "+v"(tq_)); const int tid = tq_, lane = tid & 63, l15 = lane & 15, quad = lane >> 4, tau = tid >> 3, sub = tid & 7; (void)l15; (void)quad; (void)tau; (void)sub; (void)lane;
constexpr int GD_OB_SPLIT = 48640;
DI bf16_t* gd_ob_row(bf16_t* obA, bf16_t* obB, int R) { return R < GD_OB_SPLIT ? obA + (size_t)R * D : obB + (size_t)(R - GD_OB_SPLIT) * D; }
DI void gdn_core_phase(Frame& F, int half, const bf16_t* qkvp, const float* bg, bf16_t* og, bf16_t* obA, bf16_t* obB) {
    int tid_ = F.wave * 64 + lane_id(); asm volatile("" : "+v"(tid_));
    const int tid0 = tid_, wave = __builtin_amdgcn_readfirstlane(tid0 >> 6);
    LAS unsigned char* L = F.lds;
    LAS bf16_t* QS = (LAS bf16_t*)(L + GD_QS); LAS bf16_t* KS = (LAS bf16_t*)(L + GD_KS); LAS bf16_t* VS = (LAS bf16_t*)(L + GD_VS);
    LAS bf16_t* ABF = (LAS bf16_t*)(L + GD_ABF); LAS float* ADG = (LAS float*)(L + GD_ADG); LAS bf16_t* TIB = (LAS bf16_t*)(L + GD_TIB);
    LAS bf16_t* KST = (LAS bf16_t*)(L + GD_KST); LAS bf16_t* QKM = (LAS bf16_t*)(L + GD_QKM);
    LAS bf16_t* WB = (LAS bf16_t*)(L + GD_WB); LAS float* OL = (LAS float*)(L + GD_O);
    LAS float* GC = (LAS float*)(L + GD_VEC); LAS float* BETA = GC + 64; LAS float* EG = GC + 128; LAS float* EKL = GC + 192; LAS float* GL = GC + 256;
    for (int ii = 0; ; ++ii) {
        int id;
        if (F.G == 256) { if (F.bid < 128) { if (ii >= 2) break; id = ii == 0 ? F.bid : 128 + F.bid; } else { if (ii >= 3) break; id = 256 + 3 * (F.bid - 128) + ii; } }
        else { id = F.bid + ii * F.G; if (id >= NSEQ * 32) break; }
        const int s_ = id < 128 ? id : id - 128;
        const int b = id < 128 ? NPROMPT + (s_ >> 5) : (s_ >> 5), hl = (s_ >> 1) & 15, dir = s_ & 1, hv = half * 16 + hl, ql = hl >> 1;
        const int so = seq_off(b), T = seq_len(b), NC = 1 + (T - NMETA) / 64;
        __syncthreads();
        {
            f32x4 Sacc[8];
#pragma unroll
            for (int i = 0; i < 8; ++i) Sacc[i] = (f32x4){0.f, 0.f, 0.f, 0.f};
            u32x4 pf[6]; float pgv, pbv;
            gd_fetch(qkvp, bg, so, hl, ql, hv, dir ? NC - 1 : 0, dir, tid0, wave, pf, pgv, pbv);
#define GD_S5() do { if (tprev >= 0) { GD_IDS(); f32x4 o[4]; _Pragma("unroll") for (int i = 0; i < 4; ++i) o[i] = *(const LAS f32x4*)(OL + tau * P_O + 16 * sub + 4 * i); \
                *(u32x4*)(gpprev) = pack8(o[0], o[1]); *(u32x4*)(gpprev + 8) = pack8(o[2], o[3]); } } while (0)
            int tprev = -1; bf16_t* gpprev = og;
            for (int step = 0; step < NC; ++step) {
                const int n = dir ? NC - 1 - step : step;
                int t, R; float gv = 0.f, bv = 0.f; bf16_t* gp;
                GD_S5();
                { GD_IDS();
                t = gd_tok(n, dir, tau);
                R = so + (t < 0 ? 0 : t);
#pragma unroll
                for (int i = 0; i < 6; ++i) { const int X = i >> 1, slot = (tid >> 4) + 32 * (i & 1), pc = tid & 15;
                    LAS bf16_t* dst = (X == 0 ? QS : (X == 1 ? KS : VS)) + slot * P_QS + 8 * pc;
                    *(LAS u32x4*)(dst) = pf[i];
                    if (X == 1) { const unsigned w4[4] = {pf[i].x, pf[i].y, pf[i].z, pf[i].w};
#pragma unroll
                        for (int e = 0; e < 8; ++e) KST[(8 * pc + e) * P_KST + slot] = (bf16_t)((e & 1) ? (w4[e >> 1] >> 16) : (w4[e >> 1] & 0xffffu)); } }
                gv = pgv; bv = pbv;
                if (step + 1 < NC) gd_fetch(qkvp, bg, so, hl, ql, hv, dir ? NC - 2 - step : step + 1, dir, tid, wave, pf, pgv, pbv);
                gp = (dir ? gd_ob_row(obA, obB, R) : og + (size_t)R * D) + hl * 128 + 16 * sub;
                }
                if (wave == 0) { GD_IDS();
                    float c = gv;
#pragma unroll
                    for (int o = 1; o < 64; o <<= 1) { const float y = __shfl_up(c, o); if (lane >= o) c += y; }
                    const float gl = __shfl(c, 63);
                    GC[lane] = c; BETA[lane] = bv; EG[lane] = __expf(c); EKL[lane] = __expf(gl - c); if (lane == 0) GL[0] = __expf(gl);
                }
                GD_BAR();
                { GD_IDS();
                    const int cb = wave >> 1;
                    bf16x8 ka[4], qa[4];
#pragma unroll
                    for (int ks = 0; ks < 4; ++ks) { ka[ks] = *(const LAS bf16x8*)(KS + (16 * cb + l15) * P_QS + 32 * ks + 8 * quad); qa[ks] = *(const LAS bf16x8*)(QS + (16 * cb + l15) * P_QS + 32 * ks + 8 * quad); }
                    const f32x4 gcc = *(const LAS f32x4*)(GC + 16 * cb + 4 * quad), btc = *(const LAS f32x4*)(BETA + 16 * cb + 4 * quad);
#pragma unroll
                    for (int s2 = 0; s2 < 2; ++s2) { const int sb = 2 * (wave & 1) + s2;
                        f32x4 kk = (f32x4){0.f, 0.f, 0.f, 0.f}, qk = kk;
#pragma unroll
                        for (int ks = 0; ks < 4; ++ks) { const bf16x8 kb = *(const LAS bf16x8*)(KS + (16 * sb + l15) * P_QS + 32 * ks + 8 * quad);
                            kk = __builtin_amdgcn_mfma_f32_16x16x32_bf16(ka[ks], kb, kk, 0, 0, 0); qk = __builtin_amdgcn_mfma_f32_16x16x32_bf16(qa[ks], kb, qk, 0, 0, 0); }
                        const int s = 16 * sb + l15; const float gcs = GC[s];
#pragma unroll
                        for (int g = 0; g < 4; ++g) { const int c = 16 * cb + 4 * quad + g;
                            const float dec = (s <= c) ? __expf(fminf(gcc[g] - gcs, 0.f)) : 0.f;
                            const float av = (s < c) ? btc[g] * kk[g] * dec : 0.f;
                            QKM[c * P_KST + s] = f2bf(qk[g] * dec);
                            ABF[c * P_KST + s] = f2bf(av);
                            if (sb == cb) ADG[(cb * 16 + 4 * quad + g) * P_ADG + l15] = av; }
                    }
                }
                GD_BAR();
                if (wave == 0) { GD_IDS();
                    float tcol[16];
#pragma unroll
                    for (int r = 0; r < 16; ++r) { float acc = (r == l15) ? 1.f : 0.f;
                        const LAS float* lr = ADG + (quad * 16 + r) * P_ADG;
#pragma unroll
                        for (int s4 = 0; s4 < (r + 3) / 4; ++s4) { const f32x4 lv = *(const LAS f32x4*)(lr + 4 * s4);
#pragma unroll
                            for (int e = 0; e < 4; ++e) if (4 * s4 + e < r) acc -= lv[e] * tcol[4 * s4 + e]; }
                        tcol[r] = acc; TIB[(quad * 16 + r) * 16 + l15] = f2bf(acc); }
                }
                f32x4 ru[4], rw[4];
                { GD_IDS();
#pragma unroll
                for (int k = 0; k < 4; ++k) { const f32x4 bt = *(const LAS f32x4*)(BETA + 16 * k + 4 * quad), eg = *(const LAS f32x4*)(EG + 16 * k + 4 * quad);
#pragma unroll
                    for (int g = 0; g < 4; ++g) { const int c = 16 * k + 4 * quad + g;
                        ru[k][g] = bf2f(VS[c * P_QS + 16 * wave + l15]) * bt[g]; rw[k][g] = bf2f(KS[c * P_QS + 16 * wave + l15]) * (bt[g] * eg[g]); } } }
                GD_BAR();
                f32x4 uu[4];
                { GD_IDS();
                    bf16x4 xu[4], xw[4];
#pragma unroll
                    for (int k = 0; k < 4; ++k) {
                        f32x4 su = (f32x4){0.f, 0.f, 0.f, 0.f}, sw = su;
#pragma unroll
                        for (int j = 0; j < 4; ++j) if (j < k) { const bf16x4 af = *(const LAS bf16x4*)(ABF + (16 * k + l15) * P_KST + 16 * j + 4 * quad);
                            su = MFMA16(af, xu[j], su); sw = MFMA16(af, xw[j], sw); }
                        const bf16x4 tf = *(const LAS bf16x4*)(TIB + (k * 16 + l15) * 16 + 4 * quad);
                        const f32x4 z4 = (f32x4){0.f, 0.f, 0.f, 0.f};
                        const f32x4 xuk = MFMA16(tf, pack4(ru[k] - su), z4), xwk = MFMA16(tf, pack4(rw[k] - sw), z4);
                        uu[k] = xuk; xu[k] = pack4(xuk); xw[k] = pack4(xwk);
#pragma unroll
                        for (int g = 0; g < 4; ++g) WB[(16 * k + 4 * quad + g) * P_QS + 16 * wave + l15] = f2bf(xwk[g]);
                    }
                }
                GD_BAR();
                { GD_IDS();
                    bf16x8 Sb[4];
#pragma unroll
                    for (int ks = 0; ks < 4; ++ks) Sb[ks] = pack_acc(Sacc[2 * ks], Sacc[2 * ks + 1]);
                    f32x4 vn[4], oo[4];
#pragma unroll
                    for (int cb = 0; cb < 4; ++cb) {
                        f32x4 ws = (f32x4){0.f, 0.f, 0.f, 0.f}, qs = ws;
#pragma unroll
                        for (int ks = 0; ks < 4; ++ks) { ws = __builtin_amdgcn_mfma_f32_16x16x32_bf16(frag_perm(WB + (16 * cb + l15) * P_QS, 32 * ks, quad), Sb[ks], ws, 0, 0, 0);
                            qs = __builtin_amdgcn_mfma_f32_16x16x32_bf16(frag_perm(QS + (16 * cb + l15) * P_QS, 32 * ks, quad), Sb[ks], qs, 0, 0, 0); }
                        const f32x4 egc = *(const LAS f32x4*)(EG + 16 * cb + 4 * quad);
                        vn[cb] = uu[cb] - ws; oo[cb] = egc * qs;
                    }
                    bf16x8 vb[2];
#pragma unroll
                    for (int kc = 0; kc < 2; ++kc) vb[kc] = pack_acc(vn[2 * kc], vn[2 * kc + 1]);
#pragma unroll
                    for (int cb = 0; cb < 4; ++cb) {
#pragma unroll
                        for (int kc = 0; kc < 2; ++kc) oo[cb] = __builtin_amdgcn_mfma_f32_16x16x32_bf16(frag_perm(QKM + (16 * cb + l15) * P_KST, 32 * kc, quad), vb[kc], oo[cb], 0, 0, 0);
#pragma unroll
                        for (int g = 0; g < 4; ++g) OL[(16 * cb + 4 * quad + g) * P_O + 16 * wave + l15] = oo[cb][g];
                        const f32x4 ek = *(const LAS f32x4*)(EKL + 16 * cb + 4 * quad);
                        vn[cb] = vn[cb] * ek;
                    }
#pragma unroll
                    for (int kc = 0; kc < 2; ++kc) vb[kc] = pack_acc(vn[2 * kc], vn[2 * kc + 1]);
                    const float egl = GL[0];
#pragma unroll
                    for (int db = 0; db < 8; ++db) { f32x4 s = Sacc[db] * egl;
#pragma unroll
                        for (int kc = 0; kc < 2; ++kc) s = __builtin_amdgcn_mfma_f32_16x16x32_bf16(frag_perm(KST + (16 * db + l15) * P_KST, 32 * kc, quad), vb[kc], s, 0, 0, 0);
                        Sacc[db] = s; }
                }
                GD_BAR();
                tprev = t; gpprev = gp;
            }
            GD_S5();
        }
    }
}

DI void gdn_combine_phase(Frame& F, bf16_t* og, bf16_t* obA, bf16_t* obB, const bf16_t* zb, const float* norm_w) {
    const int lane = F.lane(), e0 = (lane & 15) * 8;
    f32x4 nw0 = *(const f32x4*)(norm_w + e0), nw1 = *(const f32x4*)(norm_w + e0 + 4);
    for (int R = F.bid * 8 + F.wave; R < MTOK; R += F.G * 8) {
        bf16_t* op = og + (size_t)R * D + lane * 8; const bf16_t* bp = gd_ob_row(obA, obB, R) + lane * 8; const bf16_t* zp = zb + (size_t)R * D + lane * 8;
        u32x4 f[4], g[4], z[4];
#pragma unroll
        for (int q = 0; q < 4; ++q) { f[q] = *(const u32x4*)(op + 512 * q); g[q] = *(const u32x4*)(bp + 512 * q); z[q] = *(const u32x4*)(zp + 512 * q); }
#pragma unroll
        for (int q = 0; q < 4; ++q) {
            const unsigned fw[4] = {f[q].x, f[q].y, f[q].z, f[q].w}, gw[4] = {g[q].x, g[q].y, g[q].z, g[q].w}, zw[4] = {z[q].x, z[q].y, z[q].z, z[q].w};
            float o[8], zz[8]; float ss = 0.f;
#pragma unroll
            for (int k = 0; k < 4; ++k) { o[2 * k] = bf_lo(fw[k]) + bf_lo(gw[k]); o[2 * k + 1] = bf_hi(fw[k]) + bf_hi(gw[k]); zz[2 * k] = bf_lo(zw[k]); zz[2 * k + 1] = bf_hi(zw[k]); }
#pragma unroll
            for (int e = 0; e < 8; ++e) ss += o[e] * o[e];
            ss += __shfl_xor(ss, 1); ss += __shfl_xor(ss, 2); ss += __shfl_xor(ss, 4); ss += __shfl_xor(ss, 8);
            const float rn = 1.0f / sqrtf(ss * (1.0f / 128.0f) + NORM_EPS);
            f32x4 a, b2;
#pragma unroll
            for (int k = 0; k < 4; ++k) { a[k] = o[k] * rn * nw0[k] * siluf_(zz[k]); b2[k] = o[4 + k] * rn * nw1[k] * siluf_(zz[4 + k]); }
            *(u32x4*)(op + 512 * q) = pack8(a, b2);
        }
    }
}
constexpr int N_PHASES = 38;
#ifndef ALIGN_RES
#define ALIGN_RES true
#endif
#ifndef ALIGN_CONS
#define ALIGN_CONS true
#endif
#ifndef WGM_DEF
#define WGM_DEF 4
#endif
#ifndef WGM_RES
#define WGM_RES 4
#endif
#ifndef WGM_FFU
#define WGM_FFU 4
#endif
#ifndef WGM_GATES
#define WGM_GATES 4
#endif
DI pg8::Gemm mk_gemm(const void* A, unsigned lda, const void* B, unsigned ldb, long hB, int nt) { pg8::Gemm g; g.A = (const char*)A; g.B = (const char*)B; g.lda = lda; g.ldb = ldb; g.hstepA = 128L * lda; g.hstepB = hB; g.nt = nt; return g; }
DI SchedLin mk_lin(Frame& F, int nM, int nN, long a_base, long a_tile, long b_base, long b_tile, int nt = 32, int wgm = WGM_DEF) { SchedLin s; s.o.init(nM, nN, F.G, F.bid, wgm); s.a_base = a_base; s.a_tile = a_tile; s.b_base = b_base; s.b_tile = b_tile; s.nt = nt; return s; }
DI SchedRes mk_res(Frame& F, long a_tile, long b_base, long b_tile, int nt, int wgm = WGM_RES) { SchedRes s; s.init(F.G, F.bid, a_tile, b_base, b_tile, nt, wgm); return s; }

__global__ void __launch_bounds__(512, 2) trunk_fwd(Args args) {
    extern __shared__ __attribute__((aligned(16))) unsigned char lds_raw[];
    Frame F;
    F.lds = (LAS unsigned char*)lds_raw;
    F.wave = __builtin_amdgcn_readfirstlane(threadIdx.x >> 6); F.G = gridDim.x; F.bid = blockIdx.x;
    F.in = args.in; F.out = args.out; F.ws = args.ws;
    volatile LAS unsigned* MISC = (volatile LAS unsigned*)(F.lds + MISC_OFF);
    if (F.tid() < 16) MISC[F.tid()] = 0u;
    __syncthreads();
    const int lo = args.ph_lo, hi = args.ph_hi;
    unsigned* ctl = (unsigned*)(F.ws + WS_CTL);
    XcdBarrier bar; bar.bar = ctl + CW_BAR; bar.x = 0; bar.st = nullptr;
    if (hi - lo > 1) bar = xcd_barrier_post(ctl + CW_BAR, MISC + 8, F.wave == 0 && lane_id() == 0);
#define IN(k) (lo <= (k) && (k) < hi)
#define SEAM(k) do { if (IN(k) && IN((k) + 1)) xcd_barrier(bar, F.wave == 0 && lane_id() == 0); } while (0)
#ifndef REP_MASK
#define REP_MASK 0ull
#endif
#define PHASE(k, ...) if (IN(k)) { if constexpr (((REP_MASK) >> (k)) & 1ull) { __VA_ARGS__; xcd_barrier(bar, F.wave == 0 && lane_id() == 0); } __VA_ARGS__; } SEAM(k);
    LAS float* cscr = (LAS float*)(F.lds + F.wave * 16384);
    bf16_t* const XNp = F.XN(); bf16_t* const XCp = F.XC(); unsigned char* const SCR = F.SCR();
    bf16_t* const OUTB = (bf16_t*)F.out;
    constexpr unsigned LD2K = 4096;


#define CVT_BEGIN() CvtCursor cc{F.bid * 8 + F.wave, 0, F.G * 8}
#define CVT_BEGIN_RES() CvtCursor cc{(F.G == 256) ? (F.bid >= 64 ? (F.bid - 64) * 8 + F.wave : 0x3fffffff) : F.bid * 8 + F.wave, 0, (F.G == 256) ? 192 * 8 : F.G * 8}
#define PH_FIN(XI_, XO_, S1_, ...) { CVT_BEGIN(); __VA_ARGS__; ss_final_phase(F, ssp, rsv, XI_, XO_, SLAB0, S1_); }
#define PH_FFN_UP(LI_, X_) { bf16_t* wg = (bf16_t*)F.WFFN(); \
        pg8::Gemm g = mk_gemm(X_, LD2K, wg, LD2K, (long)DFF * LD2K, 32); SchedLin S = mk_lin(F, 195, 44, -(long)LD2K, 254L * LD2K, 0, 128L * LD2K, 32, WGM_FFU); \
        EpiFfnUp E{(bf16_t*)SCR, F.I(27) + (size_t)(LI_) * 3 * DFF, F.I(28) + (size_t)(LI_) * DFF, (LAS float*)(F.lds + EDGE_OFF), rsv, (const unsigned char*)(F.ws + WS_CTL + 768 * 1024)}; \
        pg8::gemm_phase<EpiFfnUp, SchedLin, true>(F.lds, g, S, E, F.wave); }
#define PH_FFN_DOWN(XI_, XO_, SS_, ...) { bf16_t* wd = (bf16_t*)F.WFFN() + (size_t)2 * DFF * D; \
        pg8::Gemm g = mk_gemm(SCR, DFF * 2, wd, DFF * 2, 128L * DFF * 2, 88); SchedRes S = mk_res(F, 256L * DFF * 2, 0, 256L * DFF * 2, 88); \
        EpiResAdd E{XI_, XO_, SS_, SLAB0}; pg8::gemm_phase<EpiResAdd, SchedRes, ALIGN_RES>(F.lds, g, S, E, F.wave); { CVT_BEGIN_RES(); __VA_ARGS__; } }
#define PH_RG_IN(X_) { bf16_t* win = (bf16_t*)F.WMIX(); \
        pg8::Gemm g = mk_gemm(X_, LD2K, win, LD2K, 128L * LD2K, 32); SchedLin S = mk_lin(F, 194, 16, 0, 256L * LD2K, 0, 256L * LD2K); \
        EpiRgIn E{OUTB, (bf16_t*)SCR, rsv}; pg8::gemm_phase<EpiRgIn, SchedLin, ALIGN_CONS>(F.lds, g, S, E, F.wave); }
#define PH_RG_CONV(J_) { rg_conv_phase(F, (const bf16_t*)SCR, XCp, F.I(7) + (size_t)(J_) * 4 * D, F.I(8) + (size_t)(J_) * D); }
#define PH_RG_GATES(J_) { bf16_t* gates = (bf16_t*)F.WMIX() + (size_t)4096 * D; \
        pg8::Gemm g = mk_gemm(XCp, LD2K, gates, 512, 8L * 131072, 4); SchedGates S; S.o.init(194, 32, F.G, F.bid, WGM_GATES); \
        EpiGates E{XCp, (bf16_t*)SCR, (bf16_t*)(SCR + B194), B194, F.I(10) + (size_t)(J_) * 2 * D, F.I(12) + (size_t)(J_) * 2 * D, F.I(13) + (size_t)(J_) * 2 * D, (LAS float*)(F.lds + EDGE_OFF)}; \
        pg8::gemm_phase<EpiGates, SchedGates, true>(F.lds, g, S, E, F.wave); }
#define PH_RG_SCAN() { rg_scan_phase(F, (const bf16_t*)SCR, (bf16_t*)(SCR + B194), (const bf16_t*)(SCR + 2 * B194), (bf16_t*)(SCR + 3 * B194), OUTB); }
#define PH_RG_OUT(XI_, XO_, ...) { bf16_t* wout = (bf16_t*)F.WMIX() + (size_t)4096 * D + (size_t)32 * 65536; \
        pg8::Gemm g = mk_gemm(SCR + 3 * B194, LD2K, wout, LD2K, 128L * LD2K, 32); SchedRes S = mk_res(F, 256L * LD2K, 0, 256L * LD2K, 32); \
        EpiResAdd E{XI_, XO_, ssp, SLAB0}; pg8::gemm_phase<EpiResAdd, SchedRes, ALIGN_RES>(F.lds, g, S, E, F.wave); { CVT_BEGIN_RES(); __VA_ARGS__; } }
#define PH_GDN_PROJ(HALF_, X_) { bf16_t* w = (bf16_t*)F.WMIX() + ((HALF_) ? (size_t)6400 * D : 0); \
        pg8::Gemm g = mk_gemm(X_, LD2K, w, LD2K, 128L * LD2K, 32); SchedLin S = mk_lin(F, 194, (HALF_) ? 24 : 25, 0, 256L * LD2K, 0, 256L * LD2K); \
        EpiGdnProj E{(bf16_t*)SCR, (HALF_) ? (bf16_t*)(SCR + 2 * B194) : XB, (float*)(SCR + 3 * B194), F.I(21), F.I(22), (bf16_t*)(SCR + 3 * B194 + 26 * MiB), rsv}; pg8::gemm_phase<EpiGdnProj, SchedLin, ALIGN_CONS>(F.lds, g, S, E, F.wave); }
#define PH_GDN_CONV(HALF_) { gdn_conv_phase(F, HALF_, (bf16_t*)SCR, (const bf16_t*)(SCR + 3 * B194 + 26 * MiB), F.I(20)); }
#define GD_OBA (OUTB + (size_t)MP * D)
#define GD_OBB ((bf16_t*)(SCR + 3 * B194 + 48 * MiB))
#define PH_GDN_CORE(HALF_) { gdn_core_phase(F, HALF_, (const bf16_t*)SCR, (const float*)(SCR + 3 * B194), (HALF_) ? XCp : OUTB, GD_OBA, GD_OBB); }
#define PH_GDN_COMB(HALF_) { gdn_combine_phase(F, (HALF_) ? XCp : OUTB, GD_OBA, GD_OBB, (HALF_) ? (const bf16_t*)(SCR + 2 * B194) : (const bf16_t*)XB, F.I(23)); }
#define PH_GDN_OUT(HALF_, XI_, XO_, SS_, ...) { bf16_t* wout = (bf16_t*)F.WMIX() + (size_t)(6400 + 6144) * D; \
        pg8::Gemm g = mk_gemm((HALF_) ? XCp : OUTB, LD2K, wout, 8192, 128L * 8192, 32); SchedRes S = mk_res(F, 256L * LD2K, (long)(HALF_) * 4096, 256L * 8192, 32); \
        EpiResAdd E{XI_, XO_, SS_, (HALF_) ? SLAB1 : SLAB0}; pg8::gemm_phase<EpiResAdd, SchedRes, ALIGN_RES>(F.lds, g, S, E, F.wave); { CVT_BEGIN_RES(); __VA_ARGS__; } }
    float* const SLAB0 = (float*)(SCR + 784 * MiB); float* const SLAB1 = (float*)(SCR + 640 * MiB); float* const NOSLAB = nullptr;
    float* const ssp = (float*)(SCR + 4 * B194);
    float* const rsv = (float*)(F.ws + WS_CTL + 256 * 1024);
    bf16_t* const NOXN = nullptr; float* const NOSS = nullptr; (void)NOXN;

    bf16_t* const XA = XNp; bf16_t* const XB = (bf16_t*)(F.ws + WS_H + B194);
    PHASE(0, { CVT_BEGIN(); cvt_rg(F, cc, 0, 0, cscr); cvt_ffn(F, cc, 0, cscr); fill_rflag(F, (unsigned char*)(F.ws + WS_CTL + 768 * 1024)); norm_phase<1>(F, XA, F.I(3), rsv); })
    PHASE(1, PH_RG_IN(XA)) PHASE(2, PH_RG_CONV(0)) PHASE(3, PH_RG_GATES(0)) PHASE(4, PH_RG_SCAN()) PHASE(5, PH_RG_OUT(XA, XB, (void)cc))
    PHASE(6, PH_FIN(XA, XB, NOSLAB, (void)cc))
    PHASE(7, PH_FFN_UP(0, XB)) PHASE(8, PH_FFN_DOWN(XB, XA, ssp, cvt_na(F, cc, cscr))) PHASE(9, PH_FIN(XB, XA, NOSLAB, (void)cc))
    PHASE(10, { pg8::Gemm g = mk_gemm(XA, LD2K, F.WMIX(), LD2K, 128L * LD2K, 32); SchedLin S = mk_lin(F, 194, 24, 0, 256L * LD2K, 0, 256L * LD2K);
        EpiPlainBf16 E{(bf16_t*)SCR, 6144, rsv}; pg8::gemm_phase<EpiPlainBf16, SchedLin, ALIGN_CONS>(F.lds, g, S, E, F.wave); })
    PHASE(11, { na_attn_phase(F, (const bf16_t*)SCR, OUTB, F.I(16), F.I(17)); })
    PHASE(12, { bf16_t* wo = (bf16_t*)F.WMIX() + (size_t)6144 * D;
        pg8::Gemm g = mk_gemm(OUTB, LD2K, wo, LD2K, 128L * LD2K, 32); SchedRes S = mk_res(F, 256L * LD2K, 0, 256L * LD2K, 32);
        EpiResAdd E{XA, XB, ssp, SLAB0}; pg8::gemm_phase<EpiResAdd, SchedRes, ALIGN_RES>(F.lds, g, S, E, F.wave); { CVT_BEGIN_RES(); cvt_ffn(F, cc, 1, cscr); } })
    PHASE(13, PH_FIN(XA, XB, NOSLAB, (void)cc))
    PHASE(14, PH_FFN_UP(1, XB)) PHASE(15, PH_FFN_DOWN(XB, XA, ssp, cvt_gdn(F, cc, cscr))) PHASE(16, PH_FIN(XB, XA, NOSLAB, (void)cc))
    PHASE(17, PH_GDN_PROJ(0, XA)) PHASE(18, PH_GDN_CONV(0)) PHASE(19, PH_GDN_CORE(0))
    PHASE(20, { PH_GDN_COMB(0) PH_GDN_PROJ(1, XA) }) PHASE(21, PH_GDN_CONV(1)) PHASE(22, PH_GDN_CORE(1))
    PHASE(23, { PH_GDN_COMB(1) PH_GDN_OUT(0, XA, XB, NOSS, cvt_ffn(F, cc, 2, cscr)) })
    PHASE(24, PH_GDN_OUT(1, XB, XA, ssp, (void)cc))
    PHASE(25, PH_FIN(XA, XA, SLAB1, (void)cc))
    PHASE(26, PH_FFN_UP(2, XA)) PHASE(27, PH_FFN_DOWN(XA, XB, ssp, cvt_rg(F, cc, 1, 3, cscr))) PHASE(28, PH_FIN(XA, XB, NOSLAB, (void)cc))
    PHASE(29, PH_RG_IN(XB)) PHASE(30, PH_RG_CONV(1)) PHASE(31, PH_RG_GATES(1)) PHASE(32, PH_RG_SCAN()) PHASE(33, PH_RG_OUT(XB, XA, cvt_ffn(F, cc, 3, cscr)))
    PHASE(34, PH_FIN(XB, XA, NOSLAB, (void)cc))
    PHASE(35, PH_FFN_UP(3, XA)) PHASE(36, PH_FFN_DOWN(XA, XB, NOSS, (void)cc))
    PHASE(37, { norm_phase<2>(F, XB, F.I(5), nullptr, XA, SLAB0); })
#undef IN
#undef SEAM
}

__global__ void fill_k(float* o, size_t n, float v) { for (size_t i = (size_t)blockIdx.x * blockDim.x + threadIdx.x; i < n; i += (size_t)gridDim.x * blockDim.x) o[i] = v; }
#ifndef MK_ONE_LAUNCH
#define MK_ONE_LAUNCH 1
#endif
extern "C" void kernel_launch(void* const* d_in, const int* in_sizes, int n_in, void* d_out, int out_size, void* d_ws, size_t ws_size, hipStream_t stream) {
    static int grid = 0;
    if (grid == 0) {
        int dev = 0, cus = 0;
        hipError_t e = hipGetDevice(&dev); if (e == hipSuccess) e = hipDeviceGetAttribute(&cus, hipDeviceAttributeMultiprocessorCount, dev);
        if (e == hipSuccess) e = hipFuncSetAttribute((const void*)trunk_fwd, hipFuncAttributeMaxDynamicSharedMemorySize, LDS_BYTES);
        if (e != hipSuccess || n_in != 30 || ws_size < WS_END || cus < 1) { fprintf(stderr, "kernel_launch: setup failed (%s), n_in %d, ws %zu\n", hipGetErrorName(e), n_in, ws_size); grid = -1; }
        else grid = cus;
        (void)hipGetLastError();
    }
    if (grid < 0) { fill_k<<<1024, 256, 0, stream>>>((float*)d_out, (size_t)out_size, 7.0f); return; }
    (void)hipMemsetAsync((char*)d_ws + WS_CTL, 0, CTL_ZERO_BYTES, stream);
    Args a{};
    for (int i = 0; i < 30; ++i) a.in[i] = (const float*)d_in[i];
    a.out = (float*)d_out; a.ws = (unsigned char*)d_ws;
#if MK_ONE_LAUNCH
    a.ph_lo = 0; a.ph_hi = N_PHASES;
    hipLaunchKernelGGL(trunk_fwd, dim3(grid), dim3(512), LDS_BYTES, stream, a);
#else
    for (int p = 0; p < N_PHASES; ++p) { a.ph_lo = p; a.ph_hi = p + 1; hipLaunchKernelGGL(trunk_fwd, dim3(grid), dim3(512), LDS_BYTES, stream, a); }
#endif
}
```

```cpp
#include <hip/hip_runtime.h>
#include <cstdio>
#include <cstdint>

#define LAS __attribute__((address_space(3)))
#define GAS __attribute__((address_space(1)))
typedef unsigned short bf16_t;
typedef short bf16x8 __attribute__((ext_vector_type(8)));
typedef short s16x4 __attribute__((ext_vector_type(4)));
typedef float f32x4 __attribute__((ext_vector_type(4)));
typedef float f32x2 __attribute__((ext_vector_type(2)));
typedef unsigned u32x4 __attribute__((ext_vector_type(4)));
typedef unsigned u32x2 __attribute__((ext_vector_type(2)));
#define DI __device__ __forceinline__

constexpr int D = 2048, NSEQ = 20, NPROMPT = 16, TP = 2064, TS = 4112, LP = 2048, LS = 4096, NMETA = 16;
constexpr int MPROMPT = NPROMPT * TP;
constexpr int MTOK = MPROMPT + 4 * TS;
constexpr int MP = 49664;
constexpr int DFF = 5632;
constexpr float NORM_EPS = 1e-6f;
DI int seq_off(int b) { return b < NPROMPT ? b * TP : MPROMPT + (b - NPROMPT) * TS; }
DI int seq_len(int b) { return b < NPROMPT ? TP : TS; }
DI void row_bt(int R, int& b, int& t) { if (R < MPROMPT) { b = R / TP; t = R - b * TP; } else { const int q = (R - MPROMPT) / TS; b = NPROMPT + q; t = R - MPROMPT - q * TS; } }

typedef __bf16 bf16v2_ __attribute__((ext_vector_type(2)));
DI unsigned cvt_pk_bf16(float lo, float hi) { const bf16v2_ r = __builtin_convertvector((f32x2){lo, hi}, bf16v2_); return __builtin_bit_cast(unsigned, r); }
DI float bf_lo(unsigned w) { return __uint_as_float(w << 16); }
DI float bf_hi(unsigned w) { return __uint_as_float(w & 0xffff0000u); }
DI float bf2f(bf16_t h) { return __uint_as_float(((unsigned)h) << 16); }
DI bf16_t f2bf(float f) { return (bf16_t)(cvt_pk_bf16(f, 0.f) & 0xffffu); }
DI float fast_rcp(float x) { return __builtin_amdgcn_rcpf(x); }
DI float sigmoidf_(float x) { return fast_rcp(1.f + __expf(-x)); }
DI float siluf_(float x) { return x * sigmoidf_(x); }
DI float softplusf_(float x) { return x > 20.f ? x : log1pf(__expf(x)); }
DI float softplus_lite(float x) { const float e = __expf(x), u = 1.f + e, d = u - 1.f; return x > 20.f ? x : (d == 0.f ? e : __logf(u) * e * fast_rcp(d)); }
DI float gelu_tanh_(float x) { const float u = 1.5957691216057308f * (x + 0.044715f * x * x * x); return x * sigmoidf_(u); }
DI int lane_id() { int r; asm volatile("v_mbcnt_lo_u32_b32 %0, -1, 0\n\tv_mbcnt_hi_u32_b32 %0, -1, %0" : "=&v"(r)); return r; }
DI float wave_sum(float v) {
#pragma unroll
    for (int o = 1; o < 64; o <<= 1) v += __shfl_xor(v, o);
    return v;
}

#define XB_TMO      128
#define XB_XCNT(j)  (256  + 64 * (j))
#define XB_XSUB(j)  (1280 + 64 * (j))
#define XB_XGEN(j)  (2304 + 64 * (j))
#define XB_TOP      3328
#define XB_TOPGEN   3392
#define XCD_BAR_WORDS 3456
#define XB_SPIN_CAP (1u << 22)
DI unsigned xb_ld(unsigned* p)              { return __hip_atomic_load(p, __ATOMIC_RELAXED, __HIP_MEMORY_SCOPE_AGENT); }
DI unsigned xb_add(unsigned* p, unsigned v) { return __hip_atomic_fetch_add(p, v, __ATOMIC_RELAXED, __HIP_MEMORY_SCOPE_AGENT); }
DI unsigned xb_xcc_id() { return (unsigned)__builtin_amdgcn_s_getreg((3 << 11) | 20) & 0xFu; }
#define XB_SPIN(cond, bar) do { unsigned _sp = 0; while (cond) { __builtin_amdgcn_s_sleep(1); \
    if ((++_sp & 255u) == 0u) { if (xb_ld(&(bar)[XB_TMO])) break; if (_sp > XB_SPIN_CAP) { atomicAdd(&(bar)[XB_TMO], 1u); break; } } } } while (0)
struct XcdBarrier { unsigned* bar; unsigned x; volatile LAS unsigned* st; };
DI XcdBarrier xcd_barrier_post(unsigned* bar, volatile LAS unsigned* st, bool leader) {
    XcdBarrier b; b.bar = bar; b.x = xb_xcc_id(); b.st = st;
    if (leader) (void)xb_add(&bar[XB_XCNT(b.x)], 1u);
    return b;
}
DI void xcd_barrier_complete(unsigned* bar, unsigned x, unsigned& nloc, unsigned& nx) {
    const unsigned G = gridDim.x * gridDim.y * gridDim.z;
    unsigned sum, cnt, mine, sp = 0u;
    for (;;) {
        sum = 0u; cnt = 0u; mine = 0u;
#pragma unroll
        for (unsigned j = 0; j < 16; ++j) { const unsigned c = xb_ld(&bar[XB_XCNT(j)]); sum += c; cnt += (c > 0u) ? 1u : 0u; mine = (j == x) ? c : mine; }
        if (sum == G) break;
        __builtin_amdgcn_s_sleep(1);
        if ((++sp & 255u) == 0u) { if (xb_ld(&bar[XB_TMO])) break; if (sp > XB_SPIN_CAP) { atomicAdd(&bar[XB_TMO], 1u); break; } }
    }
    nloc = mine > 0u ? mine : 1u; nx = cnt > 0u ? cnt : 1u;
}
DI void xcd_barrier(const XcdBarrier& b, bool leader) {
    asm volatile("s_waitcnt vmcnt(0)" ::: "memory");
    __syncthreads();
    if (leader) {
        unsigned* bar = b.bar;
        __builtin_amdgcn_s_waitcnt(0);
        unsigned nloc = b.st[0], nx = b.st[1];
        if (nloc == 0u) { xcd_barrier_complete(bar, b.x, nloc, nx); b.st[0] = nloc; b.st[1] = nx; }
        const unsigned old = xb_add(&bar[XB_XSUB(b.x)], 1u);
        const unsigned gen = old / nloc;
        if (old + 1u == (gen + 1u) * nloc) {
            __builtin_amdgcn_fence(__ATOMIC_RELEASE, "agent");
            asm volatile("s_waitcnt vmcnt(0)" ::: "memory");
            const unsigned og = xb_add(&bar[XB_TOP], 1u);
            const unsigned tg = og / nx;
            if (og + 1u == (tg + 1u) * nx) xb_add(&bar[XB_TOPGEN], 1u);
            else XB_SPIN(xb_ld(&bar[XB_TOPGEN]) == tg, bar);
            __builtin_amdgcn_fence(__ATOMIC_ACQUIRE, "agent");
            xb_add(&bar[XB_XGEN(b.x)], 1u);
            asm volatile("s_waitcnt vmcnt(0)" ::: "memory");
        } else {
            XB_SPIN(xb_ld(&bar[XB_XGEN(b.x)]) == gen, bar);
            __builtin_amdgcn_fence(__ATOMIC_ACQUIRE, "agent");
            asm volatile("s_waitcnt vmcnt(0)" ::: "memory");
        }
    }
    __syncthreads();
}

namespace pg8 {
constexpr int BM = 256, BK = 64, HALF = 128, HTB = HALF * BK * 2, STAGE_BYTES = 8 * HTB, NXCD = 8;
__host__ __device__ __forceinline__ int lds_byte(int r, int c) { const int st = (r >> 4) * 2 + (c >> 5), rr = r & 15, cc = c & 31, ob = rr * 64 + cc * 2; return st * 1024 + (ob ^ (((ob >> 9) & 1) << 5)); }
__host__ __device__ __forceinline__ void stage_rc(int b, int& R, int& C) { const int st = b / 1024, sb = b % 1024, swz = sb ^ (((sb >> 9) & 1) << 5); R = (st >> 1) * 16 + swz / 64; C = (st & 1) * 32 + (swz % 64) / 2; }
__host__ __device__ __forceinline__ int perm32(int rho) { const int n = rho >> 4, i = rho & 15; return 8 * (i >> 2) + 4 * n + (i & 3); }

struct Unit { int pm, pn; long aoff, boff; int nt, sub; };
struct Gemm { const char* A; const char* B; unsigned lda, ldb; long hstepA, hstepB; int nt; };
struct TileOrder {
    int nM, nN, nwg, G, c, WGM;
    DI void init(int nM_, int nN_, int G_, int c_, int wgm_ = 4) { nM = nM_; nN = nN_; nwg = nM * nN; G = G_; c = c_; WGM = wgm_; }
    DI bool tile(int i, int& pm, int& pn) const {
        const long L = (long)i * G + c; if (L >= nwg) return false;
        int wgid = (int)L; { const int q = nwg / NXCD, r = nwg % NXCD, xcd = wgid % NXCD, off = wgid / NXCD; wgid = (xcd < r ? xcd * (q + 1) : r * (q + 1) + (xcd - r) * q) + off; }
        const int nig = WGM * nN, gid = wgid / nig, fm = gid * WGM, gsz = (nM - fm) < WGM ? (nM - fm) : WGM;
        pm = fm + ((wgid % nig) % gsz); pn = (wgid % nig) / gsz; return true;
    }
};

template <class Epi, class Sched, bool ALIGN_EPI>
DI void gemm_phase(LAS unsigned char* lds, const Gemm g, const Sched& S, const Epi& E, int wave_id) {
    int tid_ = wave_id * 64 + lane_id(); asm volatile("" : "+v"(tid_));
    const int tid = tid_, wid = __builtin_amdgcn_readfirstlane(tid >> 6), lane = tid & 63, wr = wid >> 2, wc = wid & 3, fr = lane & 15, fq = lane >> 4;
    unsigned voffA[2], voffB[2];
#pragma unroll
    for (int i = 0; i < 2; ++i) { int R, C; stage_rc(tid * 16 + i * 8192, R, C); const int Rb = Epi::PERM ? ((R & ~31) + perm32(R & 31)) : R;
        voffA[i] = (unsigned)R * g.lda + (unsigned)C * 2u; voffB[i] = (unsigned)Rb * g.ldb + (unsigned)C * 2u; }
    const long kstep = (long)(BK * 2);
    const long hA = g.hstepA, hB = g.hstepB;
    const unsigned ldsw = (unsigned)wid * 1024u;
    const int aoff = lds_byte(wr * 64 + fr, fq * 8), boff = lds_byte(wc * 32 + fr, fq * 8);
#define PG8_SA(b, h) (((b) * 2 + (h)) * HTB)
#define PG8_SB(b, h) ((4 + (b) * 2 + (h)) * HTB)
#define PG8_STAGE(bufoff, gbase, voff) do { _Pragma("unroll") for (int _i = 0; _i < 2; ++_i) \
        __builtin_amdgcn_global_load_lds((const unsigned*)((const char*)(gbase) + (voff)[_i]), (LAS unsigned*)(lds + (bufoff) + ldsw + _i * 8192), 16, 0, 0); } while (0)
#define PG8_LDA(dst, b, h) do { _Pragma("unroll") for (int m = 0; m < 4; ++m) _Pragma("unroll") for (int k = 0; k < 2; ++k) dst[m][k] = *(const LAS bf16x8*)(lds + PG8_SA(b, h) + aoff + m * 2048 + k * 1024); } while (0)
#define PG8_LDB(dst, b, h) do { _Pragma("unroll") for (int n = 0; n < 2; ++n) _Pragma("unroll") for (int k = 0; k < 2; ++k) dst[n][k] = *(const LAS bf16x8*)(lds + PG8_SB(b, h) + boff + n * 2048 + k * 1024); } while (0)
#define PG8_MMA(ai, bj, At, Bt) do { __builtin_amdgcn_s_setprio(1); _Pragma("unroll") for (int m = 0; m < 4; ++m) _Pragma("unroll") for (int n = 0; n < 2; ++n) _Pragma("unroll") for (int k = 0; k < 2; ++k) \
        acc[ai][bj][m][n] = __builtin_amdgcn_mfma_f32_16x16x32_bf16(Bt[n][k], At[m][k], acc[ai][bj][m][n], 0, 0, 0); __builtin_amdgcn_s_setprio(0); } while (0)
#define PG8_WAIT_V(n) asm volatile("s_waitcnt vmcnt(" #n ")" ::: "memory")
#define PG8_WAIT_L(n) asm volatile("s_waitcnt lgkmcnt(" #n ")" ::: "memory")
#define PG8_BAR __builtin_amdgcn_s_barrier()
#define PG8_SCHED __builtin_amdgcn_sched_barrier(0)
    Unit cur, nxt; int ui = 0;
    if (!S.next(0, cur)) return;
    f32x4 acc[2][2][4][2];
#pragma unroll
    for (int a = 0; a < 2; ++a)
#pragma unroll
        for (int b = 0; b < 2; ++b)
#pragma unroll
            for (int m = 0; m < 4; ++m)
#pragma unroll
                for (int n = 0; n < 2; ++n) acc[a][b][m][n] = (f32x4){0.f, 0.f, 0.f, 0.f};
    bf16x8 At[4][2], B0[2][2], B1[2][2];
    const char* cA = g.A + cur.aoff; const char* cB = g.B + cur.boff;
    PG8_STAGE(PG8_SB(0, 0), cB, voffB); PG8_STAGE(PG8_SB(0, 1), cB + hB, voffB); PG8_STAGE(PG8_SA(0, 0), cA, voffA); PG8_STAGE(PG8_SA(0, 1), cA + hA, voffA);
    if (wr == 1) PG8_BAR;
    PG8_WAIT_V(2); PG8_BAR;
    PG8_STAGE(PG8_SB(1, 0), cB + kstep, voffB); PG8_STAGE(PG8_SA(1, 0), cA + kstep, voffA); PG8_STAGE(PG8_SB(1, 1), cB + hB + kstep, voffB);
    PG8_WAIT_V(6); PG8_BAR;
    for (;;) {
        const bool has_next = S.next(ui + 1, nxt);
        const char* nA = has_next ? g.A + nxt.aoff : cA; const char* nB = has_next ? g.B + nxt.boff : cB;
        const int nt = cur.nt;
        for (int t = 0; t < nt; t += 2) {
            const bool last = (t == nt - 2);
            const char* a1 = cA + (long)(t + 1) * kstep;
            const char* a2 = last ? nA : cA + (long)(t + 2) * kstep; const char* b2 = last ? nB : cB + (long)(t + 2) * kstep;
            const char* a3 = a2 + kstep; const char* b3 = b2 + kstep;
            PG8_LDB(B0, 0, 0); PG8_LDB(B1, 0, 1); PG8_SCHED; PG8_LDA(At, 0, 0); PG8_STAGE(PG8_SA(1, 1), a1 + hA, voffA);
            PG8_WAIT_V(8); PG8_WAIT_L(0); PG8_BAR; PG8_MMA(0, 0, At, B0); PG8_MMA(0, 1, At, B1); PG8_BAR; PG8_SCHED;
            PG8_LDA(At, 0, 1); PG8_STAGE(PG8_SB(0, 0), b2, voffB); PG8_STAGE(PG8_SB(0, 1), b2 + hB, voffB); PG8_STAGE(PG8_SA(0, 0), a2, voffA);
            PG8_WAIT_V(8); PG8_WAIT_L(0); PG8_BAR; PG8_MMA(1, 0, At, B0); PG8_MMA(1, 1, At, B1); PG8_BAR; PG8_SCHED;
            PG8_LDB(B0, 1, 0); PG8_LDB(B1, 1, 1); PG8_SCHED; PG8_LDA(At, 1, 0); PG8_STAGE(PG8_SA(0, 1), a2 + hA, voffA);
            PG8_WAIT_V(8); PG8_WAIT_L(0); PG8_BAR; PG8_MMA(0, 0, At, B0); PG8_MMA(0, 1, At, B1); PG8_BAR; PG8_SCHED;
            PG8_LDA(At, 1, 1); PG8_STAGE(PG8_SB(1, 0), b3, voffB); PG8_STAGE(PG8_SB(1, 1), b3 + hB, voffB); PG8_STAGE(PG8_SA(1, 0), a3, voffA);
            PG8_WAIT_V(8); PG8_WAIT_L(0); PG8_BAR; PG8_MMA(1, 0, At, B0); PG8_MMA(1, 1, At, B1); PG8_BAR; PG8_SCHED;
        }
        if constexpr (ALIGN_EPI) { if (wr == 0) PG8_BAR; }
        E(acc, cur, ui, wr, wc, fr, fq);
        if (!has_next) break;
#pragma unroll
        for (int a = 0; a < 2; ++a)
#pragma unroll
            for (int b = 0; b < 2; ++b)
#pragma unroll
                for (int m = 0; m < 4; ++m)
#pragma unroll
                    for (int n = 0; n < 2; ++n) acc[a][b][m][n] = (f32x4){0.f, 0.f, 0.f, 0.f};
        cur = nxt; cA = nA; cB = nB; ++ui;
        if constexpr (ALIGN_EPI) { if (wr == 1) PG8_BAR; }
    }
    PG8_WAIT_V(0);
    if constexpr (!ALIGN_EPI) { if (wr == 0) PG8_BAR; }
    PG8_BAR;
#undef PG8_SA
#undef PG8_SB
#undef PG8_STAGE
#undef PG8_LDA
#undef PG8_LDB
#undef PG8_MMA
#undef PG8_WAIT_V
#undef PG8_WAIT_L
#undef PG8_BAR
#undef PG8_SCHED
}
}
constexpr size_t MiB = (size_t)1 << 20;
constexpr size_t WS_CTL = 0, CTL_ZERO_BYTES = 64 * 1024;
constexpr size_t WS_WMIX = 1 * MiB, WS_WFFN = 67 * MiB, WS_XN = 133 * MiB, WS_H = 328 * MiB, WS_SCR = 716 * MiB, WS_END = 1524 * MiB;
constexpr size_t B194 = (size_t)MP * D * 2;
static_assert(B194 == 194 * MiB, "buffer size");
static_assert(WS_XN + 4096 + B194 <= WS_H && WS_H + 2 * B194 <= WS_SCR && WS_SCR + 4 * B194 <= WS_END, "ws map");
static_assert((size_t)MP * DFF * 2 <= WS_END - WS_SCR && (size_t)MP * 6144 * 2 <= WS_END - WS_SCR && WS_SCR + 4 * B194 + (size_t)MP * 128 <= WS_END, "scratch");
constexpr int CW_BAR = 1024;
constexpr int MISC_OFF = 163840 - 256, RING_BYTES = 131072, EDGE_OFF = 131072, EDGE_BYTES = 8192, LDS_BYTES = 163840;

struct Args { const float* in[30]; float* out; unsigned char* ws; int ph_lo, ph_hi; };

struct Frame {
    LAS unsigned char* lds;
    int wave, G, bid;
    DI int lane() const { return lane_id(); }
    DI int tid() const { return wave * 64 + lane_id(); }
    const float* const* in;
    float* out; unsigned char* ws;
    DI const float* I(int i) const { return in[i]; }
    DI bf16_t* XN() const { return (bf16_t*)(ws + WS_XN + 4096); }
    DI bf16_t* XC() const { return (bf16_t*)(ws + WS_H); }
    DI unsigned char* SCR() const { return ws + WS_SCR; }
    DI unsigned char* WMIX() const { return ws + WS_WMIX; }
    DI unsigned char* WFFN() const { return ws + WS_WFFN; }
};

struct SchedLin {
    pg8::TileOrder o; long a_base, a_tile, b_base, b_tile; int nt;
    DI bool next(int i, pg8::Unit& u) const { if (!o.tile(i, u.pm, u.pn)) return false; u.aoff = a_base + (long)u.pm * a_tile; u.boff = b_base + (long)u.pn * b_tile; u.nt = nt; u.sub = -1; return true; }
};
struct SchedGates {
    pg8::TileOrder o;
    DI bool next(int i, pg8::Unit& u) const { if (!o.tile(i, u.pm, u.pn)) return false; const int dir = u.pn >> 4, blk = (u.pn >> 1) & 7, hh = u.pn & 1;
        u.aoff = (long)u.pm * 256 * (D * 2) + blk * 512; u.boff = (long)((dir * 2) * 8 + blk) * 131072 + hh * 65536; u.nt = 4; u.sub = -1; return true; }
};

constexpr int RES_MAIN_PM = 192, RES_ROW0 = RES_MAIN_PM * 256, RES_NSPLIT = 4;
struct SchedRes {
    pg8::TileOrder o; long a_tile, b_base, b_tile; int nt; int G, c;
    DI void init(int G_, int c_, long a_tile_, long b_base_, long b_tile_, int nt_, int wgm_ = 4) { o.init(RES_MAIN_PM, 8, G_, c_, wgm_); G = G_; c = c_; a_tile = a_tile_; b_base = b_base_; b_tile = b_tile_; nt = nt_; }
    DI bool next(int i, pg8::Unit& u) const {
        const long L = (long)i * G + c;
        if (L < RES_MAIN_PM * 8) { o.tile(i, u.pm, u.pn); u.aoff = (long)u.pm * a_tile; u.boff = b_base + (long)u.pn * b_tile; u.nt = nt; u.sub = -1; return true; }
        const int r = (int)(L - RES_MAIN_PM * 8); if (r >= 16 * RES_NSPLIT) return false;
        const int s = r % RES_NSPLIT, t = r / RES_NSPLIT, nts = nt / RES_NSPLIT;
        u.pm = RES_MAIN_PM + (t >> 3); u.pn = t & 7; u.aoff = (long)u.pm * a_tile + (long)s * nts * 128; u.boff = b_base + (long)u.pn * b_tile + (long)s * nts * 128; u.nt = nts; u.sub = s; return true; }
};

DI float row_rs(const float* rsv, int row, int) { return rsv[row]; }
#ifndef NT_STORES
#define NT_STORES 0
#endif
template <class T> DI void st_stream(T* p, const T v) { if (NT_STORES) __builtin_nontemporal_store(v, p); else *p = v; }
DI u32x4 pack8(const f32x4 v0, const f32x4 v1) { u32x4 w; w.x = cvt_pk_bf16(v0[0], v0[1]); w.y = cvt_pk_bf16(v0[2], v0[3]); w.z = cvt_pk_bf16(v1[0], v1[1]); w.w = cvt_pk_bf16(v1[2], v1[3]); return w; }

struct EpiRgIn {
    static constexpr bool PERM = true;
    bf16_t* ygate; bf16_t* yrec; const float* ss;
    DI void operator()(const f32x4 (&acc)[2][2][4][2], const pg8::Unit& u, int, int wr, int wc, int fr, int fq) const {
        const bool isg = u.pn < 8; bf16_t* base = isg ? ygate : yrec; const int colt = (isg ? u.pn : u.pn - 8) * 256;
        const int row0 = u.pm * 256 + wr * 64 + fr, col0 = colt + wc * 32 + 8 * fq;
        float rs8[2][4];
#pragma unroll
        for (int ai = 0; ai < 2; ++ai)
#pragma unroll
            for (int m = 0; m < 4; ++m) rs8[ai][m] = row_rs(ss, row0 + ai * 128 + m * 16, fq);
#pragma unroll
        for (int ai = 0; ai < 2; ++ai)
#pragma unroll
            for (int m = 0; m < 4; ++m) { bf16_t* rowp = base + (size_t)(row0 + ai * 128 + m * 16) * D + col0; const float rs = rs8[ai][m];
#pragma unroll
                for (int bj = 0; bj < 2; ++bj) { f32x4 v0 = acc[ai][bj][m][0] * rs, v1 = acc[ai][bj][m][1] * rs;
                    if (isg) {
#pragma unroll
                        for (int j = 0; j < 4; ++j) { v0[j] = gelu_tanh_(v0[j]); v1[j] = gelu_tanh_(v1[j]); } }
                    st_stream((u32x4*)(rowp + bj * 128), pack8(v0, v1)); } }
    }
};
struct EpiPlainBf16 {
    static constexpr bool PERM = true;
    bf16_t* O; int ldc; const float* ss;
    DI void operator()(const f32x4 (&acc)[2][2][4][2], const pg8::Unit& u, int, int wr, int wc, int fr, int fq) const {
        const int row0 = u.pm * 256 + wr * 64 + fr, col0 = u.pn * 256 + wc * 32 + 8 * fq;
        float rs8[2][4];
#pragma unroll
        for (int ai = 0; ai < 2; ++ai)
#pragma unroll
            for (int m = 0; m < 4; ++m) rs8[ai][m] = row_rs(ss, row0 + ai * 128 + m * 16, fq);
#pragma unroll
        for (int ai = 0; ai < 2; ++ai)
#pragma unroll
            for (int m = 0; m < 4; ++m) { bf16_t* rowp = O + (size_t)(row0 + ai * 128 + m * 16) * ldc + col0; const float rs = rs8[ai][m];
#pragma unroll
                for (int bj = 0; bj < 2; ++bj) st_stream((u32x4*)(rowp + bj * 128), pack8(acc[ai][bj][m][0] * rs, acc[ai][bj][m][1] * rs)); }
    }
};
struct EpiGdnProj {
    static constexpr bool PERM = true;
    bf16_t* qkv; bf16_t* z; float* bg; const float* a_log; const float* dt_bias; bf16_t* halo; const float* ss;
    DI void operator()(const f32x4 (&acc)[2][2][4][2], const pg8::Unit& u, int, int wr, int wc, int fr, int fq) const {
        const int row0 = u.pm * 256 + wr * 64 + fr;
        float rs8[2][4];
#pragma unroll
        for (int ai = 0; ai < 2; ++ai)
#pragma unroll
            for (int m = 0; m < 4; ++m) rs8[ai][m] = row_rs(ss, row0 + ai * 128 + m * 16, fq);
        if (u.pn < 24) {
            bf16_t* base; int ldc, colt; if (u.pn < 16) { base = qkv; ldc = 4096; colt = u.pn * 256; } else { base = z; ldc = 2048; colt = (u.pn - 16) * 256; }
            const int col0 = colt + wc * 32 + 8 * fq;
#pragma unroll
            for (int ai = 0; ai < 2; ++ai)
#pragma unroll
                for (int m = 0; m < 4; ++m) { const int row = row0 + ai * 128 + m * 16; bf16_t* rowp = base + (size_t)row * ldc + col0;
                    const int r64 = row & 63, rb = row >> 6;
                    bf16_t* hp = nullptr;
                    if (u.pn < 16) { if (r64 == 63) hp = halo + ((size_t)(rb + 1) * 3 + 0) * 4096 + col0; else if (r64 == 0 && rb > 0) hp = halo + ((size_t)(rb - 1) * 3 + 1) * 4096 + col0; else if (r64 == 1 && rb > 0) hp = halo + ((size_t)(rb - 1) * 3 + 2) * 4096 + col0; }
                    const float rs = rs8[ai][m];
#pragma unroll
                    for (int bj = 0; bj < 2; ++bj) { const u32x4 w = pack8(acc[ai][bj][m][0] * rs, acc[ai][bj][m][1] * rs); st_stream((u32x4*)(rowp + bj * 128), w); if (hp) *(u32x4*)(hp + bj * 128) = w; } }
        } else {
            const int c0 = wc * 32 + 8 * fq;
            float al[8], db[8];
#pragma unroll
            for (int j = 0; j < 8; ++j) { const int c = c0 + j; al[j] = c >= 64 ? __expf(a_log[c - 64]) : 0.f; db[j] = c >= 64 ? dt_bias[c - 64] : 0.f; }
#pragma unroll
            for (int ai = 0; ai < 2; ++ai)
#pragma unroll
                for (int m = 0; m < 4; ++m) { float* rowp = bg + (size_t)(row0 + ai * 128 + m * 16) * 128 + c0; const float rs = rs8[ai][m];
                    f32x4 o[2];
#pragma unroll
                    for (int n = 0; n < 2; ++n)
#pragma unroll
                        for (int j = 0; j < 4; ++j) { const float x = acc[ai][0][m][n][j] * rs; const int jj = n * 4 + j;
                            o[n][j] = (c0 >= 64) ? -al[jj] * softplusf_(x + db[jj]) : sigmoidf_(x); }
                    *(f32x4*)(rowp) = o[0]; *(f32x4*)(rowp + 4) = o[1]; }
        }
    }
};
struct EpiResAdd {
    static constexpr bool PERM = true;
    const bf16_t* xin; bf16_t* xn; float* ss; float* slab;
    DI void operator()(const f32x4 (&acc)[2][2][4][2], const pg8::Unit& u, int, int wr, int wc, int fr, int fq) const {
        const int row0 = u.pm * 256 + wr * 64 + fr, col0 = u.pn * 256 + wc * 32 + 8 * fq;
        if (u.sub >= 0) {
#pragma unroll
            for (int ai = 0; ai < 2; ++ai)
#pragma unroll
                for (int m = 0; m < 4; ++m) { float* sp = slab + ((size_t)u.sub * 512 + (row0 + ai * 128 + m * 16 - RES_ROW0)) * D + col0;
#pragma unroll
                    for (int bj = 0; bj < 2; ++bj) { *(f32x4*)(sp + bj * 128) = acc[ai][bj][m][0]; *(f32x4*)(sp + bj * 128 + 4) = acc[ai][bj][m][1]; } }
            return; }
        const int l_ = lane_id(); const unsigned voff = (unsigned)((l_ & 15) * D + 8 * (l_ >> 4)) * 2u;
        const char* xi_u = (const char*)xin + ((size_t)(u.pm * 256 + wr * 64) * D + u.pn * 256 + wc * 32) * 2;
        char* xn_u = (char*)xn + ((size_t)(u.pm * 256 + wr * 64) * D + u.pn * 256 + wc * 32) * 2;
        u32x4 v[2][4][2];
#pragma unroll
        for (int ai = 0; ai < 2; ++ai)
#pragma unroll
            for (int m = 0; m < 4; ++m)
#pragma unroll
                for (int bj = 0; bj < 2; ++bj) v[ai][m][bj] = *(const u32x4*)(xi_u + (size_t)(ai * 128 + m * 16) * (D * 2) + bj * 256 + voff);
#pragma unroll
        for (int ai = 0; ai < 2; ++ai) {
#pragma unroll
            for (int m = 0; m < 4; ++m) { const int row = row0 + ai * 128 + m * 16; char* rowp = xn_u + (size_t)(ai * 128 + m * 16) * (D * 2);
                float sq = 0.f;
#pragma unroll
                for (int bj = 0; bj < 2; ++bj) { const u32x4 vv = v[ai][m][bj];
                    const f32x4 h0 = (f32x4){bf_lo(vv.x), bf_hi(vv.x), bf_lo(vv.y), bf_hi(vv.y)} + acc[ai][bj][m][0], h1 = (f32x4){bf_lo(vv.z), bf_hi(vv.z), bf_lo(vv.w), bf_hi(vv.w)} + acc[ai][bj][m][1];
                    const u32x4 w = pack8(h0, h1); *(u32x4*)(rowp + bj * 256 + voff) = w;
                    if (ss) { const float r0 = bf_lo(w.x), r1 = bf_hi(w.x), r2 = bf_lo(w.y), r3 = bf_hi(w.y), r4 = bf_lo(w.z), r5 = bf_hi(w.z), r6 = bf_lo(w.w), r7 = bf_hi(w.w);
                        sq += ((r0 * r0 + r1 * r1) + (r2 * r2 + r3 * r3)) + ((r4 * r4 + r5 * r5) + (r6 * r6 + r7 * r7)); } }
                if (ss) { sq += __shfl_xor(sq, 16); sq += __shfl_xor(sq, 32); if (fq == 0) ss[((size_t)u.pm * 32 + u.pn * 4 + wc) * 256 + (row & 255)] = sq; } }
        }
    }
};
#ifndef GATES_TOP
#define GATES_TOP 4
#endif
struct EpiGates {
    static constexpr bool PERM = true;
    const bf16_t* xc; bf16_t* la; bf16_t* uu;
    size_t dstride; const float* b_a; const float* b_i; const float* lam;
    LAS float* cl;
    DI void operator()(const f32x4 (&acc)[2][2][4][2], const pg8::Unit& u, int, int wr, int wc, int fr, int fq) const {
        const int dir = u.pn >> 4, blk = (u.pn >> 1) & 7, hh = u.pn & 1;
        const int row0 = u.pm * 256 + wr * 64 + fr, c0 = blk * 256 + hh * 128 + wc * 32 + 8 * fq;
        LAS float* cw_ = cl + (wr * 4 + wc) * 96;
        { const int lane = lane_id(); if (lane < 32) { const int c = dir * D + blk * 256 + hh * 128 + wc * 32 + lane;
            cw_[lane] = b_a[c]; cw_[32 + lane] = b_i[c]; cw_[64 + lane] = -8.0f * softplus_lite(-lam[c]); } }
        const int l_ = lane_id(); const unsigned voff = (unsigned)((l_ & 15) * D + 8 * (l_ >> 4)) * 2u;
        const size_t uoff = ((size_t)(u.pm * 256 + wr * 64) * D + blk * 256 + hh * 128 + wc * 32) * 2;
        const char* xc_u = (const char*)xc + uoff; char* la_u = (char*)(la + dir * dstride) + uoff; char* uu_u = (char*)(uu + dir * dstride) + uoff;
        u32x4 xw4[2][4];
#pragma unroll
        for (int g = 0; g < GATES_TOP; ++g) xw4[g >> 2][g & 3] = *(const u32x4*)(xc_u + (size_t)((g >> 2) * 128 + (g & 3) * 16) * (D * 2) + voff);
#pragma unroll
        for (int ai = 0; ai < 2; ++ai) {
#pragma unroll
            for (int m = 0; m < 4; ++m) { const size_t off = (size_t)(ai * 128 + m * 16) * (D * 2);
                const u32x4 xw = xw4[ai][m];
                float xv[8]; xv[0] = bf_lo(xw.x); xv[1] = bf_hi(xw.x); xv[2] = bf_lo(xw.y); xv[3] = bf_hi(xw.y); xv[4] = bf_lo(xw.z); xv[5] = bf_hi(xw.z); xv[6] = bf_lo(xw.w); xv[7] = bf_hi(xw.w);
                f32x4 lo[2], uo[2];
#pragma unroll
                for (int n = 0; n < 2; ++n) { LAS float* cp = cw_ + 8 * fq; asm volatile("" : "+v"(cp));
                    const f32x4 ba = *(const LAS f32x4*)(cp + 4 * n), bi = *(const LAS f32x4*)(cp + 32 + 4 * n), sp = *(const LAS f32x4*)(cp + 64 + 4 * n);
#pragma unroll
                    for (int j = 0; j < 4; ++j) { const int jj = n * 4 + j;
                        const float r = sigmoidf_(acc[ai][0][m][n][j] + ba[j]), ig = sigmoidf_(acc[ai][1][m][n][j] + bi[j]);
                        const float l = sp[j] * r;
                        lo[n][j] = l; const float x2 = 2.0f * l;
                        const float om_e = 1.0f - __expf(x2), om_s = -x2 * (1.0f + 0.5f * x2);
                        const float om = x2 > -0.0009765625f ? om_s : om_e;
                        uo[n][j] = __builtin_amdgcn_sqrtf(fmaxf(om, 0.f)) * (ig * xv[jj]); }
                    __builtin_amdgcn_sched_barrier(0); }
                *(u32x4*)(la_u + off + voff) = pack8(lo[0], lo[1]);
                *(u32x4*)(uu_u + off + voff) = pack8(uo[0], uo[1]);
                __builtin_amdgcn_sched_barrier(0);
                if (ai == 0 && m == 0) {
#pragma unroll
                    for (int g = GATES_TOP; g < 8; ++g) xw4[g >> 2][g & 3] = *(const u32x4*)(xc_u + (size_t)((g >> 2) * 128 + (g & 3) * 16) * (D * 2) + voff);
                    __builtin_amdgcn_sched_barrier(0); } }
        }
    }
};
struct EpiFfnUp {
    static constexpr bool PERM = true;
    bf16_t* act; const float* cw; const float* cb; LAS float* edge; const float* ss; const unsigned char* rflag;
    DI void operator()(f32x4 (&acc)[2][2][4][2], const pg8::Unit& u, int ui, int wr, int wc, int fr, int fq) const {
        const int lane = fq * 16 + fr;
        LAS float* ef = edge + (ui & 1) * 1024, * el = ef + 512;
        LAS float* tapl = edge + 2048 + (wr * 4 + wc) * 128;
        const int cg0 = wc * 32 + 8 * fq;
        float rs8[2][4]; unsigned flp[2] = {0u, 0u};
#pragma unroll
        for (int ai = 0; ai < 2; ++ai)
#pragma unroll
            for (int m = 0; m < 4; ++m) { const int r = 128 * ai + 64 * wr + 16 * m + fr; const int R = 254 * u.pm - 1 + r; const int Rc = R < 0 ? 0 : R;
                rs8[ai][m] = row_rs(ss, Rc, fq); flp[ai] |= ((__float_as_uint(rs8[ai][m]) & 3u) | ((r >= 1 && r <= 254 && R < MTOK) ? 4u : 0u)) << (8 * m); }
        if (lane < 32) { const int a = lane >> 3, c = lane & 7; const float* src = (a < 3 ? cw + (size_t)a * DFF : cb) + u.pn * 128 + wc * 32 + 4 * c;
            *(LAS f32x4*)(tapl + a * 32 + 4 * c) = *(const f32x4*)src; }
#pragma unroll
        for (int ai = 0; ai < 2; ++ai)
#pragma unroll
            for (int m = 0; m < 4; ++m)
#pragma unroll
                for (int bj = 0; bj < 2; ++bj)
#pragma unroll
                    for (int n = 0; n < 2; ++n) acc[ai][bj][m][n] = acc[ai][bj][m][n] * rs8[ai][m];
        __builtin_amdgcn_sched_barrier(0);
#pragma unroll
        for (int ai = 0; ai < 2; ++ai) { const int sg = 2 * ai + wr;
            if (fr == 0) { *(LAS f32x4*)(ef + sg * 128 + cg0) = acc[ai][0][0][0]; *(LAS f32x4*)(ef + sg * 128 + cg0 + 4) = acc[ai][0][0][1]; }
            if (fr == 15) { *(LAS f32x4*)(el + sg * 128 + cg0) = acc[ai][0][3][0]; *(LAS f32x4*)(el + sg * 128 + cg0 + 4) = acc[ai][0][3][1]; } }
        asm volatile("s_waitcnt lgkmcnt(0)" ::: "memory"); __builtin_amdgcn_s_barrier(); asm volatile("" ::: "memory");
        const int cf0 = u.pn * 128 + cg0;
#ifdef FFU_EPI_REP
        int reps_ = FFU_EPI_REP; asm volatile("" : "+s"(reps_));
        for (int rep_ = 0; rep_ < reps_; ++rep_)
#endif
#pragma unroll
        for (int ai = 0; ai < 2; ++ai) { const int sg = 2 * ai + wr;
#pragma unroll
            for (int n = 0; n < 2; ++n) {
                const f32x4 w0 = *(const LAS f32x4*)(tapl + 8 * fq + 4 * n), w1 = *(const LAS f32x4*)(tapl + 32 + 8 * fq + 4 * n), w2 = *(const LAS f32x4*)(tapl + 64 + 8 * fq + 4 * n), bb = *(const LAS f32x4*)(tapl + 96 + 8 * fq + 4 * n);
                const f32x4 htop = sg > 0 ? *(LAS f32x4*)(el + (sg - 1) * 128 + cg0 + 4 * n) : (f32x4){0.f, 0.f, 0.f, 0.f};
                const f32x4 hbot = sg < 3 ? *(LAS f32x4*)(ef + (sg + 1) * 128 + cg0 + 4 * n) : (f32x4){0.f, 0.f, 0.f, 0.f};
                unsigned pk[4][2];
#pragma unroll
                for (int jp = 0; jp < 2; ++jp) {
                    float rr[2][4];
#pragma unroll
                    for (int j2 = 0; j2 < 2; ++j2) { const int j = 2 * jp + j2;
                        float v[4], upv[4], dnv[4];
#pragma unroll
                        for (int m = 0; m < 4; ++m) { v[m] = acc[ai][0][m][n][j];
                            upv[m] = __int_as_float(__builtin_amdgcn_update_dpp(0, __float_as_int(v[m]), 0x121, 0xf, 0xf, false));
                            dnv[m] = __int_as_float(__builtin_amdgcn_update_dpp(0, __float_as_int(v[m]), 0x12F, 0xf, 0xf, false)); }
#pragma unroll
                        for (int m = 0; m < 4; ++m) {
                            float pv = fr > 0 ? upv[m] : (m > 0 ? upv[m > 0 ? m - 1 : 0] : htop[j]);
                            float nv = fr < 15 ? dnv[m] : (m < 3 ? dnv[m < 3 ? m + 1 : 3] : hbot[j]);
                            pv = (flp[ai] & (1u << (8 * m))) ? 0.f : pv; nv = (flp[ai] & (2u << (8 * m))) ? 0.f : nv;
                            const float a = w0[j] * pv + w1[j] * v[m] + w2[j] * nv + bb[j];
                            rr[j2][m] = siluf_(a) * acc[ai][1][m][n][j]; } }
#pragma unroll
                    for (int m = 0; m < 4; ++m) pk[m][jp] = cvt_pk_bf16(rr[0][m], rr[1][m]);
                    __builtin_amdgcn_sched_barrier(0);
                }
#pragma unroll
                for (int m = 0; m < 4; ++m) if (flp[ai] & (4u << (8 * m))) { u32x2 w; w.x = pk[m][0]; w.y = pk[m][1];
                    st_stream((u32x2*)(act + (size_t)(254 * u.pm - 1 + 128 * ai + 64 * wr + 16 * m + fr) * DFF + cf0 + 4 * n), w); }
                __builtin_amdgcn_sched_barrier(0);
            }
        }
    }
};
#define LDS_WAIT() asm volatile("s_waitcnt lgkmcnt(0)" ::: "memory")
DI void cvt_item(const float* W, int ldw, int col0, bf16_t* WT, int ldt, int k0, int n0, LAS float* scr, int lane, const float* gain = nullptr) {
    { float w[32]; const float* wp = W + (size_t)(k0 + (lane >> 5)) * ldw + col0 + n0 + (lane & 31);
#pragma unroll
        for (int i = 0; i < 32; ++i) w[i] = wp[(size_t)(2 * i) * ldw];
        if (gain) {
#pragma unroll
            for (int i = 0; i < 32; ++i) w[i] *= gain[k0 + 2 * i + (lane >> 5)]; }
#pragma unroll
        for (int i = 0; i < 32; ++i) scr[(2 * i + (lane >> 5)) * 33 + (lane & 31)] = w[i]; }
    LDS_WAIT(); asm volatile("" ::: "memory");
    const int c = lane & 7;
#pragma unroll
    for (int j = 0; j < 4; ++j) { const int n = (lane >> 3) + 8 * j; const LAS float* s = scr + (8 * c) * 33 + n;
        u32x4 o; o.x = cvt_pk_bf16(s[0 * 33], s[1 * 33]); o.y = cvt_pk_bf16(s[2 * 33], s[3 * 33]); o.z = cvt_pk_bf16(s[4 * 33], s[5 * 33]); o.w = cvt_pk_bf16(s[6 * 33], s[7 * 33]);
        *(u32x4*)(WT + (size_t)(n0 + n) * ldt + k0 + 8 * c) = o; }
    LDS_WAIT(); asm volatile("" ::: "memory");
}
struct CvtCursor { int cur, base, step; };
DI void cvt_job(CvtCursor& cc, const float* W, int ldw, int col0, int ncols, int K, bf16_t* WT, int ldt, LAS float* scr, int lane, const float* gain = nullptr) {
    const int nb = ncols / 32, n = (K / 64) * nb;
    while (cc.cur < cc.base + n) { const int it = cc.cur - cc.base; cvt_item(W, ldw, col0, WT, ldt, 64 * (it / nb), 32 * (it % nb), scr, lane, gain); cc.cur += cc.step; }
    cc.base += n;
}
DI void cvt_ffn(Frame& F, CvtCursor& cc, int li, LAS float* scr) {
    bf16_t* wg = (bf16_t*)F.WFFN(); bf16_t* wu = wg + (size_t)DFF * D; bf16_t* wd = wu + (size_t)DFF * D;
    cvt_job(cc, F.I(25) + (size_t)li * D * DFF, DFF, 0, DFF, D, wg, D, scr, F.lane(), F.I(4) + (size_t)li * D);
    cvt_job(cc, F.I(26) + (size_t)li * D * DFF, DFF, 0, DFF, D, wu, D, scr, F.lane(), F.I(4) + (size_t)li * D);
    cvt_job(cc, F.I(29) + (size_t)li * DFF * D, D, 0, D, DFF, wd, DFF, scr, F.lane());
}
DI void cvt_rg(Frame& F, CvtCursor& cc, int j, int li, LAS float* scr) {
    bf16_t* win = (bf16_t*)F.WMIX(); bf16_t* gates = win + (size_t)4096 * D; bf16_t* wout = gates + (size_t)32 * 65536;
    cvt_job(cc, F.I(6) + (size_t)j * D * 4096, 4096, 0, 4096, D, win, D, scr, F.lane(), F.I(3) + (size_t)li * D);
    {
        const int n = 32 * 32;
        while (cc.cur < cc.base + n) { const int it = cc.cur - cc.base; const int bid = it >> 5, sub = it & 31; const int gate = bid >> 4, dir = (bid >> 3) & 1, blk = bid & 7;
            const float* src = F.I(gate ? 11 : 9) + (size_t)((j * 2 + dir) * 8 + blk) * 65536;
            cvt_item(src, 256, 0, gates + (size_t)((dir * 2 + gate) * 8 + blk) * 65536, 256, 64 * (sub >> 3), 32 * (sub & 7), scr, F.lane()); cc.cur += cc.step; }
        cc.base += n; }
    cvt_job(cc, F.I(14) + (size_t)j * D * D, D, 0, D, D, wout, D, scr, F.lane());
}
DI void cvt_na(Frame& F, CvtCursor& cc, LAS float* scr) {
    bf16_t* wqkv = (bf16_t*)F.WMIX(); bf16_t* wo = wqkv + (size_t)6144 * D;
    cvt_job(cc, F.I(15), 6144, 0, 6144, D, wqkv, D, scr, F.lane(), F.I(3) + (size_t)1 * D);
    cvt_job(cc, F.I(18), D, 0, D, D, wo, D, scr, F.lane());
}
DI void cvt_gdn(Frame& F, CvtCursor& cc, LAS float* scr) {
    bf16_t* w0 = (bf16_t*)F.WMIX(); bf16_t* w1 = w0 + (size_t)6400 * D; bf16_t* wout = w1 + (size_t)6144 * D;
    const float* W = F.I(19);
    for (int g = 0; g < 2; ++g) { bf16_t* w = g ? w1 : w0;
        cvt_job(cc, W, 12416, g * 1024, 1024, D, w, D, scr, F.lane(), F.I(3) + (size_t)2 * D);
        cvt_job(cc, W, 12416, 2048 + g * 1024, 1024, D, w + (size_t)1024 * D, D, scr, F.lane(), F.I(3) + (size_t)2 * D);
        cvt_job(cc, W, 12416, 4096 + g * 2048, 2048, D, w + (size_t)2048 * D, D, scr, F.lane(), F.I(3) + (size_t)2 * D);
        cvt_job(cc, W, 12416, 8192 + g * 2048, 2048, D, w + (size_t)4096 * D, D, scr, F.lane(), F.I(3) + (size_t)2 * D); }
    cvt_job(cc, W, 12416, 12288, 128, D, w0 + (size_t)6144 * D, D, scr, F.lane(), F.I(3) + (size_t)2 * D);
    cvt_job(cc, F.I(24), D, 0, D, 4096, wout, 4096, scr, F.lane());
}

DI float rs_tag(int R, float rs) { int b, t; row_bt(R, b, t); const unsigned f = (t == 0 ? 1u : 0u) | ((b < NSEQ && t == seq_len(b) - 1) ? 2u : 0u); return __uint_as_float((__float_as_uint(rs) & ~3u) | f); }
template <int MODE> DI void norm_phase(Frame& F, bf16_t* X, const float* gain, float* rsv, const bf16_t* xin2 = nullptr, const float* slab = nullptr) {
    const int gw = F.bid * 8 + F.wave, NGW = F.G * 8, lane = F.lane();
    if (MODE == 1) {
        for (int i = F.bid * 512 + F.tid(); i < (MP - MTOK + 1) * (D / 8); i += F.G * 512) { const int r = i / (D / 8), c = i % (D / 8); const int R = r == 0 ? -1 : MTOK + r - 1;
            *(u32x4*)(X + (long)R * D + c * 8) = (u32x4){0u, 0u, 0u, 0u}; }
        for (int i = F.bid * 512 + F.tid(); i < MP - MTOK; i += F.G * 512) rsv[MTOK + i] = 0.f;
    }
    for (int R = gw; R < MTOK; R += NGW) {
        int b, t; row_bt(R, b, t);
        bf16_t* xr = X + (size_t)R * D;
        if (MODE == 2 && t < NMETA) continue;
        f32x4 v[8]; float s = 0.f;
        if (MODE == 1) {
            const float* src; if (t < NMETA) src = F.I(2) + (size_t)t * D; else if (b < NPROMPT) src = F.I(0) + ((size_t)b * LP + (t - NMETA)) * D; else src = F.I(1) + ((size_t)(b - NPROMPT) * LS + (t - NMETA)) * D;
#pragma unroll
            for (int j = 0; j < 8; ++j) { const f32x4 x = *(const f32x4*)(src + 4 * (lane + 64 * j)); u32x2 w; w.x = cvt_pk_bf16(x[0], x[1]); w.y = cvt_pk_bf16(x[2], x[3]); *(u32x2*)(xr + 4 * (lane + 64 * j)) = w;
                v[j] = (f32x4){bf_lo(w.x), bf_hi(w.x), bf_lo(w.y), bf_hi(w.y)}; }
        } else {
#pragma unroll
            for (int j = 0; j < 8; ++j) { const u32x2 w = *(const u32x2*)((R >= RES_ROW0 && xin2 ? xin2 + (size_t)R * D : xr) + 4 * (lane + 64 * j)); v[j] = (f32x4){bf_lo(w.x), bf_hi(w.x), bf_lo(w.y), bf_hi(w.y)}; }
            if (R >= RES_ROW0 && slab) {
#pragma unroll
                for (int s = 0; s < RES_NSPLIT; ++s)
#pragma unroll
                    for (int j = 0; j < 8; ++j) v[j] += *(const f32x4*)(slab + ((size_t)s * 512 + (R - RES_ROW0)) * D + 4 * (lane + 64 * j));
#pragma unroll
                for (int j = 0; j < 8; ++j) { const unsigned w0 = cvt_pk_bf16(v[j][0], v[j][1]), w1 = cvt_pk_bf16(v[j][2], v[j][3]); v[j] = (f32x4){bf_lo(w0), bf_hi(w0), bf_lo(w1), bf_hi(w1)}; } }
        }
#pragma unroll
        for (int j = 0; j < 8; ++j) s += (v[j][0] * v[j][0] + v[j][1] * v[j][1]) + (v[j][2] * v[j][2] + v[j][3] * v[j][3]);
        const float rs = 1.0f / sqrtf(wave_sum(s) * (1.0f / D) + NORM_EPS);
        if (MODE == 1) { if (lane == 0) rsv[R] = rs_tag(R, rs); }
        else {
            float* orow = F.out + (b < NPROMPT ? ((size_t)b * LP + (t - NMETA)) : ((size_t)NPROMPT * LP + (size_t)(b - NPROMPT) * LS + (t - NMETA))) * D;
#pragma unroll
            for (int j = 0; j < 8; ++j) { const f32x4 gv = *(const f32x4*)(gain + 4 * (lane + 64 * j)); *(f32x4*)(orow + 4 * (lane + 64 * j)) = v[j] * rs * gv; }
        }
    }
}
DI void ss_final_phase(Frame& F, const float* ssp, float* rsv, const bf16_t* xin, bf16_t* xout, const float* slab0, const float* slab1) {
    for (int R = F.bid * 512 + F.tid(); R < RES_ROW0; R += F.G * 512) { const float* p = ssp + (size_t)(R >> 8) * 32 * 256 + (R & 255); float s = 0.f;
#pragma unroll
        for (int i = 0; i < 8; ++i) s += (p[(4 * i) * 256] + p[(4 * i + 1) * 256]) + (p[(4 * i + 2) * 256] + p[(4 * i + 3) * 256]);
        rsv[R] = rs_tag(R, 1.0f / sqrtf(s * (1.0f / D) + NORM_EPS)); }
    const int lane = F.lane();
    for (int R = RES_ROW0 + F.bid * 8 + F.wave; R < MP; R += F.G * 8) {
        float v[32];
#pragma unroll
        for (int i = 0; i < 4; ++i) { const u32x4 x = *(const u32x4*)(xin + (size_t)R * D + lane * 32 + 8 * i); const unsigned w[4] = {x.x, x.y, x.z, x.w};
#pragma unroll
            for (int k = 0; k < 4; ++k) { v[8 * i + 2 * k] = bf_lo(w[k]); v[8 * i + 2 * k + 1] = bf_hi(w[k]); } }
#pragma unroll
        for (int set = 0; set < 2; ++set) { const float* sl = set ? slab1 : slab0; if (!sl) continue;
#pragma unroll
            for (int s = 0; s < RES_NSPLIT; ++s) { const float* p = sl + ((size_t)s * 512 + (R - RES_ROW0)) * D + lane * 32;
#pragma unroll
                for (int i = 0; i < 8; ++i) { const f32x4 a = *(const f32x4*)(p + 4 * i); v[4 * i] += a[0]; v[4 * i + 1] += a[1]; v[4 * i + 2] += a[2]; v[4 * i + 3] += a[3]; } } }
        float sq = 0.f;
#pragma unroll
        for (int i = 0; i < 4; ++i) { u32x4 w; unsigned ww[4];
#pragma unroll
            for (int k = 0; k < 4; ++k) { ww[k] = cvt_pk_bf16(v[8 * i + 2 * k], v[8 * i + 2 * k + 1]); const float a = bf_lo(ww[k]), b = bf_hi(ww[k]); sq += a * a + b * b; }
            w.x = ww[0]; w.y = ww[1]; w.z = ww[2]; w.w = ww[3]; *(u32x4*)(xout + (size_t)R * D + lane * 32 + 8 * i) = w; }
        const float tot = wave_sum(sq);
        if (lane == 0) rsv[R] = rs_tag(R, 1.0f / sqrtf(tot * (1.0f / D) + NORM_EPS));
    }
}
DI void fill_rflag(Frame& F, unsigned char* rf) { for (int R = F.bid * 512 + F.tid(); R < MP; R += F.G * 512) { int b, t; row_bt(R, b, t); rf[R] = (unsigned char)((t == 0 ? 1 : 0) | ((b < NSEQ && t == seq_len(b) - 1) ? 2 : 0)); } }

DI void rg_conv_phase(Frame& F, const bf16_t* yrec, bf16_t* xc, const float* cw, const float* cb) {
    const int tid = F.tid(), cg = tid & 255, c0 = cg * 8;
    float w[4][8], bb[8];
#pragma unroll
    for (int j = 0; j < 4; ++j)
#pragma unroll
        for (int e = 0; e < 8; ++e) w[j][e] = cw[j * D + c0 + e];
#pragma unroll
    for (int e = 0; e < 8; ++e) bb[e] = cb[c0 + e];
    for (int s = F.bid * 2 + (tid >> 8); s < MTOK / 16; s += F.G * 2) {
        const int R0 = 16 * s; int b, t0; row_bt(R0, b, t0); const int T = seq_len(b);
        const bf16_t* yp = yrec + (size_t)R0 * D + c0;
        u32x4 x0 = (u32x4){0u, 0u, 0u, 0u}, x1, x2, x3;
        if (t0 > 0) x0 = *(const u32x4*)(yp - D);
        x1 = *(const u32x4*)(yp); x2 = *(const u32x4*)(yp + D); x3 = *(const u32x4*)(yp + 2 * D);
#pragma unroll
        for (int i = 0; i < 16; ++i) {
            u32x4 xn = (u32x4){0u, 0u, 0u, 0u};
            if (i < 15 && t0 + i + 3 < T) xn = *(const u32x4*)(yp + (size_t)(i + 3) * D);
            float a[8];
#pragma unroll
            for (int e = 0; e < 8; ++e) a[e] = bb[e];
            const u32x4 xs[4] = {x0, x1, x2, x3};
#pragma unroll
            for (int j = 0; j < 4; ++j) { const u32x4 x = xs[j];
                a[0] += w[j][0] * bf_lo(x.x); a[1] += w[j][1] * bf_hi(x.x); a[2] += w[j][2] * bf_lo(x.y); a[3] += w[j][3] * bf_hi(x.y);
                a[4] += w[j][4] * bf_lo(x.z); a[5] += w[j][5] * bf_hi(x.z); a[6] += w[j][6] * bf_lo(x.w); a[7] += w[j][7] * bf_hi(x.w); }
            u32x4 o; o.x = cvt_pk_bf16(a[0], a[1]); o.y = cvt_pk_bf16(a[2], a[3]); o.z = cvt_pk_bf16(a[4], a[5]); o.w = cvt_pk_bf16(a[6], a[7]);
            *(u32x4*)(xc + (size_t)(R0 + i) * D + c0) = o;
            x0 = x1; x1 = x2; x2 = x3; x3 = xn;
        }
    }
}

template <int N, bool REV> DI void rg_ld(const bf16_t* p, size_t base, int t0, unsigned (&w)[8]) {
#pragma unroll
    for (int i = 0; i < 8; ++i) if (i < N) w[i] = *(const unsigned*)(p + base + (size_t)(REV ? t0 - i : t0 + i) * D);
}
DI void rg_scan_phase(Frame& F, const bf16_t* laf, const bf16_t* uf, const bf16_t* lab, bf16_t* ub, const bf16_t* ygate) {
    int tid_ = F.wave * 64 + lane_id(); asm volatile("" : "+v"(tid_));
    const int tid = tid_, lane = tid & 63, wave = __builtin_amdgcn_readfirstlane(tid >> 6), seg = 2 * wave + (lane >> 5), l32 = lane & 31;
    LAS float* AGG = (LAS float*)F.lds;
    LAS float* CB = AGG + 2 * 16 * 256;
    int items[3]; int ni = 0;
    if (F.G == 256) { if (F.bid < 128) { items[0] = F.bid; items[1] = 128 + F.bid; items[2] = 0; ni = 2; } else { const int b0 = 256 + 3 * (F.bid - 128); items[0] = b0; items[1] = b0 + 1; items[2] = b0 + 2; ni = 3; } }
    for (int ii = 0; ; ++ii) {
        int id;
        if (F.G == 256) { if (ii >= ni) break; id = ii == 0 ? items[0] : (ii == 1 ? items[1] : items[2]); } else { id = F.bid + ii * F.G; if (id >= 640) break; }
        const int b = id < 128 ? NPROMPT + (id >> 5) : ((id - 128) >> 5), cg = id & 31;
        const int T = seq_len(b), SL = T >> 4, NC = T >> 7, nb = NC >> 4;
        const size_t base = (size_t)seq_off(b) * D + cg * 64 + l32 * 2;
        {
            const int s1 = seg * SL + SL - 1;
            float slb0 = 0.f, slb1 = 0.f, hb0 = 0.f, hb1 = 0.f, r1s0 = 0.f, r1s1 = 0.f, r1h0 = 0.f, r1h1 = 0.f, r2s0 = 0.f, r2s1 = 0.f, r2h0 = 0.f, r2h1 = 0.f;
            const int w1 = seg, w2 = 128 + seg;
            unsigned lb[8], ub_[8], lr[8], ur[8];
            rg_ld<1, true>(lab, base, s1 - (SL - 1), lr); rg_ld<1, true>(ub, base, s1 - (SL - 1), ur);
            rg_ld<8, true>(lab, base, s1, lb); rg_ld<8, true>(ub, base, s1, ub_);
            for (int i0 = 0; i0 + 8 <= SL; i0 += 8) {
                unsigned lbn[8], ubn[8];
#pragma unroll
                for (int i = 0; i < 8; ++i) { lbn[i] = 0u; ubn[i] = 0u; }
                if (i0 + 16 <= SL) { rg_ld<8, true>(lab, base, s1 - i0 - 8, lbn); rg_ld<8, true>(ub, base, s1 - i0 - 8, ubn); }
#pragma unroll
                for (int i = 0; i < 8; ++i) { const float c0 = bf_lo(lb[i]), c1 = bf_hi(lb[i]); slb0 += c0; slb1 += c1; hb0 = __expf(c0) * hb0 + bf_lo(ub_[i]); hb1 = __expf(c1) * hb1 + bf_hi(ub_[i]);
                    const bool q1 = (i0 + i == w1), q2 = (i0 + i == w2);
                    r1s0 = q1 ? slb0 : r1s0; r1s1 = q1 ? slb1 : r1s1; r1h0 = q1 ? hb0 : r1h0; r1h1 = q1 ? hb1 : r1h1;
                    r2s0 = q2 ? slb0 : r2s0; r2s1 = q2 ? slb1 : r2s1; r2h0 = q2 ? hb0 : r2h0; r2h1 = q2 ? hb1 : r2h1; }
#pragma unroll
                for (int i = 0; i < 8; ++i) { lb[i] = lbn[i]; ub_[i] = ubn[i]; }
            }
            { const float c0 = bf_lo(lr[0]), c1 = bf_hi(lr[0]); slb0 += c0; slb1 += c1; hb0 = __expf(c0) * hb0 + bf_lo(ur[0]); hb1 = __expf(c1) * hb1 + bf_hi(ur[0]);
                const bool q1 = (SL - 1 == w1), q2 = (SL - 1 == w2);
                r1s0 = q1 ? slb0 : r1s0; r1s1 = q1 ? slb1 : r1s1; r1h0 = q1 ? hb0 : r1h0; r1h1 = q1 ? hb1 : r1h1;
                r2s0 = q2 ? slb0 : r2s0; r2s1 = q2 ? slb1 : r2s1; r2h0 = q2 ? hb0 : r2h0; r2h1 = q2 ? hb1 : r2h1; }
            __syncthreads();
            { LAS float* a = AGG + seg * 256 + 2 * l32; *(LAS f32x2*)(a) = (f32x2){slb0, slb1}; *(LAS f32x2*)(a + 64) = (f32x2){hb0, hb1}; }
            __syncthreads();
            float cb0 = 0.f, cb1 = 0.f;
            for (int v = 15; v > seg; --v) { const LAS float* a = AGG + v * 256 + 2 * l32; const f32x2 sl = *(const LAS f32x2*)(a), hh = *(const LAS f32x2*)(a + 64); cb0 = hh[0] + __expf(sl[0]) * cb0; cb1 = hh[1] + __expf(sl[1]) * cb1; }
            *(LAS f32x2*)(CB + (nb * seg + nb) * 64 + 2 * l32) = (f32x2){r1h0 + __expf(r1s0) * cb0, r1h1 + __expf(r1s1) * cb1};
            if (nb == 2) *(LAS f32x2*)(CB + (nb * seg + nb - 1) * 64 + 2 * l32) = (f32x2){r2h0 + __expf(r2s0) * cb0, r2h1 + __expf(r2s1) * cb1};
            __syncthreads();
        }
        float CF0 = 0.f, CF1 = 0.f;
        unsigned A_lf[8], A_uf[8], A_lb[8], A_ub[8], A_g[8];
        { const int t0 = 8 * seg; rg_ld<8, false>(laf, base, t0, A_lf); rg_ld<8, false>(uf, base, t0, A_uf); rg_ld<8, false>(lab, base, t0, A_lb); rg_ld<8, false>(ub, base, t0, A_ub); rg_ld<8, false>(ygate, base, t0, A_g); }
        for (int c = 0; c <= NC; ++c) {
            const bool tail = (c == NC);
            const int tb = 128 * c + (tail ? seg : 8 * seg);
            unsigned B_lf[8], B_uf[8], B_lb[8], B_ub[8], B_g[8];
#pragma unroll
            for (int i = 0; i < 8; ++i) { B_lf[i] = 0u; B_uf[i] = 0u; B_lb[i] = 0u; B_ub[i] = 0u; B_g[i] = 0u; }
            if (c + 1 < NC) { const int t0 = 128 * (c + 1) + 8 * seg; rg_ld<8, false>(laf, base, t0, B_lf); rg_ld<8, false>(uf, base, t0, B_uf); rg_ld<8, false>(lab, base, t0, B_lb); rg_ld<8, false>(ub, base, t0, B_ub); rg_ld<8, false>(ygate, base, t0, B_g); }
            else if (c + 1 == NC) { const int t0 = 128 * NC + seg; rg_ld<1, false>(laf, base, t0, B_lf); rg_ld<1, false>(uf, base, t0, B_uf); rg_ld<1, false>(lab, base, t0, B_lb); rg_ld<1, false>(ub, base, t0, B_ub); rg_ld<1, false>(ygate, base, t0, B_g); }
            float af0[8], af1[8], ab0[8], ab1[8];
            float slf0 = 0.f, slf1 = 0.f, hf0 = 0.f, hf1 = 0.f, slb0 = 0.f, slb1 = 0.f, hb0 = 0.f, hb1 = 0.f;
#pragma unroll
            for (int i = 0; i < 8; ++i) { const float a0 = bf_lo(A_lf[i]), a1 = bf_hi(A_lf[i]); slf0 += a0; slf1 += a1; af0[i] = __expf(a0); af1[i] = __expf(a1); hf0 = af0[i] * hf0 + bf_lo(A_uf[i]); hf1 = af1[i] * hf1 + bf_hi(A_uf[i]); }
#pragma unroll
            for (int i = 7; i >= 0; --i) { const float c0 = bf_lo(A_lb[i]), c1 = bf_hi(A_lb[i]); slb0 += c0; slb1 += c1; ab0[i] = __expf(c0); ab1[i] = __expf(c1); hb0 = ab0[i] * hb0 + bf_lo(A_ub[i]); hb1 = ab1[i] * hb1 + bf_hi(A_ub[i]); }
            LAS float* ag = AGG + (c & 1) * 4096;
            { LAS float* a = ag + seg * 256 + 2 * l32; *(LAS f32x2*)(a) = (f32x2){slf0, slf1}; *(LAS f32x2*)(a + 64) = (f32x2){hf0, hf1}; *(LAS f32x2*)(a + 128) = (f32x2){slb0, slb1}; *(LAS f32x2*)(a + 192) = (f32x2){hb0, hb1}; }
            __syncthreads();
            float cf0 = CF0, cf1 = CF1;
            for (int v = 0; v < seg; ++v) { const LAS float* a = ag + v * 256 + 2 * l32; const f32x2 sl = *(const LAS f32x2*)(a), hh = *(const LAS f32x2*)(a + 64); cf0 = hh[0] + __expf(sl[0]) * cf0; cf1 = hh[1] + __expf(sl[1]) * cf1; }
            { float e0 = cf0, e1 = cf1;
                for (int v = seg; v < 16; ++v) { const LAS float* a = ag + v * 256 + 2 * l32; const f32x2 sl = *(const LAS f32x2*)(a), hh = *(const LAS f32x2*)(a + 64); e0 = hh[0] + __expf(sl[0]) * e0; e1 = hh[1] + __expf(sl[1]) * e1; }
                CF0 = e0; CF1 = e1; }
            float cb0 = 0.f, cb1 = 0.f;
            if (!tail) { const f32x2 r = *(const LAS f32x2*)(CB + (c + 1) * 64 + 2 * l32); cb0 = r[0]; cb1 = r[1]; }
            for (int v = 15; v > seg; --v) { const LAS float* a = ag + v * 256 + 2 * l32; const f32x2 sl = *(const LAS f32x2*)(a + 128), hh = *(const LAS f32x2*)(a + 192); cb0 = hh[0] + __expf(sl[0]) * cb0; cb1 = hh[1] + __expf(sl[1]) * cb1; }
            float f0[8], f1[8];
#pragma unroll
            for (int i = 0; i < 8; ++i) { cf0 = af0[i] * cf0 + bf_lo(A_uf[i]); cf1 = af1[i] * cf1 + bf_hi(A_uf[i]); f0[i] = cf0; f1[i] = cf1; }
#pragma unroll
            for (int i = 7; i >= 0; --i) { cb0 = ab0[i] * cb0 + bf_lo(A_ub[i]); cb1 = ab1[i] * cb1 + bf_hi(A_ub[i]);
                f0[i] = bf_lo(A_g[i]) * (f0[i] + cb0); f1[i] = bf_hi(A_g[i]) * (f1[i] + cb1); }
            if (!tail) {
#pragma unroll
                for (int i = 0; i < 8; ++i) *(unsigned*)(ub + base + (size_t)(tb + i) * D) = cvt_pk_bf16(f0[i], f1[i]);
            } else *(unsigned*)(ub + base + (size_t)tb * D) = cvt_pk_bf16(f0[0], f1[0]);
#pragma unroll
            for (int i = 0; i < 8; ++i) { A_lf[i] = B_lf[i]; A_uf[i] = B_uf[i]; A_lb[i] = B_lb[i]; A_ub[i] = B_ub[i]; A_g[i] = B_g[i]; }
        }
    }
}
constexpr int NA_VPITCH = 144;
constexpr int NA_WAVE_LDS = 32 * NA_VPITCH * 2 + 2048;
DI void na_attn_phase(Frame& F, const bf16_t* qkv, bf16_t* O, const float* rpb, const float* mbias) {
    int tid_ = F.wave * 64 + lane_id(); asm volatile("" : "+v"(tid_));
    const int lane = tid_ & 63, l15 = lane & 15, quad = lane >> 4;
    LAS unsigned char* wl = F.lds + F.wave * NA_WAVE_LDS;
    LAS bf16_t* vt = (LAS bf16_t*)wl;
    LAS float* rp = (LAS float*)(wl + 32 * NA_VPITCH * 2);
    int cached_h = -1;
    const float scale = 0.08838834764831845f;
    const int NITEMS = MTOK;
    for (int id = F.bid * 8 + F.wave; id < NITEMS; id += F.G * 8) {
        int b, h, it, rows;
        if (id < MPROMPT) { const int bh = id / 129; it = id - bh * 129; b = bh >> 4; h = bh & 15; rows = 32; }
        else { const int i2 = id - MPROMPT; const int bh = i2 / 257; it = i2 - bh * 257; b = NPROMPT + (bh >> 4); h = bh & 15; rows = 64; }
        const bool is_meta = (it == rows * 4);
        const int r = it >> 2, n = it & 3;
        const int so = seq_off(b);
        if (h != cached_h) {
            __builtin_amdgcn_wave_barrier();
            for (int i = lane; i < 465; i += 64) rp[i] = rpb[h * 465 + i];
            if (lane < 16) rp[480 + lane] = mbias[h * 16 + lane];
            cached_h = h; LDS_WAIT(); __builtin_amdgcn_wave_barrier(); asm volatile("" ::: "memory");
        }
        int rs = r - 4; rs = rs < 0 ? 0 : (rs > rows - 8 ? rows - 8 : rs);
        int ks = 16 * n - 8; ks = ks < 0 ? 0 : (ks > 32 ? 32 : ks);
        const int qrow = is_meta ? so + l15 : so + NMETA + 64 * r + 16 * n + l15;
        const int qcol = 16 * n + l15; int cs = qcol - 8; cs = cs < 0 ? 0 : (cs > 48 ? 48 : cs);
        bf16x8 qf[4];
#pragma unroll
        for (int s = 0; s < 4; ++s) qf[s] = *(const bf16x8*)(qkv + (size_t)qrow * 6144 + h * 128 + 32 * s + 8 * quad);
        f32x4 sv[17];
#pragma unroll
        for (int kb = 0; kb < 17; ++kb) sv[kb] = (f32x4){-1e30f, -1e30f, -1e30f, -1e30f};
        if (!is_meta) {
#pragma unroll
            for (int kb0 = 0; kb0 < 16; kb0 += 8) {
                bf16x8 kf[8][4];
#pragma unroll
                for (int i = 0; i < 8; ++i) { const int kb = kb0 + i, kr = kb >> 1; const int krow = so + NMETA + 64 * (rs + kr) + ks + 16 * (kb & 1) + l15;
#pragma unroll
                    for (int s = 0; s < 4; ++s) kf[i][s] = *(const bf16x8*)(qkv + (size_t)krow * 6144 + 2048 + h * 128 + 32 * s + 8 * quad); }
#pragma unroll
                for (int i = 0; i < 8; ++i) { const int kb = kb0 + i, kr = kb >> 1;
                    f32x4 st = (f32x4){0.f, 0.f, 0.f, 0.f};
#pragma unroll
                    for (int s = 0; s < 4; ++s) st = __builtin_amdgcn_mfma_f32_16x16x32_bf16(kf[i][s], qf[s], st, 0, 0, 0);
                    const int roff = (rs + kr) - r + 7;
#pragma unroll
                    for (int g = 0; g < 4; ++g) { const int keycol = ks + 16 * (kb & 1) + 4 * quad + g; const bool valid = (keycol >= cs) && (keycol < cs + 16);
                        int coff = keycol - qcol; coff = coff < -15 ? -15 : (coff > 15 ? 15 : coff);
                        sv[kb][g] = valid ? st[g] * scale + rp[roff * 31 + coff + 15] : -1e30f; }
                }
            }
        }
        {
            const int krow = so + l15;
            f32x4 st = (f32x4){0.f, 0.f, 0.f, 0.f};
#pragma unroll
            for (int s = 0; s < 4; ++s) { const bf16x8 kf = *(const bf16x8*)(qkv + (size_t)krow * 6144 + 2048 + h * 128 + 32 * s + 8 * quad);
                st = __builtin_amdgcn_mfma_f32_16x16x32_bf16(kf, qf[s], st, 0, 0, 0); }
#pragma unroll
            for (int g = 0; g < 4; ++g) sv[16][g] = st[g] * scale + rp[480 + 4 * quad + g];
        }
#define NA_LDV(B_, KR_) do { _Pragma("unroll") for (int i = 0; i < 8; ++i) { const int cid = i * 64 + lane, vr = cid >> 4, c16 = cid & 15; B_[i] = (u32x4){0u, 0u, 0u, 0u}; \
            if ((KR_) < 8) B_[i] = *(const u32x4*)(qkv + (size_t)(so + NMETA + 64 * (rs + (KR_)) + ks + vr) * 6144 + 4096 + h * 128 + 8 * c16); \
            else if ((KR_) == 8 && vr < 16) B_[i] = *(const u32x4*)(qkv + (size_t)(so + vr) * 6144 + 4096 + h * 128 + 8 * c16); } } while (0)
        u32x4 vb[3][8];
        if (!is_meta) { NA_LDV(vb[0], 0); NA_LDV(vb[1], 1); NA_LDV(vb[2], 2); }
        else { NA_LDV(vb[2], 8);
#pragma unroll
            for (int i = 0; i < 8; ++i) { vb[0][i] = (u32x4){0u, 0u, 0u, 0u}; vb[1][i] = vb[0][i]; } }
        float mx = -1e30f;
#pragma unroll
        for (int kb = 0; kb < 17; ++kb)
#pragma unroll
            for (int g = 0; g < 4; ++g) mx = fmaxf(mx, sv[kb][g]);
        mx = fmaxf(mx, __shfl_xor(mx, 16)); mx = fmaxf(mx, __shfl_xor(mx, 32));
        float sum = 0.f;
#pragma unroll
        for (int kb = 0; kb < 17; ++kb)
#pragma unroll
            for (int g = 0; g < 4; ++g) { const float p = __expf(sv[kb][g] - mx); sv[kb][g] = p; sum += p; }
        sum += __shfl_xor(sum, 16); sum += __shfl_xor(sum, 32);
        const float inv = 1.0f / sum;
        f32x4 ot[8];
#pragma unroll
        for (int d = 0; d < 8; ++d) ot[d] = (f32x4){0.f, 0.f, 0.f, 0.f};
#pragma unroll
        for (int kr = 0; kr < 9; ++kr) {
            if (!(is_meta && kr < 8)) {
            __builtin_amdgcn_wave_barrier(); asm volatile("" ::: "memory");
#pragma unroll
            for (int i = 0; i < 8; ++i) { const int cid = i * 64 + lane, vr = cid >> 4, c16 = cid & 15; *(LAS u32x4*)(vt + vr * NA_VPITCH + 8 * c16) = vb[kr % 3][i]; }
            LDS_WAIT(); __builtin_amdgcn_wave_barrier(); asm volatile("" ::: "memory");
            if (!is_meta && kr + 3 <= 8) NA_LDV(vb[kr % 3], kr + 3);
            f32x4 p0, p1;
            if (kr < 8) { p0 = sv[2 * kr]; p1 = sv[2 * kr + 1]; } else { p0 = sv[16]; p1 = (f32x4){0.f, 0.f, 0.f, 0.f}; }
            u32x4 pw; pw.x = cvt_pk_bf16(p0[0] * inv, p0[1] * inv); pw.y = cvt_pk_bf16(p0[2] * inv, p0[3] * inv); pw.z = cvt_pk_bf16(p1[0] * inv, p1[1] * inv); pw.w = cvt_pk_bf16(p1[2] * inv, p1[3] * inv);
            const bf16x8 pf = __builtin_bit_cast(bf16x8, pw);
            const LAS bf16_t* tb = vt + (4 * quad + (l15 >> 2)) * NA_VPITCH + 4 * (l15 & 3);
#pragma unroll
            for (int d = 0; d < 8; ++d) {
                const s16x4 lo = __builtin_amdgcn_ds_read_tr16_b64_v4i16((LAS s16x4*)(tb + 16 * d)), hi = __builtin_amdgcn_ds_read_tr16_b64_v4i16((LAS s16x4*)(tb + 16 * NA_VPITCH + 16 * d));
                const bf16x8 vf = (bf16x8){lo[0], lo[1], lo[2], lo[3], hi[0], hi[1], hi[2], hi[3]};
                ot[d] = __builtin_amdgcn_mfma_f32_16x16x32_bf16(vf, pf, ot[d], 0, 0, 0);
            }
            }
        }
#pragma unroll
        for (int d = 0; d < 8; ++d) { u32x2 w; w.x = cvt_pk_bf16(ot[d][0], ot[d][1]); w.y = cvt_pk_bf16(ot[d][2], ot[d][3]);
            *(u32x2*)(O + (size_t)qrow * D + h * 128 + 16 * d + 4 * quad) = w; }
    }
}
constexpr int GD_QS = 0, GD_KS = 17408, GD_VS = 34816, GD_ABF = 52224, GD_ADG = 61440, GD_TIB = 66560, GD_KST = 68608, GD_QKM = 87040, GD_WB = 96256, GD_VEC = 113664, GD_CW = 114944, GD_END = 121088;
constexpr int GD_O = 114944;
constexpr int P_QS = 136, P_KST = 72, P_ADG = 20, P_O = 132;
typedef short bf16x4 __attribute__((ext_vector_type(4)));

DI void gdn_conv_phase(Frame& F, int half, bf16_t* qkvp, const bf16_t* halo, const float* conv_w) {
    int tid_ = F.wave * 64 + lane_id(); asm volatile("" : "+v"(tid_));
    const int tid = tid_, piece = tid & 63, tg = tid >> 6;
    constexpr int NIT = (MTOK / 64) * 8;
    for (int item = F.bid; item < NIT; item += F.G) {
        const bool ivld = true;
        const int rb = item >> 3, cs = item & 7, col = cs * 512 + piece * 8;
        const int X = col < 1024 ? 0 : (col < 2048 ? 1 : 2);
        const int wcol = X == 0 ? half * 1024 + col : (X == 1 ? 2048 + half * 1024 + (col - 1024) : 4096 + half * 2048 + (col - 2048));
        const int r0 = 64 * rb + 8 * tg; int b, t0; row_bt(r0, b, t0); const int T = seq_len(b);
        u32x4 xr[11];
#pragma unroll
        for (int r = 0; r < 11; ++r) { const int tt = t0 - 1 + r, w = r0 - 1 + r; xr[r] = (u32x4){0u, 0u, 0u, 0u};
            if (ivld && tt >= 0 && tt < T) { const bf16_t* p;
                if (w < 64 * rb) p = halo + ((size_t)rb * 3 + 0) * 4096 + col; else if (w >= 64 * rb + 64) p = halo + ((size_t)rb * 3 + 1 + (w - 64 * rb - 64)) * 4096 + col; else p = qkvp + (size_t)w * 4096 + col;
                xr[r] = *(const u32x4*)p; } }
        f32x4 wlo[4], whi[4];
#pragma unroll
        for (int j = 0; j < 4; ++j) { wlo[j] = *(const f32x4*)(conv_w + j * 8192 + wcol); whi[j] = *(const f32x4*)(conv_w + j * 8192 + wcol + 4); }
        u32x4 res[8];
#pragma unroll
        for (int ro = 0; ro < 8; ++ro) {
            float a[8];
#pragma unroll
            for (int e = 0; e < 8; ++e) a[e] = 0.f;
#pragma unroll
            for (int j = 0; j < 4; ++j) { const u32x4 x = xr[ro + j];
                a[0] += wlo[j][0] * bf_lo(x.x); a[1] += wlo[j][1] * bf_hi(x.x); a[2] += wlo[j][2] * bf_lo(x.y); a[3] += wlo[j][3] * bf_hi(x.y);
                a[4] += whi[j][0] * bf_lo(x.z); a[5] += whi[j][1] * bf_hi(x.z); a[6] += whi[j][2] * bf_lo(x.w); a[7] += whi[j][3] * bf_hi(x.w); }
            float ss = 0.f;
#pragma unroll
            for (int e = 0; e < 8; ++e) { a[e] = siluf_(a[e]); ss += a[e] * a[e]; }
            ss += __shfl_xor(ss, 1); ss += __shfl_xor(ss, 2); ss += __shfl_xor(ss, 4); ss += __shfl_xor(ss, 8);
            const float sc = X == 2 ? 1.0f : (1.0f / sqrtf(ss + 1e-6f)) * (X == 0 ? 0.08838834764831845f : 1.0f);
            res[ro] = (u32x4){cvt_pk_bf16(a[0] * sc, a[1] * sc), cvt_pk_bf16(a[2] * sc, a[3] * sc), cvt_pk_bf16(a[4] * sc, a[5] * sc), cvt_pk_bf16(a[6] * sc, a[7] * sc)};
        }
        __syncthreads();
        if (ivld) {
#pragma unroll
            for (int ro = 0; ro < 8; ++ro) *(u32x4*)(qkvp + (size_t)(r0 + ro) * 4096 + col) = res[ro]; }
    }
}
DI bf16x8 frag_perm(const LAS bf16_t* rowp, int kbase, int quad) {
    const s16x4 a = *(const LAS s16x4*)(rowp + kbase + 4 * quad), b = *(const LAS s16x4*)(rowp + kbase + 16 + 4 * quad);
    bf16x8 r; r[0] = a[0]; r[1] = a[1]; r[2] = a[2]; r[3] = a[3]; r[4] = b[0]; r[5] = b[1]; r[6] = b[2]; r[7] = b[3]; return r;
}
DI bf16x8 pack_acc(const f32x4 a, const f32x4 b) { const u32x4 w = pack8(a, b); return __builtin_bit_cast(bf16x8, w); }
DI bf16x4 pack4(const f32x4 a) { u32x2 w; w.x = cvt_pk_bf16(a[0], a[1]); w.y = cvt_pk_bf16(a[2], a[3]); return __builtin_bit_cast(bf16x4, w); }
#define MFMA16(a, b, c) __builtin_amdgcn_mfma_f32_16x16x16bf16_1k((a), (b), (c), 0, 0, 0)


DI void gd_tok_ab(int n, int dir, int& A, int& sg) { sg = dir ? -1 : 1; A = n == 0 ? (dir ? 15 : -48) : NMETA + 64 * (n - 1) + (dir ? 63 : 0); }
DI int gd_tok(int n, int dir, int slot) { int A, sg; gd_tok_ab(n, dir, A, sg); return A + sg * slot; }
DI void gd_fetch(const bf16_t* qkvp, const float* bg, int so, int hl, int ql, int hv, int n, int dir, int tid, int wave, u32x4 (&pf)[6], float& gv, float& bv) {
    int A, sg; gd_tok_ab(n, dir, A, sg);
    const int pc = tid & 15, cq = ql * 128 + 8 * pc, ck = 1024 + cq, cv = 2048 + hl * 128 + 8 * pc;
#pragma unroll
    for (int h2 = 0; h2 < 2; ++h2) { const int t = A + sg * ((tid >> 4) + 32 * h2);
        pf[h2] = pf[2 + h2] = pf[4 + h2] = (u32x4){0u, 0u, 0u, 0u};
        if (t >= 0) { const bf16_t* rp = qkvp + (size_t)(so + t) * 4096; pf[h2] = *(const u32x4*)(rp + cq); pf[2 + h2] = *(const u32x4*)(rp + ck); pf[4 + h2] = *(const u32x4*)(rp + cv); } }
    gv = 0.f; bv = 0.f;
    if (wave == 0) { const int t1 = A + sg * (tid & 63); if (t1 >= 0) { const float* p = bg + (size_t)(so + t1) * 128 + dir * 32 + hv; bv = p[0]; gv = p[64]; } }
}
#define GD_BAR() asm volatile("s_waitcnt lgkmcnt(0)\n\ts_barrier" ::: "memory")
#define GD_IDS() int tq_ = tid0; asm volatile("" : "+v"(tq_)); const int tid = tq_, lane = tid & 63, l15 = lane & 15, quad = lane >> 4, tau = tid >> 3, sub = tid & 7; (void)l15; (void)quad; (void)tau; (void)sub; (void)lane;
constexpr int GD_OB_SPLIT = 48640;
DI bf16_t* gd_ob_row(bf16_t* obA, bf16_t* obB, int R) { return R < GD_OB_SPLIT ? obA + (size_t)R * D : obB + (size_t)(R - GD_OB_SPLIT) * D; }
DI void gdn_core_phase(Frame& F, int half, const bf16_t* qkvp, const float* bg, bf16_t* og, bf16_t* obA, bf16_t* obB) {
    int tid_ = F.wave * 64 + lane_id(); asm volatile("" : "+v"(tid_));
    const int tid0 = tid_, wave = __builtin_amdgcn_readfirstlane(tid0 >> 6);
    LAS unsigned char* L = F.lds;
    LAS bf16_t* QS = (LAS bf16_t*)(L + GD_QS); LAS bf16_t* KS = (LAS bf16_t*)(L + GD_KS); LAS bf16_t* VS = (LAS bf16_t*)(L + GD_VS);
    LAS bf16_t* ABF = (LAS bf16_t*)(L + GD_ABF); LAS float* ADG = (LAS float*)(L + GD_ADG); LAS bf16_t* TIB = (LAS bf16_t*)(L + GD_TIB);
    LAS bf16_t* KST = (LAS bf16_t*)(L + GD_KST); LAS bf16_t* QKM = (LAS bf16_t*)(L + GD_QKM);
    LAS bf16_t* WB = (LAS bf16_t*)(L + GD_WB); LAS float* OL = (LAS float*)(L + GD_O);
    LAS float* GC = (LAS float*)(L + GD_VEC); LAS float* BETA = GC + 64; LAS float* EG = GC + 128; LAS float* EKL = GC + 192; LAS float* GL = GC + 256;
    for (int ii = 0; ; ++ii) {
        int id;
        if (F.G == 256) { if (F.bid < 128) { if (ii >= 2) break; id = ii == 0 ? F.bid : 128 + F.bid; } else { if (ii >= 3) break; id = 256 + 3 * (F.bid - 128) + ii; } }
        else { id = F.bid + ii * F.G; if (id >= NSEQ * 32) break; }
        const int s_ = id < 128 ? id : id - 128;
        const int b = id < 128 ? NPROMPT + (s_ >> 5) : (s_ >> 5), hl = (s_ >> 1) & 15, dir = s_ & 1, hv = half * 16 + hl, ql = hl >> 1;
        const int so = seq_off(b), T = seq_len(b), NC = 1 + (T - NMETA) / 64;
        __syncthreads();
        {
            f32x4 Sacc[8];
#pragma unroll
            for (int i = 0; i < 8; ++i) Sacc[i] = (f32x4){0.f, 0.f, 0.f, 0.f};
            u32x4 pf[6]; float pgv, pbv;
            gd_fetch(qkvp, bg, so, hl, ql, hv, dir ? NC - 1 : 0, dir, tid0, wave, pf, pgv, pbv);
#define GD_S5() do { if (tprev >= 0) { GD_IDS(); f32x4 o[4]; _Pragma("unroll") for (int i = 0; i < 4; ++i) o[i] = *(const LAS f32x4*)(OL + tau * P_O + 16 * sub + 4 * i); \
                *(u32x4*)(gpprev) = pack8(o[0], o[1]); *(u32x4*)(gpprev + 8) = pack8(o[2], o[3]); } } while (0)
            int tprev = -1; bf16_t* gpprev = og;
            for (int step = 0; step < NC; ++step) {
                const int n = dir ? NC - 1 - step : step;
                int t, R; float gv = 0.f, bv = 0.f; bf16_t* gp;
                GD_S5();
                { GD_IDS();
                t = gd_tok(n, dir, tau);
                R = so + (t < 0 ? 0 : t);
#pragma unroll
                for (int i = 0; i < 6; ++i) { const int X = i >> 1, slot = (tid >> 4) + 32 * (i & 1), pc = tid & 15;
                    LAS bf16_t* dst = (X == 0 ? QS : (X == 1 ? KS : VS)) + slot * P_QS + 8 * pc;
                    *(LAS u32x4*)(dst) = pf[i];
                    if (X == 1) { const unsigned w4[4] = {pf[i].x, pf[i].y, pf[i].z, pf[i].w};
#pragma unroll
                        for (int e = 0; e < 8; ++e) KST[(8 * pc + e) * P_KST + slot] = (bf16_t)((e & 1) ? (w4[e >> 1] >> 16) : (w4[e >> 1] & 0xffffu)); } }
                gv = pgv; bv = pbv;
                if (step + 1 < NC) gd_fetch(qkvp, bg, so, hl, ql, hv, dir ? NC - 2 - step : step + 1, dir, tid, wave, pf, pgv, pbv);
                gp = (dir ? gd_ob_row(obA, obB, R) : og + (size_t)R * D) + hl * 128 + 16 * sub;
                }
                if (wave == 0) { GD_IDS();
                    float c = gv;
#pragma unroll
                    for (int o = 1; o < 64; o <<= 1) { const float y = __shfl_up(c, o); if (lane >= o) c += y; }
                    const float gl = __shfl(c, 63);
                    GC[lane] = c; BETA[lane] = bv; EG[lane] = __expf(c); EKL[lane] = __expf(gl - c); if (lane == 0) GL[0] = __expf(gl);
                }
                GD_BAR();
                { GD_IDS();
                    const int cb = wave >> 1;
                    bf16x8 ka[4], qa[4];
#pragma unroll
                    for (int ks = 0; ks < 4; ++ks) { ka[ks] = *(const LAS bf16x8*)(KS + (16 * cb + l15) * P_QS + 32 * ks + 8 * quad); qa[ks] = *(const LAS bf16x8*)(QS + (16 * cb + l15) * P_QS + 32 * ks + 8 * quad); }
                    const f32x4 gcc = *(const LAS f32x4*)(GC + 16 * cb + 4 * quad), btc = *(const LAS f32x4*)(BETA + 16 * cb + 4 * quad);
#pragma unroll
                    for (int s2 = 0; s2 < 2; ++s2) { const int sb = 2 * (wave & 1) + s2;
                        f32x4 kk = (f32x4){0.f, 0.f, 0.f, 0.f}, qk = kk;
#pragma unroll
                        for (int ks = 0; ks < 4; ++ks) { const bf16x8 kb = *(const LAS bf16x8*)(KS + (16 * sb + l15) * P_QS + 32 * ks + 8 * quad);
                            kk = __builtin_amdgcn_mfma_f32_16x16x32_bf16(ka[ks], kb, kk, 0, 0, 0); qk = __builtin_amdgcn_mfma_f32_16x16x32_bf16(qa[ks], kb, qk, 0, 0, 0); }
                        const int s = 16 * sb + l15; const float gcs = GC[s];
#pragma unroll
                        for (int g = 0; g < 4; ++g) { const int c = 16 * cb + 4 * quad + g;
                            const float dec = (s <= c) ? __expf(fminf(gcc[g] - gcs, 0.f)) : 0.f;
                            const float av = (s < c) ? btc[g] * kk[g] * dec : 0.f;
                            QKM[c * P_KST + s] = f2bf(qk[g] * dec);
                            ABF[c * P_KST + s] = f2bf(av);
                            if (sb == cb) ADG[(cb * 16 + 4 * quad + g) * P_ADG + l15] = av; }
                    }
                }
                GD_BAR();
                if (wave == 0) { GD_IDS();
                    float tcol[16];
#pragma unroll
                    for (int r = 0; r < 16; ++r) { float acc = (r == l15) ? 1.f : 0.f;
                        const LAS float* lr = ADG + (quad * 16 + r) * P_ADG;
#pragma unroll
                        for (int s4 = 0; s4 < (r + 3) / 4; ++s4) { const f32x4 lv = *(const LAS f32x4*)(lr + 4 * s4);
#pragma unroll
                            for (int e = 0; e < 4; ++e) if (4 * s4 + e < r) acc -= lv[e] * tcol[4 * s4 + e]; }
                        tcol[r] = acc; TIB[(quad * 16 + r) * 16 + l15] = f2bf(acc); }
                }
                f32x4 ru[4], rw[4];
                { GD_IDS();
#pragma unroll
                for (int k = 0; k < 4; ++k) { const f32x4 bt = *(const LAS f32x4*)(BETA + 16 * k + 4 * quad), eg = *(const LAS f32x4*)(EG + 16 * k + 4 * quad);
#pragma unroll
                    for (int g = 0; g < 4; ++g) { const int c = 16 * k + 4 * quad + g;
                        ru[k][g] = bf2f(VS[c * P_QS + 16 * wave + l15]) * bt[g]; rw[k][g] = bf2f(KS[c * P_QS + 16 * wave + l15]) * (bt[g] * eg[g]); } } }
                GD_BAR();
                f32x4 uu[4];
                { GD_IDS();
                    bf16x4 xu[4], xw[4];
#pragma unroll
                    for (int k = 0; k < 4; ++k) {
                        f32x4 su = (f32x4){0.f, 0.f, 0.f, 0.f}, sw = su;
#pragma unroll
                        for (int j = 0; j < 4; ++j) if (j < k) { const bf16x4 af = *(const LAS bf16x4*)(ABF + (16 * k + l15) * P_KST + 16 * j + 4 * quad);
                            su = MFMA16(af, xu[j], su); sw = MFMA16(af, xw[j], sw); }
                        const bf16x4 tf = *(const LAS bf16x4*)(TIB + (k * 16 + l15) * 16 + 4 * quad);
                        const f32x4 z4 = (f32x4){0.f, 0.f, 0.f, 0.f};
                        const f32x4 xuk = MFMA16(tf, pack4(ru[k] - su), z4), xwk = MFMA16(tf, pack4(rw[k] - sw), z4);
                        uu[k] = xuk; xu[k] = pack4(xuk); xw[k] = pack4(xwk);
#pragma unroll
                        for (int g = 0; g < 4; ++g) WB[(16 * k + 4 * quad + g) * P_QS + 16 * wave + l15] = f2bf(xwk[g]);
                    }
                }
                GD_BAR();
                { GD_IDS();
                    bf16x8 Sb[4];
#pragma unroll
                    for (int ks = 0; ks < 4; ++ks) Sb[ks] = pack_acc(Sacc[2 * ks], Sacc[2 * ks + 1]);
                    f32x4 vn[4], oo[4];
#pragma unroll
                    for (int cb = 0; cb < 4; ++cb) {
                        f32x4 ws = (f32x4){0.f, 0.f, 0.f, 0.f}, qs = ws;
#pragma unroll
                        for (int ks = 0; ks < 4; ++ks) { ws = __builtin_amdgcn_mfma_f32_16x16x32_bf16(frag_perm(WB + (16 * cb + l15) * P_QS, 32 * ks, quad), Sb[ks], ws, 0, 0, 0);
                            qs = __builtin_amdgcn_mfma_f32_16x16x32_bf16(frag_perm(QS + (16 * cb + l15) * P_QS, 32 * ks, quad), Sb[ks], qs, 0, 0, 0); }
                        const f32x4 egc = *(const LAS f32x4*)(EG + 16 * cb + 4 * quad);
                        vn[cb] = uu[cb] - ws; oo[cb] = egc * qs;
                    }
                    bf16x8 vb[2];
#pragma unroll
                    for (int kc = 0; kc < 2; ++kc) vb[kc] = pack_acc(vn[2 * kc], vn[2 * kc + 1]);
#pragma unroll
                    for (int cb = 0; cb < 4; ++cb) {
#pragma unroll
                        for (int kc = 0; kc < 2; ++kc) oo[cb] = __builtin_amdgcn_mfma_f32_16x16x32_bf16(frag_perm(QKM + (16 * cb + l15) * P_KST, 32 * kc, quad), vb[kc], oo[cb], 0, 0, 0);
#pragma unroll
                        for (int g = 0; g < 4; ++g) OL[(16 * cb + 4 * quad + g) * P_O + 16 * wave + l15] = oo[cb][g];
                        const f32x4 ek = *(const LAS f32x4*)(EKL + 16 * cb + 4 * quad);
                        vn[cb] = vn[cb] * ek;
                    }
#pragma unroll
                    for (int kc = 0; kc < 2; ++kc) vb[kc] = pack_acc(vn[2 * kc], vn[2 * kc + 1]);
                    const float egl = GL[0];
#pragma unroll
                    for (int db = 0; db < 8; ++db) { f32x4 s = Sacc[db] * egl;
#pragma unroll
                        for (int kc = 0; kc < 2; ++kc) s = __builtin_amdgcn_mfma_f32_16x16x32_bf16(frag_perm(KST + (16 * db + l15) * P_KST, 32 * kc, quad), vb[kc], s, 0, 0, 0);
                        Sacc[db] = s; }
                }
                GD_BAR();
                tprev = t; gpprev = gp;
            }
            GD_S5();
        }
    }
}

DI void gdn_combine_phase(Frame& F, bf16_t* og, bf16_t* obA, bf16_t* obB, const bf16_t* zb, const float* norm_w) {
    const int lane = F.lane(), e0 = (lane & 15) * 8;
    f32x4 nw0 = *(const f32x4*)(norm_w + e0), nw1 = *(const f32x4*)(norm_w + e0 + 4);
    for (int R = F.bid * 8 + F.wave; R < MTOK; R += F.G * 8) {
        bf16_t* op = og + (size_t)R * D + lane * 8; const bf16_t* bp = gd_ob_row(obA, obB, R) + lane * 8; const bf16_t* zp = zb + (size_t)R * D + lane * 8;
        u32x4 f[4], g[4], z[4];
#pragma unroll
        for (int q = 0; q < 4; ++q) { f[q] = *(const u32x4*)(op + 512 * q); g[q] = *(const u32x4*)(bp + 512 * q); z[q] = *(const u32x4*)(zp + 512 * q); }
#pragma unroll
        for (int q = 0; q < 4; ++q) {
            const unsigned fw[4] = {f[q].x, f[q].y, f[q].z, f[q].w}, gw[4] = {g[q].x, g[q].y, g[q].z, g[q].w}, zw[4] = {z[q].x, z[q].y, z[q].z, z[q].w};
            float o[8], zz[8]; float ss = 0.f;
#pragma unroll
            for (int k = 0; k < 4; ++k) { o[2 * k] = bf_lo(fw[k]) + bf_lo(gw[k]); o[2 * k + 1] = bf_hi(fw[k]) + bf_hi(gw[k]); zz[2 * k] = bf_lo(zw[k]); zz[2 * k + 1] = bf_hi(zw[k]); }
#pragma unroll
            for (int e = 0; e < 8; ++e) ss += o[e] * o[e];
            ss += __shfl_xor(ss, 1); ss += __shfl_xor(ss, 2); ss += __shfl_xor(ss, 4); ss += __shfl_xor(ss, 8);
            const float rn = 1.0f / sqrtf(ss * (1.0f / 128.0f) + NORM_EPS);
            f32x4 a, b2;
#pragma unroll
            for (int k = 0; k < 4; ++k) { a[k] = o[k] * rn * nw0[k] * siluf_(zz[k]); b2[k] = o[4 + k] * rn * nw1[k] * siluf_(zz[4 + k]); }
            *(u32x4*)(op + 512 * q) = pack8(a, b2);
        }
    }
}
constexpr int N_PHASES = 38;
#ifndef ALIGN_RES
#define ALIGN_RES true
#endif
#ifndef ALIGN_CONS
#define ALIGN_CONS true
#endif
#ifndef WGM_DEF
#define WGM_DEF 4
#endif
#ifndef WGM_RES
#define WGM_RES 4
#endif
#ifndef WGM_FFU
#define WGM_FFU 4
#endif
#ifndef WGM_GATES
#define WGM_GATES 4
#endif
DI pg8::Gemm mk_gemm(const void* A, unsigned lda, const void* B, unsigned ldb, long hB, int nt) { pg8::Gemm g; g.A = (const char*)A; g.B = (const char*)B; g.lda = lda; g.ldb = ldb; g.hstepA = 128L * lda; g.hstepB = hB; g.nt = nt; return g; }
DI SchedLin mk_lin(Frame& F, int nM, int nN, long a_base, long a_tile, long b_base, long b_tile, int nt = 32, int wgm = WGM_DEF) { SchedLin s; s.o.init(nM, nN, F.G, F.bid, wgm); s.a_base = a_base; s.a_tile = a_tile; s.b_base = b_base; s.b_tile = b_tile; s.nt = nt; return s; }
DI SchedRes mk_res(Frame& F, long a_tile, long b_base, long b_tile, int nt, int wgm = WGM_RES) { SchedRes s; s.init(F.G, F.bid, a_tile, b_base, b_tile, nt, wgm); return s; }

__global__ void __launch_bounds__(512, 2) trunk_fwd(Args args) {
    extern __shared__ __attribute__((aligned(16))) unsigned char lds_raw[];
    Frame F;
    F.lds = (LAS unsigned char*)lds_raw;
    F.wave = __builtin_amdgcn_readfirstlane(threadIdx.x >> 6); F.G = gridDim.x; F.bid = blockIdx.x;
    F.in = args.in; F.out = args.out; F.ws = args.ws;
    volatile LAS unsigned* MISC = (volatile LAS unsigned*)(F.lds + MISC_OFF);
    if (F.tid() < 16) MISC[F.tid()] = 0u;
    __syncthreads();
    const int lo = args.ph_lo, hi = args.ph_hi;
    unsigned* ctl = (unsigned*)(F.ws + WS_CTL);
    XcdBarrier bar; bar.bar = ctl + CW_BAR; bar.x = 0; bar.st = nullptr;
    if (hi - lo > 1) bar = xcd_barrier_post(ctl + CW_BAR, MISC + 8, F.wave == 0 && lane_id() == 0);
#define IN(k) (lo <= (k) && (k) < hi)
#define SEAM(k) do { if (IN(k) && IN((k) + 1)) xcd_barrier(bar, F.wave == 0 && lane_id() == 0); } while (0)
#ifndef REP_MASK
#define REP_MASK 0ull
#endif
#define PHASE(k, ...) if (IN(k)) { if constexpr (((REP_MASK) >> (k)) & 1ull) { __VA_ARGS__; xcd_barrier(bar, F.wave == 0 && lane_id() == 0); } __VA_ARGS__; } SEAM(k);
    LAS float* cscr = (LAS float*)(F.lds + F.wave * 16384);
    bf16_t* const XNp = F.XN(); bf16_t* const XCp = F.XC(); unsigned char* const SCR = F.SCR();
    bf16_t* const OUTB = (bf16_t*)F.out;
    constexpr unsigned LD2K = 4096;


#define CVT_BEGIN() CvtCursor cc{F.bid * 8 + F.wave, 0, F.G * 8}
#define CVT_BEGIN_RES() CvtCursor cc{(F.G == 256) ? (F.bid >= 64 ? (F.bid - 64) * 8 + F.wave : 0x3fffffff) : F.bid * 8 + F.wave, 0, (F.G == 256) ? 192 * 8 : F.G * 8}
#define PH_FIN(XI_, XO_, S1_, ...) { CVT_BEGIN(); __VA_ARGS__; ss_final_phase(F, ssp, rsv, XI_, XO_, SLAB0, S1_); }
#define PH_FFN_UP(LI_, X_) { bf16_t* wg = (bf16_t*)F.WFFN(); \
        pg8::Gemm g = mk_gemm(X_, LD2K, wg, LD2K, (long)DFF * LD2K, 32); SchedLin S = mk_lin(F, 195, 44, -(long)LD2K, 254L * LD2K, 0, 128L * LD2K, 32, WGM_FFU); \
        EpiFfnUp E{(bf16_t*)SCR, F.I(27) + (size_t)(LI_) * 3 * DFF, F.I(28) + (size_t)(LI_) * DFF, (LAS float*)(F.lds + EDGE_OFF), rsv, (const unsigned char*)(F.ws + WS_CTL + 768 * 1024)}; \
        pg8::gemm_phase<EpiFfnUp, SchedLin, true>(F.lds, g, S, E, F.wave); }
#define PH_FFN_DOWN(XI_, XO_, SS_, ...) { bf16_t* wd = (bf16_t*)F.WFFN() + (size_t)2 * DFF * D; \
        pg8::Gemm g = mk_gemm(SCR, DFF * 2, wd, DFF * 2, 128L * DFF * 2, 88); SchedRes S = mk_res(F, 256L * DFF * 2, 0, 256L * DFF * 2, 88); \
        EpiResAdd E{XI_, XO_, SS_, SLAB0}; pg8::gemm_phase<EpiResAdd, SchedRes, ALIGN_RES>(F.lds, g, S, E, F.wave); { CVT_BEGIN_RES(); __VA_ARGS__; } }
#define PH_RG_IN(X_) { bf16_t* win = (bf16_t*)F.WMIX(); \
        pg8::Gemm g = mk_gemm(X_, LD2K, win, LD2K, 128L * LD2K, 32); SchedLin S = mk_lin(F, 194, 16, 0, 256L * LD2K, 0, 256L * LD2K); \
        EpiRgIn E{OUTB, (bf16_t*)SCR, rsv}; pg8::gemm_phase<EpiRgIn, SchedLin, ALIGN_CONS>(F.lds, g, S, E, F.wave); }
#define PH_RG_CONV(J_) { rg_conv_phase(F, (const bf16_t*)SCR, XCp, F.I(7) + (size_t)(J_) * 4 * D, F.I(8) + (size_t)(J_) * D); }
#define PH_RG_GATES(J_) { bf16_t* gates = (bf16_t*)F.WMIX() + (size_t)4096 * D; \
        pg8::Gemm g = mk_gemm(XCp, LD2K, gates, 512, 8L * 131072, 4); SchedGates S; S.o.init(194, 32, F.G, F.bid, WGM_GATES); \
        EpiGates E{XCp, (bf16_t*)SCR, (bf16_t*)(SCR + B194), B194, F.I(10) + (size_t)(J_) * 2 * D, F.I(12) + (size_t)(J_) * 2 * D, F.I(13) + (size_t)(J_) * 2 * D, (LAS float*)(F.lds + EDGE_OFF)}; \
        pg8::gemm_phase<EpiGates, SchedGates, true>(F.lds, g, S, E, F.wave); }
#define PH_RG_SCAN() { rg_scan_phase(F, (const bf16_t*)SCR, (bf16_t*)(SCR + B194), (const bf16_t*)(SCR + 2 * B194), (bf16_t*)(SCR + 3 * B194), OUTB); }
#define PH_RG_OUT(XI_, XO_, ...) { bf16_t* wout = (bf16_t*)F.WMIX() + (size_t)4096 * D + (size_t)32 * 65536; \
        pg8::Gemm g = mk_gemm(SCR + 3 * B194, LD2K, wout, LD2K, 128L * LD2K, 32); SchedRes S = mk_res(F, 256L * LD2K, 0, 256L * LD2K, 32); \
        EpiResAdd E{XI_, XO_, ssp, SLAB0}; pg8::gemm_phase<EpiResAdd, SchedRes, ALIGN_RES>(F.lds, g, S, E, F.wave); { CVT_BEGIN_RES(); __VA_ARGS__; } }
#define PH_GDN_PROJ(HALF_, X_) { bf16_t* w = (bf16_t*)F.WMIX() + ((HALF_) ? (size_t)6400 * D : 0); \
        pg8::Gemm g = mk_gemm(X_, LD2K, w, LD2K, 128L * LD2K, 32); SchedLin S = mk_lin(F, 194, (HALF_) ? 24 : 25, 0, 256L * LD2K, 0, 256L * LD2K); \
        EpiGdnProj E{(bf16_t*)SCR, (HALF_) ? (bf16_t*)(SCR + 2 * B194) : XB, (float*)(SCR + 3 * B194), F.I(21), F.I(22), (bf16_t*)(SCR + 3 * B194 + 26 * MiB), rsv}; pg8::gemm_phase<EpiGdnProj, SchedLin, ALIGN_CONS>(F.lds, g, S, E, F.wave); }
#define PH_GDN_CONV(HALF_) { gdn_conv_phase(F, HALF_, (bf16_t*)SCR, (const bf16_t*)(SCR + 3 * B194 + 26 * MiB), F.I(20)); }
#define GD_OBA (OUTB + (size_t)MP * D)
#define GD_OBB ((bf16_t*)(SCR + 3 * B194 + 48 * MiB))
#define PH_GDN_CORE(HALF_) { gdn_core_phase(F, HALF_, (const bf16_t*)SCR, (const float*)(SCR + 3 * B194), (HALF_) ? XCp : OUTB, GD_OBA, GD_OBB); }
#define PH_GDN_COMB(HALF_) { gdn_combine_phase(F, (HALF_) ? XCp : OUTB, GD_OBA, GD_OBB, (HALF_) ? (const bf16_t*)(SCR + 2 * B194) : (const bf16_t*)XB, F.I(23)); }
#define PH_GDN_OUT(HALF_, XI_, XO_, SS_, ...) { bf16_t* wout = (bf16_t*)F.WMIX() + (size_t)(6400 + 6144) * D; \
        pg8::Gemm g = mk_gemm((HALF_) ? XCp : OUTB, LD2K, wout, 8192, 128L * 8192, 32); SchedRes S = mk_res(F, 256L * LD2K, (long)(HALF_) * 4096, 256L * 8192, 32); \
        EpiResAdd E{XI_, XO_, SS_, (HALF_) ? SLAB1 : SLAB0}; pg8::gemm_phase<EpiResAdd, SchedRes, ALIGN_RES>(F.lds, g, S, E, F.wave); { CVT_BEGIN_RES(); __VA_ARGS__; } }
    float* const SLAB0 = (float*)(SCR + 784 * MiB); float* const SLAB1 = (float*)(SCR + 640 * MiB); float* const NOSLAB = nullptr;
    float* const ssp = (float*)(SCR + 4 * B194);
    float* const rsv = (float*)(F.ws + WS_CTL + 256 * 1024);
    bf16_t* const NOXN = nullptr; float* const NOSS = nullptr; (void)NOXN;

    bf16_t* const XA = XNp; bf16_t* const XB = (bf16_t*)(F.ws + WS_H + B194);
    PHASE(0, { CVT_BEGIN(); cvt_rg(F, cc, 0, 0, cscr); cvt_ffn(F, cc, 0, cscr); fill_rflag(F, (unsigned char*)(F.ws + WS_CTL + 768 * 1024)); norm_phase<1>(F, XA, F.I(3), rsv); })
    PHASE(1, PH_RG_IN(XA)) PHASE(2, PH_RG_CONV(0)) PHASE(3, PH_RG_GATES(0)) PHASE(4, PH_RG_SCAN()) PHASE(5, PH_RG_OUT(XA, XB, (void)cc))
    PHASE(6, PH_FIN(XA, XB, NOSLAB, (void)cc))
    PHASE(7, PH_FFN_UP(0, XB)) PHASE(8, PH_FFN_DOWN(XB, XA, ssp, cvt_na(F, cc, cscr))) PHASE(9, PH_FIN(XB, XA, NOSLAB, (void)cc))
    PHASE(10, { pg8::Gemm g = mk_gemm(XA, LD2K, F.WMIX(), LD2K, 128L * LD2K, 32); SchedLin S = mk_lin(F, 194, 24, 0, 256L * LD2K, 0, 256L * LD2K);
        EpiPlainBf16 E{(bf16_t*)SCR, 6144, rsv}; pg8::gemm_phase<EpiPlainBf16, SchedLin, ALIGN_CONS>(F.lds, g, S, E, F.wave); })
    PHASE(11, { na_attn_phase(F, (const bf16_t*)SCR, OUTB, F.I(16), F.I(17)); })
    PHASE(12, { bf16_t* wo = (bf16_t*)F.WMIX() + (size_t)6144 * D;
        pg8::Gemm g = mk_gemm(OUTB, LD2K, wo, LD2K, 128L * LD2K, 32); SchedRes S = mk_res(F, 256L * LD2K, 0, 256L * LD2K, 32);
        EpiResAdd E{XA, XB, ssp, SLAB0}; pg8::gemm_phase<EpiResAdd, SchedRes, ALIGN_RES>(F.lds, g, S, E, F.wave); { CVT_BEGIN_RES(); cvt_ffn(F, cc, 1, cscr); } })
    PHASE(13, PH_FIN(XA, XB, NOSLAB, (void)cc))
    PHASE(14, PH_FFN_UP(1, XB)) PHASE(15, PH_FFN_DOWN(XB, XA, ssp, cvt_gdn(F, cc, cscr))) PHASE(16, PH_FIN(XB, XA, NOSLAB, (void)cc))
    PHASE(17, PH_GDN_PROJ(0, XA)) PHASE(18, PH_GDN_CONV(0)) PHASE(19, PH_GDN_CORE(0))
    PHASE(20, { PH_GDN_COMB(0) PH_GDN_PROJ(1, XA) }) PHASE(21, PH_GDN_CONV(1)) PHASE(22, PH_GDN_CORE(1))
    PHASE(23, { PH_GDN_COMB(1) PH_GDN_OUT(0, XA, XB, NOSS, cvt_ffn(F, cc, 2, cscr)) })
    PHASE(24, PH_GDN_OUT(1, XB, XA, ssp, (void)cc))
    PHASE(25, PH_FIN(XA, XA, SLAB1, (void)cc))
    PHASE(26, PH_FFN_UP(2, XA)) PHASE(27, PH_FFN_DOWN(XA, XB, ssp, cvt_rg(F, cc, 1, 3, cscr))) PHASE(28, PH_FIN(XA, XB, NOSLAB, (void)cc))
    PHASE(29, PH_RG_IN(XB)) PHASE(30, PH_RG_CONV(1)) PHASE(31, PH_RG_GATES(1)) PHASE(32, PH_RG_SCAN()) PHASE(33, PH_RG_OUT(XB, XA, cvt_ffn(F, cc, 3, cscr)))
    PHASE(34, PH_FIN(XB, XA, NOSLAB, (void)cc))
    PHASE(35, PH_FFN_UP(3, XA)) PHASE(36, PH_FFN_DOWN(XA, XB, NOSS, (void)cc))
    PHASE(37, { norm_phase<2>(F, XB, F.I(5), nullptr, XA, SLAB0); })
#undef IN
#undef SEAM
}

__global__ void fill_k(float* o, size_t n, float v) { for (size_t i = (size_t)blockIdx.x * blockDim.x + threadIdx.x; i < n; i += (size_t)gridDim.x * blockDim.x) o[i] = v; }
#ifndef MK_ONE_LAUNCH
#define MK_ONE_LAUNCH 1
#endif
extern "C" void kernel_launch(void* const* d_in, const int* in_sizes, int n_in, void* d_out, int out_size, void* d_ws, size_t ws_size, hipStream_t stream) {
    static int grid = 0;
    if (grid == 0) {
        int dev = 0, cus = 0;
        hipError_t e = hipGetDevice(&dev); if (e == hipSuccess) e = hipDeviceGetAttribute(&cus, hipDeviceAttributeMultiprocessorCount, dev);
        if (e == hipSuccess) e = hipFuncSetAttribute((const void*)trunk_fwd, hipFuncAttributeMaxDynamicSharedMemorySize, LDS_BYTES);
        if (e != hipSuccess || n_in != 30 || ws_size < WS_END || cus < 1) { fprintf(stderr, "kernel_launch: setup failed (%s), n_in %d, ws %zu\n", hipGetErrorName(e), n_in, ws_size); grid = -1; }
        else grid = cus;
        (void)hipGetLastError();
    }
    if (grid < 0) { fill_k<<<1024, 256, 0, stream>>>((float*)d_out, (size_t)out_size, 7.0f); return; }
    (void)hipMemsetAsync((char*)d_ws + WS_CTL, 0, CTL_ZERO_BYTES, stream);
    Args a{};
    for (int i = 0; i < 30; ++i) a.in[i] = (const float*)d_in[i];
    a.out = (float*)d_out; a.ws = (unsigned char*)d_ws;
#if MK_ONE_LAUNCH
    a.ph_lo = 0; a.ph_hi = N_PHASES;
    hipLaunchKernelGGL(trunk_fwd, dim3(grid), dim3(512), LDS_BYTES, stream, a);
#else
    for (int p = 0; p < N_PHASES; ++p) { a.ph_lo = p; a.ph_hi = p + 1; hipLaunchKernelGGL(trunk_fwd, dim3(grid), dim3(512), LDS_BYTES, stream, a); }
#endif
}
```

```cpp
#include <hip/hip_runtime.h>
#include <cstdio>
#include <cstdint>

#define LAS __attribute__((address_space(3)))
#define GAS __attribute__((address_space(1)))
typedef unsigned short bf16_t;
typedef short bf16x8 __attribute__((ext_vector_type(8)));
typedef short s16x4 __attribute__((ext_vector_type(4)));
typedef float f32x4 __attribute__((ext_vector_type(4)));
typedef float f32x2 __attribute__((ext_vector_type(2)));
typedef unsigned u32x4 __attribute__((ext_vector_type(4)));
typedef unsigned u32x2 __attribute__((ext_vector_type(2)));
#define DI __device__ __forceinline__

constexpr int D = 2048, NSEQ = 20, NPROMPT = 16, TP = 2064, TS = 4112, LP = 2048, LS = 4096, NMETA = 16;
constexpr int MPROMPT = NPROMPT * TP;
constexpr int MTOK = MPROMPT + 4 * TS;
constexpr int MP = 49664;
constexpr int DFF = 5632;
constexpr float NORM_EPS = 1e-6f;
DI int seq_off(int b) { return b < NPROMPT ? b * TP : MPROMPT + (b - NPROMPT) * TS; }
DI int seq_len(int b) { return b < NPROMPT ? TP : TS; }
DI void row_bt(int R, int& b, int& t) { if (R < MPROMPT) { b = R / TP; t = R - b * TP; } else { const int q = (R - MPROMPT) / TS; b = NPROMPT + q; t = R - MPROMPT - q * TS; } }

typedef __bf16 bf16v2_ __attribute__((ext_vector_type(2)));
DI unsigned cvt_pk_bf16(float lo, float hi) { const bf16v2_ r = __builtin_convertvector((f32x2){lo, hi}, bf16v2_); return __builtin_bit_cast(unsigned, r); }
DI float bf_lo(unsigned w) { return __uint_as_float(w << 16); }
DI float bf_hi(unsigned w) { return __uint_as_float(w & 0xffff0000u); }
DI float bf2f(bf16_t h) { return __uint_as_float(((unsigned)h) << 16); }
DI bf16_t f2bf(float f) { return (bf16_t)(cvt_pk_bf16(f, 0.f) & 0xffffu); }
DI float fast_rcp(float x) { return __builtin_amdgcn_rcpf(x); }
DI float sigmoidf_(float x) { return fast_rcp(1.f + __expf(-x)); }
DI float siluf_(float x) { return x * sigmoidf_(x); }
DI float softplusf_(float x) { return x > 20.f ? x : log1pf(__expf(x)); }
DI float softplus_lite(float x) { const float e = __expf(x), u = 1.f + e, d = u - 1.f; return x > 20.f ? x : (d == 0.f ? e : __logf(u) * e * fast_rcp(d)); }
DI float gelu_tanh_(float x) { const float u = 1.5957691216057308f * (x + 0.044715f * x * x * x); return x * sigmoidf_(u); }
DI int lane_id() { int r; asm volatile("v_mbcnt_lo_u32_b32 %0, -1, 0\n\tv_mbcnt_hi_u32_b32 %0, -1, %0" : "=&v"(r)); return r; }
DI float wave_sum(float v) {
#pragma unroll
    for (int o = 1; o < 64; o <<= 1) v += __shfl_xor(v, o);
    return v;
}

#define XB_TMO      128
#define XB_XCNT(j)  (256  + 64 * (j))
#define XB_XSUB(j)  (1280 + 64 * (j))
#define XB_XGEN(j)  (2304 + 64 * (j))
#define XB_TOP      3328
#define XB_TOPGEN   3392
#define XCD_BAR_WORDS 3456
#define XB_SPIN_CAP (1u << 22)
DI unsigned xb_ld(unsigned* p)              { return __hip_atomic_load(p, __ATOMIC_RELAXED, __HIP_MEMORY_SCOPE_AGENT); }
DI unsigned xb_add(unsigned* p, unsigned v) { return __hip_atomic_fetch_add(p, v, __ATOMIC_RELAXED, __HIP_MEMORY_SCOPE_AGENT); }
DI unsigned xb_xcc_id() { return (unsigned)__builtin_amdgcn_s_getreg((3 << 11) | 20) & 0xFu; }
#define XB_SPIN(cond, bar) do { unsigned _sp = 0; while (cond) { __builtin_amdgcn_s_sleep(1); \
    if ((++_sp & 255u) == 0u) { if (xb_ld(&(bar)[XB_TMO])) break; if (_sp > XB_SPIN_CAP) { atomicAdd(&(bar)[XB_TMO], 1u); break; } } } } while (0)
struct XcdBarrier { unsigned* bar; unsigned x; volatile LAS unsigned* st; };
DI XcdBarrier xcd_barrier_post(unsigned* bar, volatile LAS unsigned* st, bool leader) {
    XcdBarrier b; b.bar = bar; b.x = xb_xcc_id(); b.st = st;
    if (leader) (void)xb_add(&bar[XB_XCNT(b.x)], 1u);
    return b;
}
DI void xcd_barrier_complete(unsigned* bar, unsigned x, unsigned& nloc, unsigned& nx) {
    const unsigned G = gridDim.x * gridDim.y * gridDim.z;
    unsigned sum, cnt, mine, sp = 0u;
    for (;;) {
        sum = 0u; cnt = 0u; mine = 0u;
#pragma unroll
        for (unsigned j = 0; j < 16; ++j) { const unsigned c = xb_ld(&bar[XB_XCNT(j)]); sum += c; cnt += (c > 0u) ? 1u : 0u; mine = (j == x) ? c : mine; }
        if (sum == G) break;
        __builtin_amdgcn_s_sleep(1);
        if ((++sp & 255u) == 0u) { if (xb_ld(&bar[XB_TMO])) break; if (sp > XB_SPIN_CAP) { atomicAdd(&bar[XB_TMO], 1u); break; } }
    }
    nloc = mine > 0u ? mine : 1u; nx = cnt > 0u ? cnt : 1u;
}
DI void xcd_barrier(const XcdBarrier& b, bool leader) {
    asm volatile("s_waitcnt vmcnt(0)" ::: "memory");
    __syncthreads();
    if (leader) {
        unsigned* bar = b.bar;
        __builtin_amdgcn_s_waitcnt(0);
        unsigned nloc = b.st[0], nx = b.st[1];
        if (nloc == 0u) { xcd_barrier_complete(bar, b.x, nloc, nx); b.st[0] = nloc; b.st[1] = nx; }
        const unsigned old = xb_add(&bar[XB_XSUB(b.x)], 1u);
        const unsigned gen = old / nloc;
        if (old + 1u == (gen + 1u) * nloc) {
            __builtin_amdgcn_fence(__ATOMIC_RELEASE, "agent");
            asm volatile("s_waitcnt vmcnt(0)" ::: "memory");
            const unsigned og = xb_add(&bar[XB_TOP], 1u);
            const unsigned tg = og / nx;
            if (og + 1u == (tg + 1u) * nx) xb_add(&bar[XB_TOPGEN], 1u);
            else XB_SPIN(xb_ld(&bar[XB_TOPGEN]) == tg, bar);
            __builtin_amdgcn_fence(__ATOMIC_ACQUIRE, "agent");
            xb_add(&bar[XB_XGEN(b.x)], 1u);
            asm volatile("s_waitcnt vmcnt(0)" ::: "memory");
        } else {
            XB_SPIN(xb_ld(&bar[XB_XGEN(b.x)]) == gen, bar);
            __builtin_amdgcn_fence(__ATOMIC_ACQUIRE, "agent");
            asm volatile("s_waitcnt vmcnt(0)" ::: "memory");
        }
    }
    __syncthreads();
}

namespace pg8 {
constexpr int BM = 256, BK = 64, HALF = 128, HTB = HALF * BK * 2, STAGE_BYTES = 8 * HTB, NXCD = 8;
__host__ __device__ __forceinline__ int lds_byte(int r, int c) { const int st = (r >> 4) * 2 + (c >> 5), rr = r & 15, cc = c & 31, ob = rr * 64 + cc * 2; return st * 1024 + (ob ^ (((ob >> 9) & 1) << 5)); }
__host__ __device__ __forceinline__ void stage_rc(int b, int& R, int& C) { const int st = b / 1024, sb = b % 1024, swz = sb ^ (((sb >> 9) & 1) << 5); R = (st >> 1) * 16 + swz / 64; C = (st & 1) * 32 + (swz % 64) / 2; }
__host__ __device__ __forceinline__ int perm32(int rho) { const int n = rho >> 4, i = rho & 15; return 8 * (i >> 2) + 4 * n + (i & 3); }

struct Unit { int pm, pn; long aoff, boff; int nt, sub; };
struct Gemm { const char* A; const char* B; unsigned lda, ldb; long hstepA, hstepB; int nt; };
struct TileOrder {
    int nM, nN, nwg, G, c, WGM;
    DI void init(int nM_, int nN_, int G_, int c_, int wgm_ = 4) { nM = nM_; nN = nN_; nwg = nM * nN; G = G_; c = c_; WGM = wgm_; }
    DI bool tile(int i, int& pm, int& pn) const {
        const long L = (long)i * G + c; if (L >= nwg) return false;
        int wgid = (int)L; { const int q = nwg / NXCD, r = nwg % NXCD, xcd = wgid % NXCD, off = wgid / NXCD; wgid = (xcd < r ? xcd * (q + 1) : r * (q + 1) + (xcd - r) * q) + off; }
        const int nig = WGM * nN, gid = wgid / nig, fm = gid * WGM, gsz = (nM - fm) < WGM ? (nM - fm) : WGM;
        pm = fm + ((wgid % nig) % gsz); pn = (wgid % nig) / gsz; return true;
    }
};

template <class Epi, class Sched, bool ALIGN_EPI>
DI void gemm_phase(LAS unsigned char* lds, const Gemm g, const Sched& S, const Epi& E, int wave_id) {
    int tid_ = wave_id * 64 + lane_id(); asm volatile("" : "+v"(tid_));
    const int tid = tid_, wid = __builtin_amdgcn_readfirstlane(tid >> 6), lane = tid & 63, wr = wid >> 2, wc = wid & 3, fr = lane & 15, fq = lane >> 4;
    unsigned voffA[2], voffB[2];
#pragma unroll
    for (int i = 0; i < 2; ++i) { int R, C; stage_rc(tid * 16 + i * 8192, R, C); const int Rb = Epi::PERM ? ((R & ~31) + perm32(R & 31)) : R;
        voffA[i] = (unsigned)R * g.lda + (unsigned)C * 2u; voffB[i] = (unsigned)Rb * g.ldb + (unsigned)C * 2u; }
    const long kstep = (long)(BK * 2);
    const long hA = g.hstepA, hB = g.hstepB;
    const unsigned ldsw = (unsigned)wid * 1024u;
    const int aoff = lds_byte(wr * 64 + fr, fq * 8), boff = lds_byte(wc * 32 + fr, fq * 8);
#define PG8_SA(b, h) (((b) * 2 + (h)) * HTB)
#define PG8_SB(b, h) ((4 + (b) * 2 + (h)) * HTB)
#define PG8_STAGE(bufoff, gbase, voff) do { _Pragma("unroll") for (int _i = 0; _i < 2; ++_i) \
        __builtin_amdgcn_global_load_lds((const unsigned*)((const char*)(gbase) + (voff)[_i]), (LAS unsigned*)(lds + (bufoff) + ldsw + _i * 8192), 16, 0, 0); } while (0)
#define PG8_LDA(dst, b, h) do { _Pragma("unroll") for (int m = 0; m < 4; ++m) _Pragma("unroll") for (int k = 0; k < 2; ++k) dst[m][k] = *(const LAS bf16x8*)(lds + PG8_SA(b, h) + aoff + m * 2048 + k * 1024); } while (0)
#define PG8_LDB(dst, b, h) do { _Pragma("unroll") for (int n = 0; n < 2; ++n) _Pragma("unroll") for (int k = 0; k < 2; ++k) dst[n][k] = *(const LAS bf16x8*)(lds + PG8_SB(b, h) + boff + n * 2048 + k * 1024); } while (0)
#define PG8_MMA(ai, bj, At, Bt) do { __builtin_amdgcn_s_setprio(1); _Pragma("unroll") for (int m = 0; m < 4; ++m) _Pragma("unroll") for (int n = 0; n < 2; ++n) _Pragma("unroll") for (int k = 0; k < 2; ++k) \
        acc[ai][bj][m][n] = __builtin_amdgcn_mfma_f32_16x16x32_bf16(Bt[n][k], At[m][k], acc[ai][bj][m][n], 0, 0, 0); __builtin_amdgcn_s_setprio(0); } while (0)
#define PG8_WAIT_V(n) asm volatile("s_waitcnt vmcnt(" #n ")" ::: "memory")
#define PG8_WAIT_L(n) asm volatile("s_waitcnt lgkmcnt(" #n ")" ::: "memory")
#define PG8_BAR __builtin_amdgcn_s_barrier()
#define PG8_SCHED __builtin_amdgcn_sched_barrier(0)
    Unit cur, nxt; int ui = 0;
    if (!S.next(0, cur)) return;
    f32x4 acc[2][2][4][2];
#pragma unroll
    for (int a = 0; a < 2; ++a)
#pragma unroll
        for (int b = 0; b < 2; ++b)
#pragma unroll
            for (int m = 0; m < 4; ++m)
#pragma unroll
                for (int n = 0; n < 2; ++n) acc[a][b][m][n] = (f32x4){0.f, 0.f, 0.f, 0.f};
    bf16x8 At[4][2], B0[2][2], B1[2][2];
    const char* cA = g.A + cur.aoff; const char* cB = g.B + cur.boff;
    PG8_STAGE(PG8_SB(0, 0), cB, voffB); PG8_STAGE(PG8_SB(0, 1), cB + hB, voffB); PG8_STAGE(PG8_SA(0, 0), cA, voffA); PG8_STAGE(PG8_SA(0, 1), cA + hA, voffA);
    if (wr == 1) PG8_BAR;
    PG8_WAIT_V(2); PG8_BAR;
    PG8_STAGE(PG8_SB(1, 0), cB + kstep, voffB); PG8_STAGE(PG8_SA(1, 0), cA + kstep, voffA); PG8_STAGE(PG8_SB(1, 1), cB + hB + kstep, voffB);
    PG8_WAIT_V(6); PG8_BAR;
    for (;;) {
        const bool has_next = S.next(ui + 1, nxt);
        const char* nA = has_next ? g.A + nxt.aoff : cA; const char* nB = has_next ? g.B + nxt.boff : cB;
        const int nt = cur.nt;
        for (int t = 0; t < nt; t += 2) {
            const bool last = (t == nt - 2);
            const char* a1 = cA + (long)(t + 1) * kstep;
            const char* a2 = last ? nA : cA + (long)(t + 2) * kstep; const char* b2 = last ? nB : cB + (long)(t + 2) * kstep;
            const char* a3 = a2 + kstep; const char* b3 = b2 + kstep;
            PG8_LDB(B0, 0, 0); PG8_LDB(B1, 0, 1); PG8_SCHED; PG8_LDA(At, 0, 0); PG8_STAGE(PG8_SA(1, 1), a1 + hA, voffA);
            PG8_WAIT_V(8); PG8_WAIT_L(0); PG8_BAR; PG8_MMA(0, 0, At, B0); PG8_MMA(0, 1, At, B1); PG8_BAR; PG8_SCHED;
            PG8_LDA(At, 0, 1); PG8_STAGE(PG8_SB(0, 0), b2, voffB); PG8_STAGE(PG8_SB(0, 1), b2 + hB, voffB); PG8_STAGE(PG8_SA(0, 0), a2, voffA);
            PG8_WAIT_V(8); PG8_WAIT_L(0); PG8_BAR; PG8_MMA(1, 0, At, B0); PG8_MMA(1, 1, At, B1); PG8_BAR; PG8_SCHED;
            PG8_LDB(B0, 1, 0); PG8_LDB(B1, 1, 1); PG8_SCHED; PG8_LDA(At, 1, 0); PG8_STAGE(PG8_SA(0, 1), a2 + hA, voffA);
            PG8_WAIT_V(8); PG8_WAIT_L(0); PG8_BAR; PG8_MMA(0, 0, At, B0); PG8_MMA(0, 1, At, B1); PG8_BAR; PG8_SCHED;
            PG8_LDA(At, 1, 1); PG8_STAGE(PG8_SB(1, 0), b3, voffB); PG8_STAGE(PG8_SB(1, 1), b3 + hB, voffB); PG8_STAGE(PG8_SA(1, 0), a3, voffA);
            PG8_WAIT_V(8); PG8_WAIT_L(0); PG8_BAR; PG8_MMA(1, 0, At, B0); PG8_MMA(1, 1, At, B1); PG8_BAR; PG8_SCHED;
        }
        if constexpr (ALIGN_EPI) { if (wr == 0) PG8_BAR; }
        E(acc, cur, ui, wr, wc, fr, fq);
        if (!has_next) break;
#pragma unroll
        for (int a = 0; a < 2; ++a)
#pragma unroll
            for (int b = 0; b < 2; ++b)
#pragma unroll
                for (int m = 0; m < 4; ++m)
#pragma unroll
                    for (int n = 0; n < 2; ++n) acc[a][b][m][n] = (f32x4){0.f, 0.f, 0.f, 0.f};
        cur = nxt; cA = nA; cB = nB; ++ui;
        if constexpr (ALIGN_EPI) { if (wr == 1) PG8_BAR; }
    }
    PG8_WAIT_V(0);
    if constexpr (!ALIGN_EPI) { if (wr == 0) PG8_BAR; }
    PG8_BAR;
#undef PG8_SA
#undef PG8_SB
#undef PG8_STAGE
#undef PG8_LDA
#undef PG8_LDB
#undef PG8_MMA
#undef PG8_WAIT_V
#undef PG8_WAIT_L
#undef PG8_BAR
#undef PG8_SCHED
}
}
constexpr size_t MiB = (size_t)1 << 20;
constexpr size_t WS_CTL = 0, CTL_ZERO_BYTES = 64 * 1024;
constexpr size_t WS_WMIX = 1 * MiB, WS_WFFN = 67 * MiB, WS_XN = 133 * MiB, WS_H = 328 * MiB, WS_SCR = 716 * MiB, WS_END = 1524 * MiB;
constexpr size_t B194 = (size_t)MP * D * 2;
static_assert(B194 == 194 * MiB, "buffer size");
static_assert(WS_XN + 4096 + B194 <= WS_H && WS_H + 2 * B194 <= WS_SCR && WS_SCR + 4 * B194 <= WS_END, "ws map");
static_assert((size_t)MP * DFF * 2 <= WS_END - WS_SCR && (size_t)MP * 6144 * 2 <= WS_END - WS_SCR && WS_SCR + 4 * B194 + (size_t)MP * 128 <= WS_END, "scratch");
constexpr int CW_BAR = 1024;
constexpr int MISC_OFF = 163840 - 256, RING_BYTES = 131072, EDGE_OFF = 131072, EDGE_BYTES = 8192, LDS_BYTES = 163840;

struct Args { const float* in[30]; float* out; unsigned char* ws; int ph_lo, ph_hi; };

struct Frame {
    LAS unsigned char* lds;
    int wave, G, bid;
    DI int lane() const { return lane_id(); }
    DI int tid() const { return wave * 64 + lane_id(); }
    const float* const* in;
    float* out; unsigned char* ws;
    DI const float* I(int i) const { return in[i]; }
    DI bf16_t* XN() const { return (bf16_t*)(ws + WS_XN + 4096); }
    DI bf16_t* XC() const { return (bf16_t*)(ws + WS_H); }
    DI unsigned char* SCR() const { return ws + WS_SCR; }
    DI unsigned char* WMIX() const { return ws + WS_WMIX; }
    DI unsigned char* WFFN() const { return ws + WS_WFFN; }
};

struct SchedLin {
    pg8::TileOrder o; long a_base, a_tile, b_base, b_tile; int nt;
    DI bool next(int i, pg8::Unit& u) const { if (!o.tile(i, u.pm, u.pn)) return false; u.aoff = a_base + (long)u.pm * a_tile; u.boff = b_base + (long)u.pn * b_tile; u.nt = nt; u.sub = -1; return true; }
};
struct SchedGates {
    pg8::TileOrder o;
    DI bool next(int i, pg8::Unit& u) const { if (!o.tile(i, u.pm, u.pn)) return false; const int dir = u.pn >> 4, blk = (u.pn >> 1) & 7, hh = u.pn & 1;
        u.aoff = (long)u.pm * 256 * (D * 2) + blk * 512; u.boff = (long)((dir * 2) * 8 + blk) * 131072 + hh * 65536; u.nt = 4; u.sub = -1; return true; }
};

constexpr int RES_MAIN_PM = 192, RES_ROW0 = RES_MAIN_PM * 256, RES_NSPLIT = 4;
struct SchedRes {
    pg8::TileOrder o; long a_tile, b_base, b_tile; int nt; int G, c;
    DI void init(int G_, int c_, long a_tile_, long b_base_, long b_tile_, int nt_, int wgm_ = 4) { o.init(RES_MAIN_PM, 8, G_, c_, wgm_); G = G_; c = c_; a_tile = a_tile_; b_base = b_base_; b_tile = b_tile_; nt = nt_; }
    DI bool next(int i, pg8::Unit& u) const {
        const long L = (long)i * G + c;
        if (L < RES_MAIN_PM * 8) { o.tile(i, u.pm, u.pn); u.aoff = (long)u.pm * a_tile; u.boff = b_base + (long)u.pn * b_tile; u.nt = nt; u.sub = -1; return true; }
        const int r = (int)(L - RES_MAIN_PM * 8); if (r >= 16 * RES_NSPLIT) return false;
        const int s = r % RES_NSPLIT, t = r / RES_NSPLIT, nts = nt / RES_NSPLIT;
        u.pm = RES_MAIN_PM + (t >> 3); u.pn = t & 7; u.aoff = (long)u.pm * a_tile + (long)s * nts * 128; u.boff = b_base + (long)u.pn * b_tile + (long)s * nts * 128; u.nt = nts; u.sub = s; return true; }
};

DI float row_rs(const float* rsv, int row, int) { return rsv[row]; }
#ifndef NT_STORES
#define NT_STORES 0
#endif
template <class T> DI void st_stream(T* p, const T v) { if (NT_STORES) __builtin_nontemporal_store(v, p); else *p = v; }
DI u32x4 pack8(const f32x4 v0, const f32x4 v1) { u32x4 w; w.x = cvt_pk_bf16(v0[0], v0[1]); w.y = cvt_pk_bf16(v0[2], v0[3]); w.z = cvt_pk_bf16(v1[0], v1[1]); w.w = cvt_pk_bf16(v1[2], v1[3]); return w; }

struct EpiRgIn {
    static constexpr bool PERM = true;
    bf16_t* ygate; bf16_t* yrec; const float* ss;
    DI void operator()(const f32x4 (&acc)[2][2][4][2], const pg8::Unit& u, int, int wr, int wc, int fr, int fq) const {
        const bool isg = u.pn < 8; bf16_t* base = isg ? ygate : yrec; const int colt = (isg ? u.pn : u.pn - 8) * 256;
        const int row0 = u.pm * 256 + wr * 64 + fr, col0 = colt + wc * 32 + 8 * fq;
        float rs8[2][4];
#pragma unroll
        for (int ai = 0; ai < 2; ++ai)
#pragma unroll
            for (int m = 0; m < 4; ++m) rs8[ai][m] = row_rs(ss, row0 + ai * 128 + m * 16, fq);
#pragma unroll
        for (int ai = 0; ai < 2; ++ai)
#pragma unroll
            for (int m = 0; m < 4; ++m) { bf16_t* rowp = base + (size_t)(row0 + ai * 128 + m * 16) * D + col0; const float rs = rs8[ai][m];
#pragma unroll
                for (int bj = 0; bj < 2; ++bj) { f32x4 v0 = acc[ai][bj][m][0] * rs, v1 = acc[ai][bj][m][1] * rs;
                    if (isg) {
#pragma unroll
                        for (int j = 0; j < 4; ++j) { v0[j] = gelu_tanh_(v0[j]); v1[j] = gelu_tanh_(v1[j]); } }
                    st_stream((u32x4*)(rowp + bj * 128), pack8(v0, v1)); } }
    }
};
struct EpiPlainBf16 {
    static constexpr bool PERM = true;
    bf16_t* O; int ldc; const float* ss;
    DI void operator()(const f32x4 (&acc)[2][2][4][2], const pg8::Unit& u, int, int wr, int wc, int fr, int fq) const {
        const int row0 = u.pm * 256 + wr * 64 + fr, col0 = u.pn * 256 + wc * 32 + 8 * fq;
        float rs8[2][4];
#pragma unroll
        for (int ai = 0; ai < 2; ++ai)
#pragma unroll
            for (int m = 0; m < 4; ++m) rs8[ai][m] = row_rs(ss, row0 + ai * 128 + m * 16, fq);
#pragma unroll
        for (int ai = 0; ai < 2; ++ai)
#pragma unroll
            for (int m = 0; m < 4; ++m) { bf16_t* rowp = O + (size_t)(row0 + ai * 128 + m * 16) * ldc + col0; const float rs = rs8[ai][m];
#pragma unroll
                for (int bj = 0; bj < 2; ++bj) st_stream((u32x4*)(rowp + bj * 128), pack8(acc[ai][bj][m][0] * rs, acc[ai][bj][m][1] * rs)); }
    }
};
struct EpiGdnProj {
    static constexpr bool PERM = true;
    bf16_t* qkv; bf16_t* z; float* bg; const float* a_log; const float* dt_bias; bf16_t* halo; const float* ss;
    DI void operator()(const f32x4 (&acc)[2][2][4][2], const pg8::Unit& u, int, int wr, int wc, int fr, int fq) const {
        const int row0 = u.pm * 256 + wr * 64 + fr;
        float rs8[2][4];
#pragma unroll
        for (int ai = 0; ai < 2; ++ai)
#pragma unroll
            for (int m = 0; m < 4; ++m) rs8[ai][m] = row_rs(ss, row0 + ai * 128 + m * 16, fq);
        if (u.pn < 24) {
            bf16_t* base; int ldc, colt; if (u.pn < 16) { base = qkv; ldc = 4096; colt = u.pn * 256; } else { base = z; ldc = 2048; colt = (u.pn - 16) * 256; }
            const int col0 = colt + wc * 32 + 8 * fq;
#pragma unroll
            for (int ai = 0; ai < 2; ++ai)
#pragma unroll
                for (int m = 0; m < 4; ++m) { const int row = row0 + ai * 128 + m * 16; bf16_t* rowp = base + (size_t)row * ldc + col0;
                    const int r64 = row & 63, rb = row >> 6;
                    bf16_t* hp = nullptr;
                    if (u.pn < 16) { if (r64 == 63) hp = halo + ((size_t)(rb + 1) * 3 + 0) * 4096 + col0; else if (r64 == 0 && rb > 0) hp = halo + ((size_t)(rb - 1) * 3 + 1) * 4096 + col0; else if (r64 == 1 && rb > 0) hp = halo + ((size_t)(rb - 1) * 3 + 2) * 4096 + col0; }
                    const float rs = rs8[ai][m];
#pragma unroll
                    for (int bj = 0; bj < 2; ++bj) { const u32x4 w = pack8(acc[ai][bj][m][0] * rs, acc[ai][bj][m][1] * rs); st_stream((u32x4*)(rowp + bj * 128), w); if (hp) *(u32x4*)(hp + bj * 128) = w; } }
        } else {
            const int c0 = wc * 32 + 8 * fq;
            float al[8], db[8];
#pragma unroll
            for (int j = 0; j < 8; ++j) { const int c = c0 + j; al[j] = c >= 64 ? __expf(a_log[c - 64]) : 0.f; db[j] = c >= 64 ? dt_bias[c - 64] : 0.f; }
#pragma unroll
            for (int ai = 0; ai < 2; ++ai)
#pragma unroll
                for (int m = 0; m < 4; ++m) { float* rowp = bg + (size_t)(row0 + ai * 128 + m * 16) * 128 + c0; const float rs = rs8[ai][m];
                    f32x4 o[2];
#pragma unroll
                    for (int n = 0; n < 2; ++n)
#pragma unroll
                        for (int j = 0; j < 4; ++j) { const float x = acc[ai][0][m][n][j] * rs; const int jj = n * 4 + j;
                            o[n][j] = (c0 >= 64) ? -al[jj] * softplusf_(x + db[jj]) : sigmoidf_(x); }
                    *(f32x4*)(rowp) = o[0]; *(f32x4*)(rowp + 4) = o[1]; }
        }
    }
};
struct EpiResAdd {
    static constexpr bool PERM = true;
    const bf16_t* xin; bf16_t* xn; float* ss; float* slab;
    DI void operator()(const f32x4 (&acc)[2][2][4][2], const pg8::Unit& u, int, int wr, int wc, int fr, int fq) const {
        const int row0 = u.pm * 256 + wr * 64 + fr, col0 = u.pn * 256 + wc * 32 + 8 * fq;
        if (u.sub >= 0) {
#pragma unroll
            for (int ai = 0; ai < 2; ++ai)
#pragma unroll
                for (int m = 0; m < 4; ++m) { float* sp = slab + ((size_t)u.sub * 512 + (row0 + ai * 128 + m * 16 - RES_ROW0)) * D + col0;
#pragma unroll
                    for (int bj = 0; bj < 2; ++bj) { *(f32x4*)(sp + bj * 128) = acc[ai][bj][m][0]; *(f32x4*)(sp + bj * 128 + 4) = acc[ai][bj][m][1]; } }
            return; }
        const int l_ = lane_id(); const unsigned voff = (unsigned)((l_ & 15) * D + 8 * (l_ >> 4)) * 2u;
        const char* xi_u = (const char*)xin + ((size_t)(u.pm * 256 + wr * 64) * D + u.pn * 256 + wc * 32) * 2;
        char* xn_u = (char*)xn + ((size_t)(u.pm * 256 + wr * 64) * D + u.pn * 256 + wc * 32) * 2;
        u32x4 v[2][4][2];
#pragma unroll
        for (int ai = 0; ai < 2; ++ai)
#pragma unroll
            for (int m = 0; m < 4; ++m)
#pragma unroll
                for (int bj = 0; bj < 2; ++bj) v[ai][m][bj] = *(const u32x4*)(xi_u + (size_t)(ai * 128 + m * 16) * (D * 2) + bj * 256 + voff);
#pragma unroll
        for (int ai = 0; ai < 2; ++ai) {
#pragma unroll
            for (int m = 0; m < 4; ++m) { const int row = row0 + ai * 128 + m * 16; char* rowp = xn_u + (size_t)(ai * 128 + m * 16) * (D * 2);
                float sq = 0.f;
#pragma unroll
                for (int bj = 0; bj < 2; ++bj) { const u32x4 vv = v[ai][m][bj];
                    const f32x4 h0 = (f32x4){bf_lo(vv.x), bf_hi(vv.x), bf_lo(vv.y), bf_hi(vv.y)} + acc[ai][bj][m][0], h1 = (f32x4){bf_lo(vv.z), bf_hi(vv.z), bf_lo(vv.w), bf_hi(vv.w)} + acc[ai][bj][m][1];
                    const u32x4 w = pack8(h0, h1); *(u32x4*)(rowp + bj * 256 + voff) = w;
                    if (ss) { const float r0 = bf_lo(w.x), r1 = bf_hi(w.x), r2 = bf_lo(w.y), r3 = bf_hi(w.y), r4 = bf_lo(w.z), r5 = bf_hi(w.z), r6 = bf_lo(w.w), r7 = bf_hi(w.w);
                        sq += ((r0 * r0 + r1 * r1) + (r2 * r2 + r3 * r3)) + ((r4 * r4 + r5 * r5) + (r6 * r6 + r7 * r7)); } }
                if (ss) { sq += __shfl_xor(sq, 16); sq += __shfl_xor(sq, 32); if (fq == 0) ss[((size_t)u.pm * 32 + u.pn * 4 + wc) * 256 + (row & 255)] = sq; } }
        }
    }
};
#ifndef GATES_TOP
#define GATES_TOP 4
#endif
struct EpiGates {
    static constexpr bool PERM = true;
    const bf16_t* xc; bf16_t* la; bf16_t* uu;
    size_t dstride; const float* b_a; const float* b_i; const float* lam;
    LAS float* cl;
    DI void operator()(const f32x4 (&acc)[2][2][4][2], const pg8::Unit& u, int, int wr, int wc, int fr, int fq) const {
        const int dir = u.pn >> 4, blk = (u.pn >> 1) & 7, hh = u.pn & 1;
        const int row0 = u.pm * 256 + wr * 64 + fr, c0 = blk * 256 + hh * 128 + wc * 32 + 8 * fq;
        LAS float* cw_ = cl + (wr * 4 + wc) * 96;
        { const int lane = lane_id(); if (lane < 32) { const int c = dir * D + blk * 256 + hh * 128 + wc * 32 + lane;
            cw_[lane] = b_a[c]; cw_[32 + lane] = b_i[c]; cw_[64 + lane] = -8.0f * softplus_lite(-lam[c]); } }
        const int l_ = lane_id(); const unsigned voff = (unsigned)((l_ & 15) * D + 8 * (l_ >> 4)) * 2u;
        const size_t uoff = ((size_t)(u.pm * 256 + wr * 64) * D + blk * 256 + hh * 128 + wc * 32) * 2;
        const char* xc_u = (const char*)xc + uoff; char* la_u = (char*)(la + dir * dstride) + uoff; char* uu_u = (char*)(uu + dir * dstride) + uoff;
        u32x4 xw4[2][4];
#pragma unroll
        for (int g = 0; g < GATES_TOP; ++g) xw4[g >> 2][g & 3] = *(const u32x4*)(xc_u + (size_t)((g >> 2) * 128 + (g & 3) * 16) * (D * 2) + voff);
#pragma unroll
        for (int ai = 0; ai < 2; ++ai) {
#pragma unroll
            for (int m = 0; m < 4; ++m) { const size_t off = (size_t)(ai * 128 + m * 16) * (D * 2);
                const u32x4 xw = xw4[ai][m];
                float xv[8]; xv[0] = bf_lo(xw.x); xv[1] = bf_hi(xw.x); xv[2] = bf_lo(xw.y); xv[3] = bf_hi(xw.y); xv[4] = bf_lo(xw.z); xv[5] = bf_hi(xw.z); xv[6] = bf_lo(xw.w); xv[7] = bf_hi(xw.w);
                f32x4 lo[2], uo[2];
#pragma unroll
                for (int n = 0; n < 2; ++n) { LAS float* cp = cw_ + 8 * fq; asm volatile("" : "+v"(cp));
                    const f32x4 ba = *(const LAS f32x4*)(cp + 4 * n), bi = *(const LAS f32x4*)(cp + 32 + 4 * n), sp = *(const LAS f32x4*)(cp + 64 + 4 * n);
#pragma unroll
                    for (int j = 0; j < 4; ++j) { const int jj = n * 4 + j;
                        const float r = sigmoidf_(acc[ai][0][m][n][j] + ba[j]), ig = sigmoidf_(acc[ai][1][m][n][j] + bi[j]);
                        const float l = sp[j] * r;
                        lo[n][j] = l; const float x2 = 2.0f * l;
                        const float om_e = 1.0f - __expf(x2), om_s = -x2 * (1.0f + 0.5f * x2);
                        const float om = x2 > -0.0009765625f ? om_s : om_e;
                        uo[n][j] = __builtin_amdgcn_sqrtf(fmaxf(om, 0.f)) * (ig * xv[jj]); }
                    __builtin_amdgcn_sched_barrier(0); }
                *(u32x4*)(la_u + off + voff) = pack8(lo[0], lo[1]);
                *(u32x4*)(uu_u + off + voff) = pack8(uo[0], uo[1]);
                __builtin_amdgcn_sched_barrier(0);
                if (ai == 0 && m == 0) {
#pragma unroll
                    for (int g = GATES_TOP; g < 8; ++g) xw4[g >> 2][g & 3] = *(const u32x4*)(xc_u + (size_t)((g >> 2) * 128 + (g & 3) * 16) * (D * 2) + voff);
                    __builtin_amdgcn_sched_barrier(0); } }
        }
    }
};
struct EpiFfnUp {
    static constexpr bool PERM = true;
    bf16_t* act; const float* cw; const float* cb; LAS float* edge; const float* ss; const unsigned char* rflag;
    DI void operator()(f32x4 (&acc)[2][2][4][2], const pg8::Unit& u, int ui, int wr, int wc, int fr, int fq) const {
        const int lane = fq * 16 + fr;
        LAS float* ef = edge + (ui & 1) * 1024, * el = ef + 512;
        LAS float* tapl = edge + 2048 + (wr * 4 + wc) * 128;
        const int cg0 = wc * 32 + 8 * fq;
        float rs8[2][4]; unsigned flp[2] = {0u, 0u};
#pragma unroll
        for (int ai = 0; ai < 2; ++ai)
#pragma unroll
            for (int m = 0; m < 4; ++m) { const int r = 128 * ai + 64 * wr + 16 * m + fr; const int R = 254 * u.pm - 1 + r; const int Rc = R < 0 ? 0 : R;
                rs8[ai][m] = row_rs(ss, Rc, fq); flp[ai] |= ((__float_as_uint(rs8[ai][m]) & 3u) | ((r >= 1 && r <= 254 && R < MTOK) ? 4u : 0u)) << (8 * m); }
        if (lane < 32) { const int a = lane >> 3, c = lane & 7; const float* src = (a < 3 ? cw + (size_t)a * DFF : cb) + u.pn * 128 + wc * 32 + 4 * c;
            *(LAS f32x4*)(tapl + a * 32 + 4 * c) = *(const f32x4*)src; }
#pragma unroll
        for (int ai = 0; ai < 2; ++ai)
#pragma unroll
            for (int m = 0; m < 4; ++m)
#pragma unroll
                for (int bj = 0; bj < 2; ++bj)
#pragma unroll
                    for (int n = 0; n < 2; ++n) acc[ai][bj][m][n] = acc[ai][bj][m][n] * rs8[ai][m];
        __builtin_amdgcn_sched_barrier(0);
#pragma unroll
        for (int ai = 0; ai < 2; ++ai) { const int sg = 2 * ai + wr;
            if (fr == 0) { *(LAS f32x4*)(ef + sg * 128 + cg0) = acc[ai][0][0][0]; *(LAS f32x4*)(ef + sg * 128 + cg0 + 4) = acc[ai][0][0][1]; }
            if (fr == 15) { *(LAS f32x4*)(el + sg * 128 + cg0) = acc[ai][0][3][0]; *(LAS f32x4*)(el + sg * 128 + cg0 + 4) = acc[ai][0][3][1]; } }
        asm volatile("s_waitcnt lgkmcnt(0)" ::: "memory"); __builtin_amdgcn_s_barrier(); asm volatile("" ::: "memory");
        const int cf0 = u.pn * 128 + cg0;
#ifdef FFU_EPI_REP
        int reps_ = FFU_EPI_REP; asm volatile("" : "+s"(reps_));
        for (int rep_ = 0; rep_ < reps_; ++rep_)
#endif
#pragma unroll
        for (int ai = 0; ai < 2; ++ai) { const int sg = 2 * ai + wr;
#pragma unroll
            for (int n = 0; n < 2; ++n) {
                const f32x4 w0 = *(const LAS f32x4*)(tapl + 8 * fq + 4 * n), w1 = *(const LAS f32x4*)(tapl + 32 + 8 * fq + 4 * n), w2 = *(const LAS f32x4*)(tapl + 64 + 8 * fq + 4 * n), bb = *(const LAS f32x4*)(tapl + 96 + 8 * fq + 4 * n);
                const f32x4 htop = sg > 0 ? *(LAS f32x4*)(el + (sg - 1) * 128 + cg0 + 4 * n) : (f32x4){0.f, 0.f, 0.f, 0.f};
                const f32x4 hbot = sg < 3 ? *(LAS f32x4*)(ef + (sg + 1) * 128 + cg0 + 4 * n) : (f32x4){0.f, 0.f, 0.f, 0.f};
                unsigned pk[4][2];
#pragma unroll
                for (int jp = 0; jp < 2; ++jp) {
                    float pvv[2][4], nvv[2][4], vv[2][4];
#pragma unroll
                    for (int j2 = 0; j2 < 2; ++j2) { const int j = 2 * jp + j2;
                        float upv[4], dnv[4];
#pragma unroll
                        for (int m = 0; m < 4; ++m) { vv[j2][m] = acc[ai][0][m][n][j];
                            upv[m] = __int_as_float(__builtin_amdgcn_update_dpp(0, __float_as_int(vv[j2][m]), 0x121, 0xf, 0xf, false));
                            dnv[m] = __int_as_float(__builtin_amdgcn_update_dpp(0, __float_as_int(vv[j2][m]), 0x12F, 0xf, 0xf, false)); }
#pragma unroll
                        for (int m = 0; m < 4; ++m) {
                            float pv = fr > 0 ? upv[m] : (m > 0 ? upv[m > 0 ? m - 1 : 0] : htop[j]);
                            float nv = fr < 15 ? dnv[m] : (m < 3 ? dnv[m < 3 ? m + 1 : 3] : hbot[j]);
                            pvv[j2][m] = (flp[ai] & (1u << (8 * m))) ? 0.f : pv; nvv[j2][m] = (flp[ai] & (2u << (8 * m))) ? 0.f : nv; } }
                    const f32x2 W0 = (f32x2){w0[2 * jp], w0[2 * jp + 1]}, W1 = (f32x2){w1[2 * jp], w1[2 * jp + 1]}, W2 = (f32x2){w2[2 * jp], w2[2 * jp + 1]}, BB = (f32x2){bb[2 * jp], bb[2 * jp + 1]};
#pragma unroll
                    for (int m = 0; m < 4; ++m) {
                        const f32x2 P = (f32x2){pvv[0][m], pvv[1][m]}, V = (f32x2){vv[0][m], vv[1][m]}, N = (f32x2){nvv[0][m], nvv[1][m]};
                        const f32x2 a = W0 * P + (W1 * V + (W2 * N + BB));
                        const f32x2 t = a * (f32x2){-1.4426950408889634f, -1.4426950408889634f};
                        const f32x2 den = (f32x2){__builtin_amdgcn_exp2f(t[0]), __builtin_amdgcn_exp2f(t[1])} + (f32x2){1.f, 1.f};
                        const f32x2 r = (f32x2){fast_rcp(den[0]), fast_rcp(den[1])};
                        const f32x2 o = (a * r) * (f32x2){acc[ai][1][m][n][2 * jp], acc[ai][1][m][n][2 * jp + 1]};
                        pk[m][jp] = cvt_pk_bf16(o[0], o[1]); }
                    __builtin_amdgcn_sched_barrier(0);
                }
#pragma unroll
                for (int m = 0; m < 4; ++m) if (flp[ai] & (4u << (8 * m))) { u32x2 w; w.x = pk[m][0]; w.y = pk[m][1];
                    st_stream((u32x2*)(act + (size_t)(254 * u.pm - 1 + 128 * ai + 64 * wr + 16 * m + fr) * DFF + cf0 + 4 * n), w); }
                __builtin_amdgcn_sched_barrier(0);
            }
        }
    }
};
#define LDS_WAIT() asm volatile("s_waitcnt lgkmcnt(0)" ::: "memory")
DI void cvt_item(const float* W, int ldw, int col0, bf16_t* WT, int ldt, int k0, int n0, LAS float* scr, int lane, const float* gain = nullptr) {
    { float w[32]; const float* wp = W + (size_t)(k0 + (lane >> 5)) * ldw + col0 + n0 + (lane & 31);
#pragma unroll
        for (int i = 0; i < 32; ++i) w[i] = wp[(size_t)(2 * i) * ldw];
        if (gain) {
#pragma unroll
            for (int i = 0; i < 32; ++i) w[i] *= gain[k0 + 2 * i + (lane >> 5)]; }
#pragma unroll
        for (int i = 0; i < 32; ++i) scr[(2 * i + (lane >> 5)) * 33 + (lane & 31)] = w[i]; }
    LDS_WAIT(); asm volatile("" ::: "memory");
    const int c = lane & 7;
#pragma unroll
    for (int j = 0; j < 4; ++j) { const int n = (lane >> 3) + 8 * j; const LAS float* s = scr + (8 * c) * 33 + n;
        u32x4 o; o.x = cvt_pk_bf16(s[0 * 33], s[1 * 33]); o.y = cvt_pk_bf16(s[2 * 33], s[3 * 33]); o.z = cvt_pk_bf16(s[4 * 33], s[5 * 33]); o.w = cvt_pk_bf16(s[6 * 33], s[7 * 33]);
        *(u32x4*)(WT + (size_t)(n0 + n) * ldt + k0 + 8 * c) = o; }
    LDS_WAIT(); asm volatile("" ::: "memory");
}
struct CvtCursor { int cur, base, step; };
DI void cvt_job(CvtCursor& cc, const float* W, int ldw, int col0, int ncols, int K, bf16_t* WT, int ldt, LAS float* scr, int lane, const float* gain = nullptr) {
    const int nb = ncols / 32, n = (K / 64) * nb;
    while (cc.cur < cc.base + n) { const int it = cc.cur - cc.base; cvt_item(W, ldw, col0, WT, ldt, 64 * (it / nb), 32 * (it % nb), scr, lane, gain); cc.cur += cc.step; }
    cc.base += n;
}
DI void cvt_ffn(Frame& F, CvtCursor& cc, int li, LAS float* scr) {
    bf16_t* wg = (bf16_t*)F.WFFN(); bf16_t* wu = wg + (size_t)DFF * D; bf16_t* wd = wu + (size_t)DFF * D;
    cvt_job(cc, F.I(25) + (size_t)li * D * DFF, DFF, 0, DFF, D, wg, D, scr, F.lane(), F.I(4) + (size_t)li * D);
    cvt_job(cc, F.I(26) + (size_t)li * D * DFF, DFF, 0, DFF, D, wu, D, scr, F.lane(), F.I(4) + (size_t)li * D);
    cvt_job(cc, F.I(29) + (size_t)li * DFF * D, D, 0, D, DFF, wd, DFF, scr, F.lane());
}
DI void cvt_rg(Frame& F, CvtCursor& cc, int j, int li, LAS float* scr) {
    bf16_t* win = (bf16_t*)F.WMIX(); bf16_t* gates = win + (size_t)4096 * D; bf16_t* wout = gates + (size_t)32 * 65536;
    cvt_job(cc, F.I(6) + (size_t)j * D * 4096, 4096, 0, 4096, D, win, D, scr, F.lane(), F.I(3) + (size_t)li * D);
    {
        const int n = 32 * 32;
        while (cc.cur < cc.base + n) { const int it = cc.cur - cc.base; const int bid = it >> 5, sub = it & 31; const int gate = bid >> 4, dir = (bid >> 3) & 1, blk = bid & 7;
            const float* src = F.I(gate ? 11 : 9) + (size_t)((j * 2 + dir) * 8 + blk) * 65536;
            cvt_item(src, 256, 0, gates + (size_t)((dir * 2 + gate) * 8 + blk) * 65536, 256, 64 * (sub >> 3), 32 * (sub & 7), scr, F.lane()); cc.cur += cc.step; }
        cc.base += n; }
    cvt_job(cc, F.I(14) + (size_t)j * D * D, D, 0, D, D, wout, D, scr, F.lane());
}
DI void cvt_na(Frame& F, CvtCursor& cc, LAS float* scr) {
    bf16_t* wqkv = (bf16_t*)F.WMIX(); bf16_t* wo = wqkv + (size_t)6144 * D;
    cvt_job(cc, F.I(15), 6144, 0, 6144, D, wqkv, D, scr, F.lane(), F.I(3) + (size_t)1 * D);
    cvt_job(cc, F.I(18), D, 0, D, D, wo, D, scr, F.lane());
}
DI void cvt_gdn(Frame& F, CvtCursor& cc, LAS float* scr) {
    bf16_t* w0 = (bf16_t*)F.WMIX(); bf16_t* w1 = w0 + (size_t)6400 * D; bf16_t* wout = w1 + (size_t)6144 * D;
    const float* W = F.I(19);
    for (int g = 0; g < 2; ++g) { bf16_t* w = g ? w1 : w0;
        cvt_job(cc, W, 12416, g * 1024, 1024, D, w, D, scr, F.lane(), F.I(3) + (size_t)2 * D);
        cvt_job(cc, W, 12416, 2048 + g * 1024, 1024, D, w + (size_t)1024 * D, D, scr, F.lane(), F.I(3) + (size_t)2 * D);
        cvt_job(cc, W, 12416, 4096 + g * 2048, 2048, D, w + (size_t)2048 * D, D, scr, F.lane(), F.I(3) + (size_t)2 * D);
        cvt_job(cc, W, 12416, 8192 + g * 2048, 2048, D, w + (size_t)4096 * D, D, scr, F.lane(), F.I(3) + (size_t)2 * D); }
    cvt_job(cc, W, 12416, 12288, 128, D, w0 + (size_t)6144 * D, D, scr, F.lane(), F.I(3) + (size_t)2 * D);
    cvt_job(cc, F.I(24), D, 0, D, 4096, wout, 4096, scr, F.lane());
}

DI float rs_tag(int R, float rs) { int b, t; row_bt(R, b, t); const unsigned f = (t == 0 ? 1u : 0u) | ((b < NSEQ && t == seq_len(b) - 1) ? 2u : 0u); return __uint_as_float((__float_as_uint(rs) & ~3u) | f); }
template <int MODE> DI void norm_phase(Frame& F, bf16_t* X, const float* gain, float* rsv, const bf16_t* xin2 = nullptr, const float* slab = nullptr) {
    const int gw = F.bid * 8 + F.wave, NGW = F.G * 8, lane = F.lane();
    if (MODE == 1) {
        for (int i = F.bid * 512 + F.tid(); i < (MP - MTOK + 1) * (D / 8); i += F.G * 512) { const int r = i / (D / 8), c = i % (D / 8); const int R = r == 0 ? -1 : MTOK + r - 1;
            *(u32x4*)(X + (long)R * D + c * 8) = (u32x4){0u, 0u, 0u, 0u}; }
        for (int i = F.bid * 512 + F.tid(); i < MP - MTOK; i += F.G * 512) rsv[MTOK + i] = 0.f;
    }
    for (int R = gw; R < MTOK; R += NGW) {
        int b, t; row_bt(R, b, t);
        bf16_t* xr = X + (size_t)R * D;
        if (MODE == 2 && t < NMETA) continue;
        f32x4 v[8]; float s = 0.f;
        if (MODE == 1) {
            const float* src; if (t < NMETA) src = F.I(2) + (size_t)t * D; else if (b < NPROMPT) src = F.I(0) + ((size_t)b * LP + (t - NMETA)) * D; else src = F.I(1) + ((size_t)(b - NPROMPT) * LS + (t - NMETA)) * D;
#pragma unroll
            for (int j = 0; j < 8; ++j) { const f32x4 x = *(const f32x4*)(src + 4 * (lane + 64 * j)); u32x2 w; w.x = cvt_pk_bf16(x[0], x[1]); w.y = cvt_pk_bf16(x[2], x[3]); *(u32x2*)(xr + 4 * (lane + 64 * j)) = w;
                v[j] = (f32x4){bf_lo(w.x), bf_hi(w.x), bf_lo(w.y), bf_hi(w.y)}; }
        } else {
#pragma unroll
            for (int j = 0; j < 8; ++j) { const u32x2 w = *(const u32x2*)((R >= RES_ROW0 && xin2 ? xin2 + (size_t)R * D : xr) + 4 * (lane + 64 * j)); v[j] = (f32x4){bf_lo(w.x), bf_hi(w.x), bf_lo(w.y), bf_hi(w.y)}; }
            if (R >= RES_ROW0 && slab) {
#pragma unroll
                for (int s = 0; s < RES_NSPLIT; ++s)
#pragma unroll
                    for (int j = 0; j < 8; ++j) v[j] += *(const f32x4*)(slab + ((size_t)s * 512 + (R - RES_ROW0)) * D + 4 * (lane + 64 * j));
#pragma unroll
                for (int j = 0; j < 8; ++j) { const unsigned w0 = cvt_pk_bf16(v[j][0], v[j][1]), w1 = cvt_pk_bf16(v[j][2], v[j][3]); v[j] = (f32x4){bf_lo(w0), bf_hi(w0), bf_lo(w1), bf_hi(w1)}; } }
        }
#pragma unroll
        for (int j = 0; j < 8; ++j) s += (v[j][0] * v[j][0] + v[j][1] * v[j][1]) + (v[j][2] * v[j][2] + v[j][3] * v[j][3]);
        const float rs = 1.0f / sqrtf(wave_sum(s) * (1.0f / D) + NORM_EPS);
        if (MODE == 1) { if (lane == 0) rsv[R] = rs_tag(R, rs); }
        else {
            float* orow = F.out + (b < NPROMPT ? ((size_t)b * LP + (t - NMETA)) : ((size_t)NPROMPT * LP + (size_t)(b - NPROMPT) * LS + (t - NMETA))) * D;
#pragma unroll
            for (int j = 0; j < 8; ++j) { const f32x4 gv = *(const f32x4*)(gain + 4 * (lane + 64 * j)); *(f32x4*)(orow + 4 * (lane + 64 * j)) = v[j] * rs * gv; }
        }
    }
}
DI void ss_final_phase(Frame& F, const float* ssp, float* rsv, const bf16_t* xin, bf16_t* xout, const float* slab0, const float* slab1) {
    for (int R = F.bid * 512 + F.tid(); R < RES_ROW0; R += F.G * 512) { const float* p = ssp + (size_t)(R >> 8) * 32 * 256 + (R & 255); float s = 0.f;
#pragma unroll
        for (int i = 0; i < 8; ++i) s += (p[(4 * i) * 256] + p[(4 * i + 1) * 256]) + (p[(4 * i + 2) * 256] + p[(4 * i + 3) * 256]);
        rsv[R] = rs_tag(R, 1.0f / sqrtf(s * (1.0f / D) + NORM_EPS)); }
    const int lane = F.lane();
    for (int R = RES_ROW0 + F.bid * 8 + F.wave; R < MP; R += F.G * 8) {
        float v[32];
#pragma unroll
        for (int i = 0; i < 4; ++i) { const u32x4 x = *(const u32x4*)(xin + (size_t)R * D + lane * 32 + 8 * i); const unsigned w[4] = {x.x, x.y, x.z, x.w};
#pragma unroll
            for (int k = 0; k < 4; ++k) { v[8 * i + 2 * k] = bf_lo(w[k]); v[8 * i + 2 * k + 1] = bf_hi(w[k]); } }
#pragma unroll
        for (int set = 0; set < 2; ++set) { const float* sl = set ? slab1 : slab0; if (!sl) continue;
#pragma unroll
            for (int s = 0; s < RES_NSPLIT; ++s) { const float* p = sl + ((size_t)s * 512 + (R - RES_ROW0)) * D + lane * 32;
#pragma unroll
                for (int i = 0; i < 8; ++i) { const f32x4 a = *(const f32x4*)(p + 4 * i); v[4 * i] += a[0]; v[4 * i + 1] += a[1]; v[4 * i + 2] += a[2]; v[4 * i + 3] += a[3]; } } }
        float sq = 0.f;
#pragma unroll
        for (int i = 0; i < 4; ++i) { u32x4 w; unsigned ww[4];
#pragma unroll
            for (int k = 0; k < 4; ++k) { ww[k] = cvt_pk_bf16(v[8 * i + 2 * k], v[8 * i + 2 * k + 1]); const float a = bf_lo(ww[k]), b = bf_hi(ww[k]); sq += a * a + b * b; }
            w.x = ww[0]; w.y = ww[1]; w.z = ww[2]; w.w = ww[3]; *(u32x4*)(xout + (size_t)R * D + lane * 32 + 8 * i) = w; }
        const float tot = wave_sum(sq);
        if (lane == 0) rsv[R] = rs_tag(R, 1.0f / sqrtf(tot * (1.0f / D) + NORM_EPS));
    }
}
DI void fill_rflag(Frame& F, unsigned char* rf) { for (int R = F.bid * 512 + F.tid(); R < MP; R += F.G * 512) { int b, t; row_bt(R, b, t); rf[R] = (unsigned char)((t == 0 ? 1 : 0) | ((b < NSEQ && t == seq_len(b) - 1) ? 2 : 0)); } }

DI void rg_conv_phase(Frame& F, const bf16_t* yrec, bf16_t* xc, const float* cw, const float* cb) {
    const int tid = F.tid(), cg = tid & 255, c0 = cg * 8;
    float w[4][8], bb[8];
#pragma unroll
    for (int j = 0; j < 4; ++j)
#pragma unroll
        for (int e = 0; e < 8; ++e) w[j][e] = cw[j * D + c0 + e];
#pragma unroll
    for (int e = 0; e < 8; ++e) bb[e] = cb[c0 + e];
    for (int s = F.bid * 2 + (tid >> 8); s < MTOK / 16; s += F.G * 2) {
        const int R0 = 16 * s; int b, t0; row_bt(R0, b, t0); const int T = seq_len(b);
        const bf16_t* yp = yrec + (size_t)R0 * D + c0;
        u32x4 x0 = (u32x4){0u, 0u, 0u, 0u}, x1, x2, x3;
        if (t0 > 0) x0 = *(const u32x4*)(yp - D);
        x1 = *(const u32x4*)(yp); x2 = *(const u32x4*)(yp + D); x3 = *(const u32x4*)(yp + 2 * D);
#pragma unroll
        for (int i = 0; i < 16; ++i) {
            u32x4 xn = (u32x4){0u, 0u, 0u, 0u};
            if (i < 15 && t0 + i + 3 < T) xn = *(const u32x4*)(yp + (size_t)(i + 3) * D);
            float a[8];
#pragma unroll
            for (int e = 0; e < 8; ++e) a[e] = bb[e];
            const u32x4 xs[4] = {x0, x1, x2, x3};
#pragma unroll
            for (int j = 0; j < 4; ++j) { const u32x4 x = xs[j];
                a[0] += w[j][0] * bf_lo(x.x); a[1] += w[j][1] * bf_hi(x.x); a[2] += w[j][2] * bf_lo(x.y); a[3] += w[j][3] * bf_hi(x.y);
                a[4] += w[j][4] * bf_lo(x.z); a[5] += w[j][5] * bf_hi(x.z); a[6] += w[j][6] * bf_lo(x.w); a[7] += w[j][7] * bf_hi(x.w); }
            u32x4 o; o.x = cvt_pk_bf16(a[0], a[1]); o.y = cvt_pk_bf16(a[2], a[3]); o.z = cvt_pk_bf16(a[4], a[5]); o.w = cvt_pk_bf16(a[6], a[7]);
            *(u32x4*)(xc + (size_t)(R0 + i) * D + c0) = o;
            x0 = x1; x1 = x2; x2 = x3; x3 = xn;
        }
    }
}

template <int N, bool REV> DI void rg_ld(const bf16_t* p, size_t base, int t0, unsigned (&w)[8]) {
#pragma unroll
    for (int i = 0; i < 8; ++i) if (i < N) w[i] = *(const unsigned*)(p + base + (size_t)(REV ? t0 - i : t0 + i) * D);
}
DI void rg_scan_phase(Frame& F, const bf16_t* laf, const bf16_t* uf, const bf16_t* lab, bf16_t* ub, const bf16_t* ygate) {
    int tid_ = F.wave * 64 + lane_id(); asm volatile("" : "+v"(tid_));
    const int tid = tid_, lane = tid & 63, wave = __builtin_amdgcn_readfirstlane(tid >> 6), seg = 2 * wave + (lane >> 5), l32 = lane & 31;
    LAS float* AGG = (LAS float*)F.lds;
    LAS float* CB = AGG + 2 * 16 * 256;
    int items[3]; int ni = 0;
    if (F.G == 256) { if (F.bid < 128) { items[0] = F.bid; items[1] = 128 + F.bid; items[2] = 0; ni = 2; } else { const int b0 = 256 + 3 * (F.bid - 128); items[0] = b0; items[1] = b0 + 1; items[2] = b0 + 2; ni = 3; } }
    for (int ii = 0; ; ++ii) {
        int id;
        if (F.G == 256) { if (ii >= ni) break; id = ii == 0 ? items[0] : (ii == 1 ? items[1] : items[2]); } else { id = F.bid + ii * F.G; if (id >= 640) break; }
        const int b = id < 128 ? NPROMPT + (id >> 5) : ((id - 128) >> 5), cg = id & 31;
        const int T = seq_len(b), SL = T >> 4, NC = T >> 7, nb = NC >> 4;
        const size_t base = (size_t)seq_off(b) * D + cg * 64 + l32 * 2;
        {
            const int s1 = seg * SL + SL - 1;
            float slb0 = 0.f, slb1 = 0.f, hb0 = 0.f, hb1 = 0.f, r1s0 = 0.f, r1s1 = 0.f, r1h0 = 0.f, r1h1 = 0.f, r2s0 = 0.f, r2s1 = 0.f, r2h0 = 0.f, r2h1 = 0.f;
            const int w1 = seg, w2 = 128 + seg;
            unsigned lb[8], ub_[8], lr[8], ur[8];
            rg_ld<1, true>(lab, base, s1 - (SL - 1), lr); rg_ld<1, true>(ub, base, s1 - (SL - 1), ur);
            rg_ld<8, true>(lab, base, s1, lb); rg_ld<8, true>(ub, base, s1, ub_);
            for (int i0 = 0; i0 + 8 <= SL; i0 += 8) {
                unsigned lbn[8], ubn[8];
#pragma unroll
                for (int i = 0; i < 8; ++i) { lbn[i] = 0u; ubn[i] = 0u; }
                if (i0 + 16 <= SL) { rg_ld<8, true>(lab, base, s1 - i0 - 8, lbn); rg_ld<8, true>(ub, base, s1 - i0 - 8, ubn); }
#pragma unroll
                for (int i = 0; i < 8; ++i) { const float c0 = bf_lo(lb[i]), c1 = bf_hi(lb[i]); slb0 += c0; slb1 += c1; hb0 = __expf(c0) * hb0 + bf_lo(ub_[i]); hb1 = __expf(c1) * hb1 + bf_hi(ub_[i]);
                    const bool q1 = (i0 + i == w1), q2 = (i0 + i == w2);
                    r1s0 = q1 ? slb0 : r1s0; r1s1 = q1 ? slb1 : r1s1; r1h0 = q1 ? hb0 : r1h0; r1h1 = q1 ? hb1 : r1h1;
                    r2s0 = q2 ? slb0 : r2s0; r2s1 = q2 ? slb1 : r2s1; r2h0 = q2 ? hb0 : r2h0; r2h1 = q2 ? hb1 : r2h1; }
#pragma unroll
                for (int i = 0; i < 8; ++i) { lb[i] = lbn[i]; ub_[i] = ubn[i]; }
            }
            { const float c0 = bf_lo(lr[0]), c1 = bf_hi(lr[0]); slb0 += c0; slb1 += c1; hb0 = __expf(c0) * hb0 + bf_lo(ur[0]); hb1 = __expf(c1) * hb1 + bf_hi(ur[0]);
                const bool q1 = (SL - 1 == w1), q2 = (SL - 1 == w2);
                r1s0 = q1 ? slb0 : r1s0; r1s1 = q1 ? slb1 : r1s1; r1h0 = q1 ? hb0 : r1h0; r1h1 = q1 ? hb1 : r1h1;
                r2s0 = q2 ? slb0 : r2s0; r2s1 = q2 ? slb1 : r2s1; r2h0 = q2 ? hb0 : r2h0; r2h1 = q2 ? hb1 : r2h1; }
            __syncthreads();
            { LAS float* a = AGG + seg * 256 + 2 * l32; *(LAS f32x2*)(a) = (f32x2){slb0, slb1}; *(LAS f32x2*)(a + 64) = (f32x2){hb0, hb1}; }
            __syncthreads();
            float cb0 = 0.f, cb1 = 0.f;
            for (int v = 15; v > seg; --v) { const LAS float* a = AGG + v * 256 + 2 * l32; const f32x2 sl = *(const LAS f32x2*)(a), hh = *(const LAS f32x2*)(a + 64); cb0 = hh[0] + __expf(sl[0]) * cb0; cb1 = hh[1] + __expf(sl[1]) * cb1; }
            *(LAS f32x2*)(CB + (nb * seg + nb) * 64 + 2 * l32) = (f32x2){r1h0 + __expf(r1s0) * cb0, r1h1 + __expf(r1s1) * cb1};
            if (nb == 2) *(LAS f32x2*)(CB + (nb * seg + nb - 1) * 64 + 2 * l32) = (f32x2){r2h0 + __expf(r2s0) * cb0, r2h1 + __expf(r2s1) * cb1};
            __syncthreads();
        }
        float CF0 = 0.f, CF1 = 0.f;
        unsigned A_lf[8], A_uf[8], A_lb[8], A_ub[8], A_g[8];
        { const int t0 = 8 * seg; rg_ld<8, false>(laf, base, t0, A_lf); rg_ld<8, false>(uf, base, t0, A_uf); rg_ld<8, false>(lab, base, t0, A_lb); rg_ld<8, false>(ub, base, t0, A_ub); rg_ld<8, false>(ygate, base, t0, A_g); }
        for (int c = 0; c <= NC; ++c) {
            const bool tail = (c == NC);
            const int tb = 128 * c + (tail ? seg : 8 * seg);
            unsigned B_lf[8], B_uf[8], B_lb[8], B_ub[8], B_g[8];
#pragma unroll
            for (int i = 0; i < 8; ++i) { B_lf[i] = 0u; B_uf[i] = 0u; B_lb[i] = 0u; B_ub[i] = 0u; B_g[i] = 0u; }
            if (c + 1 < NC) { const int t0 = 128 * (c + 1) + 8 * seg; rg_ld<8, false>(laf, base, t0, B_lf); rg_ld<8, false>(uf, base, t0, B_uf); rg_ld<8, false>(lab, base, t0, B_lb); rg_ld<8, false>(ub, base, t0, B_ub); rg_ld<8, false>(ygate, base, t0, B_g); }
            else if (c + 1 == NC) { const int t0 = 128 * NC + seg; rg_ld<1, false>(laf, base, t0, B_lf); rg_ld<1, false>(uf, base, t0, B_uf); rg_ld<1, false>(lab, base, t0, B_lb); rg_ld<1, false>(ub, base, t0, B_ub); rg_ld<1, false>(ygate, base, t0, B_g); }
            float af0[8], af1[8], ab0[8], ab1[8];
            float slf0 = 0.f, slf1 = 0.f, hf0 = 0.f, hf1 = 0.f, slb0 = 0.f, slb1 = 0.f, hb0 = 0.f, hb1 = 0.f;
#pragma unroll
            for (int i = 0; i < 8; ++i) { const float a0 = bf_lo(A_lf[i]), a1 = bf_hi(A_lf[i]); slf0 += a0; slf1 += a1; af0[i] = __expf(a0); af1[i] = __expf(a1); hf0 = af0[i] * hf0 + bf_lo(A_uf[i]); hf1 = af1[i] * hf1 + bf_hi(A_uf[i]); }
#pragma unroll
            for (int i = 7; i >= 0; --i) { const float c0 = bf_lo(A_lb[i]), c1 = bf_hi(A_lb[i]); slb0 += c0; slb1 += c1; ab0[i] = __expf(c0); ab1[i] = __expf(c1); hb0 = ab0[i] * hb0 + bf_lo(A_ub[i]); hb1 = ab1[i] * hb1 + bf_hi(A_ub[i]); }
            LAS float* ag = AGG + (c & 1) * 4096;
            { LAS float* a = ag + seg * 256 + 2 * l32; *(LAS f32x2*)(a) = (f32x2){slf0, slf1}; *(LAS f32x2*)(a + 64) = (f32x2){hf0, hf1}; *(LAS f32x2*)(a + 128) = (f32x2){slb0, slb1}; *(LAS f32x2*)(a + 192) = (f32x2){hb0, hb1}; }
            __syncthreads();
            float cf0 = CF0, cf1 = CF1;
            for (int v = 0; v < seg; ++v) { const LAS float* a = ag + v * 256 + 2 * l32; const f32x2 sl = *(const LAS f32x2*)(a), hh = *(const LAS f32x2*)(a + 64); cf0 = hh[0] + __expf(sl[0]) * cf0; cf1 = hh[1] + __expf(sl[1]) * cf1; }
            { float e0 = cf0, e1 = cf1;
                for (int v = seg; v < 16; ++v) { const LAS float* a = ag + v * 256 + 2 * l32; const f32x2 sl = *(const LAS f32x2*)(a), hh = *(const LAS f32x2*)(a + 64); e0 = hh[0] + __expf(sl[0]) * e0; e1 = hh[1] + __expf(sl[1]) * e1; }
                CF0 = e0; CF1 = e1; }
            float cb0 = 0.f, cb1 = 0.f;
            if (!tail) { const f32x2 r = *(const LAS f32x2*)(CB + (c + 1) * 64 + 2 * l32); cb0 = r[0]; cb1 = r[1]; }
            for (int v = 15; v > seg; --v) { const LAS float* a = ag + v * 256 + 2 * l32; const f32x2 sl = *(const LAS f32x2*)(a + 128), hh = *(const LAS f32x2*)(a + 192); cb0 = hh[0] + __expf(sl[0]) * cb0; cb1 = hh[1] + __expf(sl[1]) * cb1; }
            float f0[8], f1[8];
#pragma unroll
            for (int i = 0; i < 8; ++i) { cf0 = af0[i] * cf0 + bf_lo(A_uf[i]); cf1 = af1[i] * cf1 + bf_hi(A_uf[i]); f0[i] = cf0; f1[i] = cf1; }
#pragma unroll
            for (int i = 7; i >= 0; --i) { cb0 = ab0[i] * cb0 + bf_lo(A_ub[i]); cb1 = ab1[i] * cb1 + bf_hi(A_ub[i]);
                f0[i] = bf_lo(A_g[i]) * (f0[i] + cb0); f1[i] = bf_hi(A_g[i]) * (f1[i] + cb1); }
            if (!tail) {
#pragma unroll
                for (int i = 0; i < 8; ++i) *(unsigned*)(ub + base + (size_t)(tb + i) * D) = cvt_pk_bf16(f0[i], f1[i]);
            } else *(unsigned*)(ub + base + (size_t)tb * D) = cvt_pk_bf16(f0[0], f1[0]);
#pragma unroll
            for (int i = 0; i < 8; ++i) { A_lf[i] = B_lf[i]; A_uf[i] = B_uf[i]; A_lb[i] = B_lb[i]; A_ub[i] = B_ub[i]; A_g[i] = B_g[i]; }
        }
    }
}
constexpr int NA_VPITCH = 144;
constexpr int NA_WAVE_LDS = 32 * NA_VPITCH * 2 + 2048;
DI void na_attn_phase(Frame& F, const bf16_t* qkv, bf16_t* O, const float* rpb, const float* mbias) {
    int tid_ = F.wave * 64 + lane_id(); asm volatile("" : "+v"(tid_));
    const int lane = tid_ & 63, l15 = lane & 15, quad = lane >> 4;
    LAS unsigned char* wl = F.lds + F.wave * NA_WAVE_LDS;
    LAS bf16_t* vt = (LAS bf16_t*)wl;
    LAS float* rp = (LAS float*)(wl + 32 * NA_VPITCH * 2);
    int cached_h = -1;
    const float scale = 0.08838834764831845f;
    const int NITEMS = MTOK;
    for (int id = F.bid * 8 + F.wave; id < NITEMS; id += F.G * 8) {
        int b, h, it, rows;
        if (id < MPROMPT) { const int bh = id / 129; it = id - bh * 129; b = bh >> 4; h = bh & 15; rows = 32; }
        else { const int i2 = id - MPROMPT; const int bh = i2 / 257; it = i2 - bh * 257; b = NPROMPT + (bh >> 4); h = bh & 15; rows = 64; }
        const bool is_meta = (it == rows * 4);
        const int r = it >> 2, n = it & 3;
        const int so = seq_off(b);
        if (h != cached_h) {
            __builtin_amdgcn_wave_barrier();
            for (int i = lane; i < 465; i += 64) rp[i] = rpb[h * 465 + i];
            if (lane < 16) rp[480 + lane] = mbias[h * 16 + lane];
            cached_h = h; LDS_WAIT(); __builtin_amdgcn_wave_barrier(); asm volatile("" ::: "memory");
        }
        int rs = r - 4; rs = rs < 0 ? 0 : (rs > rows - 8 ? rows - 8 : rs);
        int ks = 16 * n - 8; ks = ks < 0 ? 0 : (ks > 32 ? 32 : ks);
        const int qrow = is_meta ? so + l15 : so + NMETA + 64 * r + 16 * n + l15;
        const int qcol = 16 * n + l15; int cs = qcol - 8; cs = cs < 0 ? 0 : (cs > 48 ? 48 : cs);
        bf16x8 qf[4];
#pragma unroll
        for (int s = 0; s < 4; ++s) qf[s] = *(const bf16x8*)(qkv + (size_t)qrow * 6144 + h * 128 + 32 * s + 8 * quad);
        f32x4 sv[17];
#pragma unroll
        for (int kb = 0; kb < 17; ++kb) sv[kb] = (f32x4){-1e30f, -1e30f, -1e30f, -1e30f};
        if (!is_meta) {
#pragma unroll
            for (int kb0 = 0; kb0 < 16; kb0 += 8) {
                bf16x8 kf[8][4];
#pragma unroll
                for (int i = 0; i < 8; ++i) { const int kb = kb0 + i, kr = kb >> 1; const int krow = so + NMETA + 64 * (rs + kr) + ks + 16 * (kb & 1) + l15;
#pragma unroll
                    for (int s = 0; s < 4; ++s) kf[i][s] = *(const bf16x8*)(qkv + (size_t)krow * 6144 + 2048 + h * 128 + 32 * s + 8 * quad); }
#pragma unroll
                for (int i = 0; i < 8; ++i) { const int kb = kb0 + i, kr = kb >> 1;
                    f32x4 st = (f32x4){0.f, 0.f, 0.f, 0.f};
#pragma unroll
                    for (int s = 0; s < 4; ++s) st = __builtin_amdgcn_mfma_f32_16x16x32_bf16(kf[i][s], qf[s], st, 0, 0, 0);
                    const int roff = (rs + kr) - r + 7;
#pragma unroll
                    for (int g = 0; g < 4; ++g) { const int keycol = ks + 16 * (kb & 1) + 4 * quad + g; const bool valid = (keycol >= cs) && (keycol < cs + 16);
                        int coff = keycol - qcol; coff = coff < -15 ? -15 : (coff > 15 ? 15 : coff);
                        sv[kb][g] = valid ? st[g] * scale + rp[roff * 31 + coff + 15] : -1e30f; }
                }
            }
        }
        {
            const int krow = so + l15;
            f32x4 st = (f32x4){0.f, 0.f, 0.f, 0.f};
#pragma unroll
            for (int s = 0; s < 4; ++s) { const bf16x8 kf = *(const bf16x8*)(qkv + (size_t)krow * 6144 + 2048 + h * 128 + 32 * s + 8 * quad);
                st = __builtin_amdgcn_mfma_f32_16x16x32_bf16(kf, qf[s], st, 0, 0, 0); }
#pragma unroll
            for (int g = 0; g < 4; ++g) sv[16][g] = st[g] * scale + rp[480 + 4 * quad + g];
        }
#define NA_LDV(B_, KR_) do { _Pragma("unroll") for (int i = 0; i < 8; ++i) { const int cid = i * 64 + lane, vr = cid >> 4, c16 = cid & 15; B_[i] = (u32x4){0u, 0u, 0u, 0u}; \
            if ((KR_) < 8) B_[i] = *(const u32x4*)(qkv + (size_t)(so + NMETA + 64 * (rs + (KR_)) + ks + vr) * 6144 + 4096 + h * 128 + 8 * c16); \
            else if ((KR_) == 8 && vr < 16) B_[i] = *(const u32x4*)(qkv + (size_t)(so + vr) * 6144 + 4096 + h * 128 + 8 * c16); } } while (0)
        u32x4 vb[3][8];
        if (!is_meta) { NA_LDV(vb[0], 0); NA_LDV(vb[1], 1); NA_LDV(vb[2], 2); }
        else { NA_LDV(vb[2], 8);
#pragma unroll
            for (int i = 0; i < 8; ++i) { vb[0][i] = (u32x4){0u, 0u, 0u, 0u}; vb[1][i] = vb[0][i]; } }
        float mx = -1e30f;
#pragma unroll
        for (int kb = 0; kb < 17; ++kb)
#pragma unroll
            for (int g = 0; g < 4; ++g) mx = fmaxf(mx, sv[kb][g]);
        mx = fmaxf(mx, __shfl_xor(mx, 16)); mx = fmaxf(mx, __shfl_xor(mx, 32));
        float sum = 0.f;
#pragma unroll
        for (int kb = 0; kb < 17; ++kb)
#pragma unroll
            for (int g = 0; g < 4; ++g) { const float p = __expf(sv[kb][g] - mx); sv[kb][g] = p; sum += p; }
        sum += __shfl_xor(sum, 16); sum += __shfl_xor(sum, 32);
        const float inv = 1.0f / sum;
        f32x4 ot[8];
#pragma unroll
        for (int d = 0; d < 8; ++d) ot[d] = (f32x4){0.f, 0.f, 0.f, 0.f};
#pragma unroll
        for (int kr = 0; kr < 9; ++kr) {
            if (!(is_meta && kr < 8)) {
            __builtin_amdgcn_wave_barrier(); asm volatile("" ::: "memory");
#pragma unroll
            for (int i = 0; i < 8; ++i) { const int cid = i * 64 + lane, vr = cid >> 4, c16 = cid & 15; *(LAS u32x4*)(vt + vr * NA_VPITCH + 8 * c16) = vb[kr % 3][i]; }
            LDS_WAIT(); __builtin_amdgcn_wave_barrier(); asm volatile("" ::: "memory");
            if (!is_meta && kr + 3 <= 8) NA_LDV(vb[kr % 3], kr + 3);
            f32x4 p0, p1;
            if (kr < 8) { p0 = sv[2 * kr]; p1 = sv[2 * kr + 1]; } else { p0 = sv[16]; p1 = (f32x4){0.f, 0.f, 0.f, 0.f}; }
            u32x4 pw; pw.x = cvt_pk_bf16(p0[0] * inv, p0[1] * inv); pw.y = cvt_pk_bf16(p0[2] * inv, p0[3] * inv); pw.z = cvt_pk_bf16(p1[0] * inv, p1[1] * inv); pw.w = cvt_pk_bf16(p1[2] * inv, p1[3] * inv);
            const bf16x8 pf = __builtin_bit_cast(bf16x8, pw);
            const LAS bf16_t* tb = vt + (4 * quad + (l15 >> 2)) * NA_VPITCH + 4 * (l15 & 3);
#pragma unroll
            for (int d = 0; d < 8; ++d) {
                const s16x4 lo = __builtin_amdgcn_ds_read_tr16_b64_v4i16((LAS s16x4*)(tb + 16 * d)), hi = __builtin_amdgcn_ds_read_tr16_b64_v4i16((LAS s16x4*)(tb + 16 * NA_VPITCH + 16 * d));
                const bf16x8 vf = (bf16x8){lo[0], lo[1], lo[2], lo[3], hi[0], hi[1], hi[2], hi[3]};
                ot[d] = __builtin_amdgcn_mfma_f32_16x16x32_bf16(vf, pf, ot[d], 0, 0, 0);
            }
            }
        }
#pragma unroll
        for (int d = 0; d < 8; ++d) { u32x2 w; w.x = cvt_pk_bf16(ot[d][0], ot[d][1]); w.y = cvt_pk_bf16(ot[d][2], ot[d][3]);
            *(u32x2*)(O + (size_t)qrow * D + h * 128 + 16 * d + 4 * quad) = w; }
    }
}
constexpr int GD_QS = 0, GD_KS = 17408, GD_VS = 34816, GD_ABF = 52224, GD_ADG = 61440, GD_TIB = 66560, GD_KST = 68608, GD_QKM = 87040, GD_WB = 96256, GD_VEC = 113664, GD_CW = 114944, GD_END = 121088;
constexpr int GD_O = 114944;
constexpr int P_QS = 136, P_KST = 72, P_ADG = 20, P_O = 132;
typedef short bf16x4 __attribute__((ext_vector_type(4)));

DI void gdn_conv_phase(Frame& F, int half, bf16_t* qkvp, const bf16_t* halo, const float* conv_w) {
    int tid_ = F.wave * 64 + lane_id(); asm volatile("" : "+v"(tid_));
    const int tid = tid_, piece = tid & 63, tg = tid >> 6;
    constexpr int NIT = (MTOK / 64) * 8;
    for (int item = F.bid; item < NIT; item += F.G) {
        const bool ivld = true;
        const int rb = item >> 3, cs = item & 7, col = cs * 512 + piece * 8;
        const int X = col < 1024 ? 0 : (col < 2048 ? 1 : 2);
        const int wcol = X == 0 ? half * 1024 + col : (X == 1 ? 2048 + half * 1024 + (col - 1024) : 4096 + half * 2048 + (col - 2048));
        const int r0 = 64 * rb + 8 * tg; int b, t0; row_bt(r0, b, t0); const int T = seq_len(b);
        u32x4 xr[11];
#pragma unroll
        for (int r = 0; r < 11; ++r) { const int tt = t0 - 1 + r, w = r0 - 1 + r; xr[r] = (u32x4){0u, 0u, 0u, 0u};
            if (ivld && tt >= 0 && tt < T) { const bf16_t* p;
                if (w < 64 * rb) p = halo + ((size_t)rb * 3 + 0) * 4096 + col; else if (w >= 64 * rb + 64) p = halo + ((size_t)rb * 3 + 1 + (w - 64 * rb - 64)) * 4096 + col; else p = qkvp + (size_t)w * 4096 + col;
                xr[r] = *(const u32x4*)p; } }
        f32x4 wlo[4], whi[4];
#pragma unroll
        for (int j = 0; j < 4; ++j) { wlo[j] = *(const f32x4*)(conv_w + j * 8192 + wcol); whi[j] = *(const f32x4*)(conv_w + j * 8192 + wcol + 4); }
        u32x4 res[8];
#pragma unroll
        for (int ro = 0; ro < 8; ++ro) {
            float a[8];
#pragma unroll
            for (int e = 0; e < 8; ++e) a[e] = 0.f;
#pragma unroll
            for (int j = 0; j < 4; ++j) { const u32x4 x = xr[ro + j];
                a[0] += wlo[j][0] * bf_lo(x.x); a[1] += wlo[j][1] * bf_hi(x.x); a[2] += wlo[j][2] * bf_lo(x.y); a[3] += wlo[j][3] * bf_hi(x.y);
                a[4] += whi[j][0] * bf_lo(x.z); a[5] += whi[j][1] * bf_hi(x.z); a[6] += whi[j][2] * bf_lo(x.w); a[7] += whi[j][3] * bf_hi(x.w); }
            float ss = 0.f;
#pragma unroll
            for (int e = 0; e < 8; ++e) { a[e] = siluf_(a[e]); ss += a[e] * a[e]; }
            ss += __shfl_xor(ss, 1); ss += __shfl_xor(ss, 2); ss += __shfl_xor(ss, 4); ss += __shfl_xor(ss, 8);
            const float sc = X == 2 ? 1.0f : (1.0f / sqrtf(ss + 1e-6f)) * (X == 0 ? 0.08838834764831845f : 1.0f);
            res[ro] = (u32x4){cvt_pk_bf16(a[0] * sc, a[1] * sc), cvt_pk_bf16(a[2] * sc, a[3] * sc), cvt_pk_bf16(a[4] * sc, a[5] * sc), cvt_pk_bf16(a[6] * sc, a[7] * sc)};
        }
        __syncthreads();
        if (ivld) {
#pragma unroll
            for (int ro = 0; ro < 8; ++ro) *(u32x4*)(qkvp + (size_t)(r0 + ro) * 4096 + col) = res[ro]; }
    }
}
DI bf16x8 frag_perm(const LAS bf16_t* rowp, int kbase, int quad) {
    const s16x4 a = *(const LAS s16x4*)(rowp + kbase + 4 * quad), b = *(const LAS s16x4*)(rowp + kbase + 16 + 4 * quad);
    bf16x8 r; r[0] = a[0]; r[1] = a[1]; r[2] = a[2]; r[3] = a[3]; r[4] = b[0]; r[5] = b[1]; r[6] = b[2]; r[7] = b[3]; return r;
}
DI bf16x8 pack_acc(const f32x4 a, const f32x4 b) { const u32x4 w = pack8(a, b); return __builtin_bit_cast(bf16x8, w); }
DI bf16x4 pack4(const f32x4 a) { u32x2 w; w.x = cvt_pk_bf16(a[0], a[1]); w.y = cvt_pk_bf16(a[2], a[3]); return __builtin_bit_cast(bf16x4, w); }
#define MFMA16(a, b, c) __builtin_amdgcn_mfma_f32_16x16x16bf16_1k((a), (b), (c), 0, 0, 0)


DI void gd_tok_ab(int n, int dir, int& A, int& sg) { sg = dir ? -1 : 1; A = n == 0 ? (dir ? 15 : -48) : NMETA + 64 * (n - 1) + (dir ? 63 : 0); }
DI int gd_tok(int n, int dir, int slot) { int A, sg; gd_tok_ab(n, dir, A, sg); return A + sg * slot; }
DI void gd_fetch(const bf16_t* qkvp, const float* bg, int so, int hl, int ql, int hv, int n, int dir, int tid, int wave, u32x4 (&pf)[6], float& gv, float& bv) {
    int A, sg; gd_tok_ab(n, dir, A, sg);
    const int pc = tid & 15, cq = ql * 128 + 8 * pc, ck = 1024 + cq, cv = 2048 + hl * 128 + 8 * pc;
#pragma unroll
    for (int h2 = 0; h2 < 2; ++h2) { const int t = A + sg * ((tid >> 4) + 32 * h2);
        pf[h2] = pf[2 + h2] = pf[4 + h2] = (u32x4){0u, 0u, 0u, 0u};
        if (t >= 0) { const bf16_t* rp = qkvp + (size_t)(so + t) * 4096; pf[h2] = *(const u32x4*)(rp + cq); pf[2 + h2] = *(const u32x4*)(rp + ck); pf[4 + h2] = *(const u32x4*)(rp + cv); } }
    gv = 0.f; bv = 0.f;
    if (wave == 0) { const int t1 = A + sg * (tid & 63); if (t1 >= 0) { const float* p = bg + (size_t)(so + t1) * 128 + dir * 32 + hv; bv = p[0]; gv = p[64]; } }
}
#define GD_BAR() asm volatile("s_waitcnt lgkmcnt(0)\n\ts_barrier" ::: "memory")
#define GD_IDS() int tq_ = tid0; asm volatile("" : "+v"(tq_)); const int tid = tq_, lane = tid & 63, l15 = lane & 15, quad = lane >> 4, tau = tid >> 3, sub = tid & 7; (void)l15; (void)quad; (void)tau; (void)sub; (void)lane;
constexpr int GD_OB_SPLIT = 48640;
DI bf16_t* gd_ob_row(bf16_t* obA, bf16_t* obB, int R) { return R < GD_OB_SPLIT ? obA + (size_t)R * D : obB + (size_t)(R - GD_OB_SPLIT) * D; }
DI void gdn_core_phase(Frame& F, int half, const bf16_t* qkvp, const float* bg, bf16_t* og, bf16_t* obA, bf16_t* obB) {
    int tid_ = F.wave * 64 + lane_id(); asm volatile("" : "+v"(tid_));
    const int tid0 = tid_, wave = __builtin_amdgcn_readfirstlane(tid0 >> 6);
    LAS unsigned char* L = F.lds;
    LAS bf16_t* QS = (LAS bf16_t*)(L + GD_QS); LAS bf16_t* KS = (LAS bf16_t*)(L + GD_KS); LAS bf16_t* VS = (LAS bf16_t*)(L + GD_VS);
    LAS bf16_t* ABF = (LAS bf16_t*)(L + GD_ABF); LAS float* ADG = (LAS float*)(L + GD_ADG); LAS bf16_t* TIB = (LAS bf16_t*)(L + GD_TIB);
    LAS bf16_t* KST = (LAS bf16_t*)(L + GD_KST); LAS bf16_t* QKM = (LAS bf16_t*)(L + GD_QKM);
    LAS bf16_t* WB = (LAS bf16_t*)(L + GD_WB); LAS float* OL = (LAS float*)(L + GD_O);
    LAS float* GC = (LAS float*)(L + GD_VEC); LAS float* BETA = GC + 64; LAS float* EG = GC + 128; LAS float* EKL = GC + 192; LAS float* GL = GC + 256;
    for (int ii = 0; ; ++ii) {
        int id;
        if (F.G == 256) { if (F.bid < 128) { if (ii >= 2) break; id = ii == 0 ? F.bid : 128 + F.bid; } else { if (ii >= 3) break; id = 256 + 3 * (F.bid - 128) + ii; } }
        else { id = F.bid + ii * F.G; if (id >= NSEQ * 32) break; }
        const int s_ = id < 128 ? id : id - 128;
        const int b = id < 128 ? NPROMPT + (s_ >> 5) : (s_ >> 5), hl = (s_ >> 1) & 15, dir = s_ & 1, hv = half * 16 + hl, ql = hl >> 1;
        const int so = seq_off(b), T = seq_len(b), NC = 1 + (T - NMETA) / 64;
        __syncthreads();
        {
            f32x4 Sacc[8];
#pragma unroll
            for (int i = 0; i < 8; ++i) Sacc[i] = (f32x4){0.f, 0.f, 0.f, 0.f};
            u32x4 pf[6]; float pgv, pbv;
            gd_fetch(qkvp, bg, so, hl, ql, hv, dir ? NC - 1 : 0, dir, tid0, wave, pf, pgv, pbv);
#define GD_S5() do { if (tprev >= 0) { GD_IDS(); f32x4 o[4]; _Pragma("unroll") for (int i = 0; i < 4; ++i) o[i] = *(const LAS f32x4*)(OL + tau * P_O + 16 * sub + 4 * i); \
                *(u32x4*)(gpprev) = pack8(o[0], o[1]); *(u32x4*)(gpprev + 8) = pack8(o[2], o[3]); } } while (0)
            int tprev = -1; bf16_t* gpprev = og;
            for (int step = 0; step < NC; ++step) {
                const int n = dir ? NC - 1 - step : step;
                int t, R; float gv = 0.f, bv = 0.f; bf16_t* gp;
                GD_S5();
                { GD_IDS();
                t = gd_tok(n, dir, tau);
                R = so + (t < 0 ? 0 : t);
#pragma unroll
                for (int i = 0; i < 6; ++i) { const int X = i >> 1, slot = (tid >> 4) + 32 * (i & 1), pc = tid & 15;
                    LAS bf16_t* dst = (X == 0 ? QS : (X == 1 ? KS : VS)) + slot * P_QS + 8 * pc;
                    *(LAS u32x4*)(dst) = pf[i];
                    if (X == 1) { const unsigned w4[4] = {pf[i].x, pf[i].y, pf[i].z, pf[i].w};
#pragma unroll
                        for (int e = 0; e < 8; ++e) KST[(8 * pc + e) * P_KST + slot] = (bf16_t)((e & 1) ? (w4[e >> 1] >> 16) : (w4[e >> 1] & 0xffffu)); } }
                gv = pgv; bv = pbv;
                if (step + 1 < NC) gd_fetch(qkvp, bg, so, hl, ql, hv, dir ? NC - 2 - step : step + 1, dir, tid, wave, pf, pgv, pbv);
                gp = (dir ? gd_ob_row(obA, obB, R) : og + (size_t)R * D) + hl * 128 + 16 * sub;
                }
                if (wave == 0) { GD_IDS();
                    float c = gv;
#pragma unroll
                    for (int o = 1; o < 64; o <<= 1) { const float y = __shfl_up(c, o); if (lane >= o) c += y; }
                    const float gl = __shfl(c, 63);
                    GC[lane] = c; BETA[lane] = bv; EG[lane] = __expf(c); EKL[lane] = __expf(gl - c); if (lane == 0) GL[0] = __expf(gl);
                }
                GD_BAR();
                { GD_IDS();
                    const int cb = wave >> 1;
                    bf16x8 ka[4], qa[4];
#pragma unroll
                    for (int ks = 0; ks < 4; ++ks) { ka[ks] = *(const LAS bf16x8*)(KS + (16 * cb + l15) * P_QS + 32 * ks + 8 * quad); qa[ks] = *(const LAS bf16x8*)(QS + (16 * cb + l15) * P_QS + 32 * ks + 8 * quad); }
                    const f32x4 gcc = *(const LAS f32x4*)(GC + 16 * cb + 4 * quad), btc = *(const LAS f32x4*)(BETA + 16 * cb + 4 * quad);
#pragma unroll
                    for (int s2 = 0; s2 < 2; ++s2) { const int sb = 2 * (wave & 1) + s2;
                        f32x4 kk = (f32x4){0.f, 0.f, 0.f, 0.f}, qk = kk;
#pragma unroll
                        for (int ks = 0; ks < 4; ++ks) { const bf16x8 kb = *(const LAS bf16x8*)(KS + (16 * sb + l15) * P_QS + 32 * ks + 8 * quad);
                            kk = __builtin_amdgcn_mfma_f32_16x16x32_bf16(ka[ks], kb, kk, 0, 0, 0); qk = __builtin_amdgcn_mfma_f32_16x16x32_bf16(qa[ks], kb, qk, 0, 0, 0); }
                        const int s = 16 * sb + l15; const float gcs = GC[s];
#pragma unroll
                        for (int g = 0; g < 4; ++g) { const int c = 16 * cb + 4 * quad + g;
                            const float dec = (s <= c) ? __expf(fminf(gcc[g] - gcs, 0.f)) : 0.f;
                            const float av = (s < c) ? btc[g] * kk[g] * dec : 0.f;
                            QKM[c * P_KST + s] = f2bf(qk[g] * dec);
                            ABF[c * P_KST + s] = f2bf(av);
                            if (sb == cb) ADG[(cb * 16 + 4 * quad + g) * P_ADG + l15] = av; }
                    }
                }
                GD_BAR();
                if (wave == 0) { GD_IDS();
                    float tcol[16];
#pragma unroll
                    for (int r = 0; r < 16; ++r) { float acc = (r == l15) ? 1.f : 0.f;
                        const LAS float* lr = ADG + (quad * 16 + r) * P_ADG;
#pragma unroll
                        for (int s4 = 0; s4 < (r + 3) / 4; ++s4) { const f32x4 lv = *(const LAS f32x4*)(lr + 4 * s4);
#pragma unroll
                            for (int e = 0; e < 4; ++e) if (4 * s4 + e < r) acc -= lv[e] * tcol[4 * s4 + e]; }
                        tcol[r] = acc; TIB[(quad * 16 + r) * 16 + l15] = f2bf(acc); }
                }
                f32x4 ru[4], rw[4];
                { GD_IDS();
#pragma unroll
                for (int k = 0; k < 4; ++k) { const f32x4 bt = *(const LAS f32x4*)(BETA + 16 * k + 4 * quad), eg = *(const LAS f32x4*)(EG + 16 * k + 4 * quad);
#pragma unroll
                    for (int g = 0; g < 4; ++g) { const int c = 16 * k + 4 * quad + g;
                        ru[k][g] = bf2f(VS[c * P_QS + 16 * wave + l15]) * bt[g]; rw[k][g] = bf2f(KS[c * P_QS + 16 * wave + l15]) * (bt[g] * eg[g]); } } }
                GD_BAR();
                f32x4 uu[4];
                { GD_IDS();
                    bf16x4 xu[4], xw[4];
#pragma unroll
                    for (int k = 0; k < 4; ++k) {
                        f32x4 su = (f32x4){0.f, 0.f, 0.f, 0.f}, sw = su;
#pragma unroll
                        for (int j = 0; j < 4; ++j) if (j < k) { const bf16x4 af = *(const LAS bf16x4*)(ABF + (16 * k + l15) * P_KST + 16 * j + 4 * quad);
                            su = MFMA16(af, xu[j], su); sw = MFMA16(af, xw[j], sw); }
                        const bf16x4 tf = *(const LAS bf16x4*)(TIB + (k * 16 + l15) * 16 + 4 * quad);
                        const f32x4 z4 = (f32x4){0.f, 0.f, 0.f, 0.f};
                        const f32x4 xuk = MFMA16(tf, pack4(ru[k] - su), z4), xwk = MFMA16(tf, pack4(rw[k] - sw), z4);
                        uu[k] = xuk; xu[k] = pack4(xuk); xw[k] = pack4(xwk);
#pragma unroll
                        for (int g = 0; g < 4; ++g) WB[(16 * k + 4 * quad + g) * P_QS + 16 * wave + l15] = f2bf(xwk[g]);
                    }
                }
                GD_BAR();
                { GD_IDS();
                    bf16x8 Sb[4];
#pragma unroll
                    for (int ks = 0; ks < 4; ++ks) Sb[ks] = pack_acc(Sacc[2 * ks], Sacc[2 * ks + 1]);
                    f32x4 vn[4], oo[4];
#pragma unroll
                    for (int cb = 0; cb < 4; ++cb) {
                        f32x4 ws = (f32x4){0.f, 0.f, 0.f, 0.f}, qs = ws;
#pragma unroll
                        for (int ks = 0; ks < 4; ++ks) { ws = __builtin_amdgcn_mfma_f32_16x16x32_bf16(frag_perm(WB + (16 * cb + l15) * P_QS, 32 * ks, quad), Sb[ks], ws, 0, 0, 0);
                            qs = __builtin_amdgcn_mfma_f32_16x16x32_bf16(frag_perm(QS + (16 * cb + l15) * P_QS, 32 * ks, quad), Sb[ks], qs, 0, 0, 0); }
                        const f32x4 egc = *(const LAS f32x4*)(EG + 16 * cb + 4 * quad);
                        vn[cb] = uu[cb] - ws; oo[cb] = egc * qs;
                    }
                    bf16x8 vb[2];
#pragma unroll
                    for (int kc = 0; kc < 2; ++kc) vb[kc] = pack_acc(vn[2 * kc], vn[2 * kc + 1]);
#pragma unroll
                    for (int cb = 0; cb < 4; ++cb) {
#pragma unroll
                        for (int kc = 0; kc < 2; ++kc) oo[cb] = __builtin_amdgcn_mfma_f32_16x16x32_bf16(frag_perm(QKM + (16 * cb + l15) * P_KST, 32 * kc, quad), vb[kc], oo[cb], 0, 0, 0);
#pragma unroll
                        for (int g = 0; g < 4; ++g) OL[(16 * cb + 4 * quad + g) * P_O + 16 * wave + l15] = oo[cb][g];
                        const f32x4 ek = *(const LAS f32x4*)(EKL + 16 * cb + 4 * quad);
                        vn[cb] = vn[cb] * ek;
                    }
#pragma unroll
                    for (int kc = 0; kc < 2; ++kc) vb[kc] = pack_acc(vn[2 * kc], vn[2 * kc + 1]);
                    const float egl = GL[0];
#pragma unroll
                    for (int db = 0; db < 8; ++db) { f32x4 s = Sacc[db] * egl;
#pragma unroll
                        for (int kc = 0; kc < 2; ++kc) s = __builtin_amdgcn_mfma_f32_16x16x32_bf16(frag_perm(KST + (16 * db + l15) * P_KST, 32 * kc, quad), vb[kc], s, 0, 0, 0);
                        Sacc[db] = s; }
                }
                GD_BAR();
                tprev = t; gpprev = gp;
            }
            GD_S5();
        }
    }
}

DI void gdn_combine_phase(Frame& F, bf16_t* og, bf16_t* obA, bf16_t* obB, const bf16_t* zb, const float* norm_w) {
    const int lane = F.lane(), e0 = (lane & 15) * 8;
    f32x4 nw0 = *(const f32x4*)(norm_w + e0), nw1 = *(const f32x4*)(norm_w + e0 + 4);
    for (int R = F.bid * 8 + F.wave; R < MTOK; R += F.G * 8) {
        bf16_t* op = og + (size_t)R * D + lane * 8; const bf16_t* bp = gd_ob_row(obA, obB, R) + lane * 8; const bf16_t* zp = zb + (size_t)R * D + lane * 8;
        u32x4 f[4], g[4], z[4];
#pragma unroll
        for (int q = 0; q < 4; ++q) { f[q] = *(const u32x4*)(op + 512 * q); g[q] = *(const u32x4*)(bp + 512 * q); z[q] = *(const u32x4*)(zp + 512 * q); }
#pragma unroll
        for (int q = 0; q < 4; ++q) {
            const unsigned fw[4] = {f[q].x, f[q].y, f[q].z, f[q].w}, gw[4] = {g[q].x, g[q].y, g[q].z, g[q].w}, zw[4] = {z[q].x, z[q].y, z[q].z, z[q].w};
            float o[8], zz[8]; float ss = 0.f;
#pragma unroll
            for (int k = 0; k < 4; ++k) { o[2 * k] = bf_lo(fw[k]) + bf_lo(gw[k]); o[2 * k + 1] = bf_hi(fw[k]) + bf_hi(gw[k]); zz[2 * k] = bf_lo(zw[k]); zz[2 * k + 1] = bf_hi(zw[k]); }
#pragma unroll
            for (int e = 0; e < 8; ++e) ss += o[e] * o[e];
            ss += __shfl_xor(ss, 1); ss += __shfl_xor(ss, 2); ss += __shfl_xor(ss, 4); ss += __shfl_xor(ss, 8);
            const float rn = 1.0f / sqrtf(ss * (1.0f / 128.0f) + NORM_EPS);
            f32x4 a, b2;
#pragma unroll
            for (int k = 0; k < 4; ++k) { a[k] = o[k] * rn * nw0[k] * siluf_(zz[k]); b2[k] = o[4 + k] * rn * nw1[k] * siluf_(zz[4 + k]); }
            *(u32x4*)(op + 512 * q) = pack8(a, b2);
        }
    }
}
constexpr int N_PHASES = 38;
#ifndef ALIGN_RES
#define ALIGN_RES true
#endif
#ifndef ALIGN_CONS
#define ALIGN_CONS true
#endif
#ifndef WGM_DEF
#define WGM_DEF 4
#endif
#ifndef WGM_RES
#define WGM_RES 4
#endif
#ifndef WGM_FFU
#define WGM_FFU 4
#endif
#ifndef WGM_GATES
#define WGM_GATES 4
#endif
DI pg8::Gemm mk_gemm(const void* A, unsigned lda, const void* B, unsigned ldb, long hB, int nt) { pg8::Gemm g; g.A = (const char*)A; g.B = (const char*)B; g.lda = lda; g.ldb = ldb; g.hstepA = 128L * lda; g.hstepB = hB; g.nt = nt; return g; }
DI SchedLin mk_lin(Frame& F, int nM, int nN, long a_base, long a_tile, long b_base, long b_tile, int nt = 32, int wgm = WGM_DEF) { SchedLin s; s.o.init(nM, nN, F.G, F.bid, wgm); s.a_base = a_base; s.a_tile = a_tile; s.b_base = b_base; s.b_tile = b_tile; s.nt = nt; return s; }
DI SchedRes mk_res(Frame& F, long a_tile, long b_base, long b_tile, int nt, int wgm = WGM_RES) { SchedRes s; s.init(F.G, F.bid, a_tile, b_base, b_tile, nt, wgm); return s; }

__global__ void __launch_bounds__(512, 2) trunk_fwd(Args args) {
    extern __shared__ __attribute__((aligned(16))) unsigned char lds_raw[];
    Frame F;
    F.lds = (LAS unsigned char*)lds_raw;
    F.wave = __builtin_amdgcn_readfirstlane(threadIdx.x >> 6); F.G = gridDim.x; F.bid = blockIdx.x;
    F.in = args.in; F.out = args.out; F.ws = args.ws;
    volatile LAS unsigned* MISC = (volatile LAS unsigned*)(F.lds + MISC_OFF);
    if (F.tid() < 16) MISC[F.tid()] = 0u;
    __syncthreads();
    const int lo = args.ph_lo, hi = args.ph_hi;
    unsigned* ctl = (unsigned*)(F.ws + WS_CTL);
    XcdBarrier bar; bar.bar = ctl + CW_BAR; bar.x = 0; bar.st = nullptr;
    if (hi - lo > 1) bar = xcd_barrier_post(ctl + CW_BAR, MISC + 8, F.wave == 0 && lane_id() == 0);
#define IN(k) (lo <= (k) && (k) < hi)
#define SEAM(k) do { if (IN(k) && IN((k) + 1)) xcd_barrier(bar, F.wave == 0 && lane_id() == 0); } while (0)
#ifndef REP_MASK
#define REP_MASK 0ull
#endif
#define PHASE(k, ...) if (IN(k)) { if constexpr (((REP_MASK) >> (k)) & 1ull) { __VA_ARGS__; xcd_barrier(bar, F.wave == 0 && lane_id() == 0); } __VA_ARGS__; } SEAM(k);
    LAS float* cscr = (LAS float*)(F.lds + F.wave * 16384);
    bf16_t* const XNp = F.XN(); bf16_t* const XCp = F.XC(); unsigned char* const SCR = F.SCR();
    bf16_t* const OUTB = (bf16_t*)F.out;
    constexpr unsigned LD2K = 4096;


#define CVT_BEGIN() CvtCursor cc{F.bid * 8 + F.wave, 0, F.G * 8}
#define CVT_BEGIN_RES() CvtCursor cc{(F.G == 256) ? (F.bid >= 64 ? (F.bid - 64) * 8 + F.wave : 0x3fffffff) : F.bid * 8 + F.wave, 0, (F.G == 256) ? 192 * 8 : F.G * 8}
#define PH_FIN(XI_, XO_, S1_, ...) { CVT_BEGIN(); __VA_ARGS__; ss_final_phase(F, ssp, rsv, XI_, XO_, SLAB0, S1_); }
#define PH_FFN_UP(LI_, X_) { bf16_t* wg = (bf16_t*)F.WFFN(); \
        pg8::Gemm g = mk_gemm(X_, LD2K, wg, LD2K, (long)DFF * LD2K, 32); SchedLin S = mk_lin(F, 195, 44, -(long)LD2K, 254L * LD2K, 0, 128L * LD2K, 32, WGM_FFU); \
        EpiFfnUp E{(bf16_t*)SCR, F.I(27) + (size_t)(LI_) * 3 * DFF, F.I(28) + (size_t)(LI_) * DFF, (LAS float*)(F.lds + EDGE_OFF), rsv, (const unsigned char*)(F.ws + WS_CTL + 768 * 1024)}; \
        pg8::gemm_phase<EpiFfnUp, SchedLin, true>(F.lds, g, S, E, F.wave); }
#define PH_FFN_DOWN(XI_, XO_, SS_, ...) { bf16_t* wd = (bf16_t*)F.WFFN() + (size_t)2 * DFF * D; \
        pg8::Gemm g = mk_gemm(SCR, DFF * 2, wd, DFF * 2, 128L * DFF * 2, 88); SchedRes S = mk_res(F, 256L * DFF * 2, 0, 256L * DFF * 2, 88); \
        EpiResAdd E{XI_, XO_, SS_, SLAB0}; pg8::gemm_phase<EpiResAdd, SchedRes, ALIGN_RES>(F.lds, g, S, E, F.wave); { CVT_BEGIN_RES(); __VA_ARGS__; } }
#define PH_RG_IN(X_) { bf16_t* win = (bf16_t*)F.WMIX(); \
        pg8::Gemm g = mk_gemm(X_, LD2K, win, LD2K, 128L * LD2K, 32); SchedLin S = mk_lin(F, 194, 16, 0, 256L * LD2K, 0, 256L * LD2K); \
        EpiRgIn E{OUTB, (bf16_t*)SCR, rsv}; pg8::gemm_phase<EpiRgIn, SchedLin, ALIGN_CONS>(F.lds, g, S, E, F.wave); }
#define PH_RG_CONV(J_) { rg_conv_phase(F, (const bf16_t*)SCR, XCp, F.I(7) + (size_t)(J_) * 4 * D, F.I(8) + (size_t)(J_) * D); }
#define PH_RG_GATES(J_) { bf16_t* gates = (bf16_t*)F.WMIX() + (size_t)4096 * D; \
        pg8::Gemm g = mk_gemm(XCp, LD2K, gates, 512, 8L * 131072, 4); SchedGates S; S.o.init(194, 32, F.G, F.bid, WGM_GATES); \
        EpiGates E{XCp, (bf16_t*)SCR, (bf16_t*)(SCR + B194), B194, F.I(10) + (size_t)(J_) * 2 * D, F.I(12) + (size_t)(J_) * 2 * D, F.I(13) + (size_t)(J_) * 2 * D, (LAS float*)(F.lds + EDGE_OFF)}; \
        pg8::gemm_phase<EpiGates, SchedGates, true>(F.lds, g, S, E, F.wave); }
#define PH_RG_SCAN() { rg_scan_phase(F, (const bf16_t*)SCR, (bf16_t*)(SCR + B194), (const bf16_t*)(SCR + 2 * B194), (bf16_t*)(SCR + 3 * B194), OUTB); }
#define PH_RG_OUT(XI_, XO_, ...) { bf16_t* wout = (bf16_t*)F.WMIX() + (size_t)4096 * D + (size_t)32 * 65536; \
        pg8::Gemm g = mk_gemm(SCR + 3 * B194, LD2K, wout, LD2K, 128L * LD2K, 32); SchedRes S = mk_res(F, 256L * LD2K, 0, 256L * LD2K, 32); \
        EpiResAdd E{XI_, XO_, ssp, SLAB0}; pg8::gemm_phase<EpiResAdd, SchedRes, ALIGN_RES>(F.lds, g, S, E, F.wave); { CVT_BEGIN_RES(); __VA_ARGS__; } }
#define PH_GDN_PROJ(HALF_, X_) { bf16_t* w = (bf16_t*)F.WMIX() + ((HALF_) ? (size_t)6400 * D : 0); \
        pg8::Gemm g = mk_gemm(X_, LD2K, w, LD2K, 128L * LD2K, 32); SchedLin S = mk_lin(F, 194, (HALF_) ? 24 : 25, 0, 256L * LD2K, 0, 256L * LD2K); \
        EpiGdnProj E{(bf16_t*)SCR, (HALF_) ? (bf16_t*)(SCR + 2 * B194) : XB, (float*)(SCR + 3 * B194), F.I(21), F.I(22), (bf16_t*)(SCR + 3 * B194 + 26 * MiB), rsv}; pg8::gemm_phase<EpiGdnProj, SchedLin, ALIGN_CONS>(F.lds, g, S, E, F.wave); }
#define PH_GDN_CONV(HALF_) { gdn_conv_phase(F, HALF_, (bf16_t*)SCR, (const bf16_t*)(SCR + 3 * B194 + 26 * MiB), F.I(20)); }
#define GD_OBA (OUTB + (size_t)MP * D)
#define GD_OBB ((bf16_t*)(SCR + 3 * B194 + 48 * MiB))
#define PH_GDN_CORE(HALF_) { gdn_core_phase(F, HALF_, (const bf16_t*)SCR, (const float*)(SCR + 3 * B194), (HALF_) ? XCp : OUTB, GD_OBA, GD_OBB); }
#define PH_GDN_COMB(HALF_) { gdn_combine_phase(F, (HALF_) ? XCp : OUTB, GD_OBA, GD_OBB, (HALF_) ? (const bf16_t*)(SCR + 2 * B194) : (const bf16_t*)XB, F.I(23)); }
#define PH_GDN_OUT(HALF_, XI_, XO_, SS_, ...) { bf16_t* wout = (bf16_t*)F.WMIX() + (size_t)(6400 + 6144) * D; \
        pg8::Gemm g = mk_gemm((HALF_) ? XCp : OUTB, LD2K, wout, 8192, 128L * 8192, 32); SchedRes S = mk_res(F, 256L * LD2K, (long)(HALF_) * 4096, 256L * 8192, 32); \
        EpiResAdd E{XI_, XO_, SS_, (HALF_) ? SLAB1 : SLAB0}; pg8::gemm_phase<EpiResAdd, SchedRes, ALIGN_RES>(F.lds, g, S, E, F.wave); { CVT_BEGIN_RES(); __VA_ARGS__; } }
    float* const SLAB0 = (float*)(SCR + 784 * MiB); float* const SLAB1 = (float*)(SCR + 640 * MiB); float* const NOSLAB = nullptr;
    float* const ssp = (float*)(SCR + 4 * B194);
    float* const rsv = (float*)(F.ws + WS_CTL + 256 * 1024);
    bf16_t* const NOXN = nullptr; float* const NOSS = nullptr; (void)NOXN;

    bf16_t* const XA = XNp; bf16_t* const XB = (bf16_t*)(F.ws + WS_H + B194);
    PHASE(0, { CVT_BEGIN(); cvt_rg(F, cc, 0, 0, cscr); cvt_ffn(F, cc, 0, cscr); fill_rflag(F, (unsigned char*)(F.ws + WS_CTL + 768 * 1024)); norm_phase<1>(F, XA, F.I(3), rsv); })
    PHASE(1, PH_RG_IN(XA)) PHASE(2, PH_RG_CONV(0)) PHASE(3, PH_RG_GATES(0)) PHASE(4, PH_RG_SCAN()) PHASE(5, PH_RG_OUT(XA, XB, (void)cc))
    PHASE(6, PH_FIN(XA, XB, NOSLAB, (void)cc))
    PHASE(7, PH_FFN_UP(0, XB)) PHASE(8, PH_FFN_DOWN(XB, XA, ssp, cvt_na(F, cc, cscr))) PHASE(9, PH_FIN(XB, XA, NOSLAB, (void)cc))
    PHASE(10, { pg8::Gemm g = mk_gemm(XA, LD2K, F.WMIX(), LD2K, 128L * LD2K, 32); SchedLin S = mk_lin(F, 194, 24, 0, 256L * LD2K, 0, 256L * LD2K);
        EpiPlainBf16 E{(bf16_t*)SCR, 6144, rsv}; pg8::gemm_phase<EpiPlainBf16, SchedLin, ALIGN_CONS>(F.lds, g, S, E, F.wave); })
    PHASE(11, { na_attn_phase(F, (const bf16_t*)SCR, OUTB, F.I(16), F.I(17)); })
    PHASE(12, { bf16_t* wo = (bf16_t*)F.WMIX() + (size_t)6144 * D;
        pg8::Gemm g = mk_gemm(OUTB, LD2K, wo, LD2K, 128L * LD2K, 32); SchedRes S = mk_res(F, 256L * LD2K, 0, 256L * LD2K, 32);
        EpiResAdd E{XA, XB, ssp, SLAB0}; pg8::gemm_phase<EpiResAdd, SchedRes, ALIGN_RES>(F.lds, g, S, E, F.wave); { CVT_BEGIN_RES(); cvt_ffn(F, cc, 1, cscr); } })
    PHASE(13, PH_FIN(XA, XB, NOSLAB, (void)cc))
    PHASE(14, PH_FFN_UP(1, XB)) PHASE(15, PH_FFN_DOWN(XB, XA, ssp, cvt_gdn(F, cc, cscr))) PHASE(16, PH_FIN(XB, XA, NOSLAB, (void)cc))
    PHASE(17, PH_GDN_PROJ(0, XA)) PHASE(18, PH_GDN_CONV(0)) PHASE(19, PH_GDN_CORE(0))
    PHASE(20, { PH_GDN_COMB(0) PH_GDN_PROJ(1, XA) }) PHASE(21, PH_GDN_CONV(1)) PHASE(22, PH_GDN_CORE(1))
    PHASE(23, { PH_GDN_COMB(1) PH_GDN_OUT(0, XA, XB, NOSS, cvt_ffn(F, cc, 2, cscr)) })
    PHASE(24, PH_GDN_OUT(1, XB, XA, ssp, (void)cc))
    PHASE(25, PH_FIN(XA, XA, SLAB1, (void)cc))
    PHASE(26, PH_FFN_UP(2, XA)) PHASE(27, PH_FFN_DOWN(XA, XB, ssp, cvt_rg(F, cc, 1, 3, cscr))) PHASE(28, PH_FIN(XA, XB, NOSLAB, (void)cc))
    PHASE(29, PH_RG_IN(XB)) PHASE(30, PH_RG_CONV(1)) PHASE(31, PH_RG_GATES(1)) PHASE(32, PH_RG_SCAN()) PHASE(33, PH_RG_OUT(XB, XA, cvt_ffn(F, cc, 3, cscr)))
    PHASE(34, PH_FIN(XB, XA, NOSLAB, (void)cc))
    PHASE(35, PH_FFN_UP(3, XA)) PHASE(36, PH_FFN_DOWN(XA, XB, NOSS, (void)cc))
    PHASE(37, { norm_phase<2>(F, XB, F.I(5), nullptr, XA, SLAB0); })
#undef IN
#undef SEAM
}

__global__ void fill_k(float* o, size_t n, float v) { for (size_t i = (size_t)blockIdx.x * blockDim.x + threadIdx.x; i < n; i += (size_t)gridDim.x * blockDim.x) o[i] = v; }
#ifndef MK_ONE_LAUNCH
#define MK_ONE_LAUNCH 1
#endif
extern "C" void kernel_launch(void* const* d_in, const int* in_sizes, int n_in, void* d_out, int out_size, void* d_ws, size_t ws_size, hipStream_t stream) {
    static int grid = 0;
    if (grid == 0) {
        int dev = 0, cus = 0;
        hipError_t e = hipGetDevice(&dev); if (e == hipSuccess) e = hipDeviceGetAttribute(&cus, hipDeviceAttributeMultiprocessorCount, dev);
        if (e == hipSuccess) e = hipFuncSetAttribute((const void*)trunk_fwd, hipFuncAttributeMaxDynamicSharedMemorySize, LDS_BYTES);
        if (e != hipSuccess || n_in != 30 || ws_size < WS_END || cus < 1) { fprintf(stderr, "kernel_launch: setup failed (%s), n_in %d, ws %zu\n", hipGetErrorName(e), n_in, ws_size); grid = -1; }
        else grid = cus;
        (void)hipGetLastError();
    }
    if (grid < 0) { fill_k<<<1024, 256, 0, stream>>>((float*)d_out, (size_t)out_size, 7.0f); return; }
    (void)hipMemsetAsync((char*)d_ws + WS_CTL, 0, CTL_ZERO_BYTES, stream);
    Args a{};
    for (int i = 0; i < 30; ++i) a.in[i] = (const float*)d_in[i];
    a.out = (float*)d_out; a.ws = (unsigned char*)d_ws;
#if MK_ONE_LAUNCH
    a.ph_lo = 0; a.ph_hi = N_PHASES;
    hipLaunchKernelGGL(trunk_fwd, dim3(grid), dim3(512), LDS_BYTES, stream, a);
#else
    for (int p = 0; p < N_PHASES; ++p) { a.ph_lo = p; a.ph_hi = p + 1; hipLaunchKernelGGL(trunk_fwd, dim3(grid), dim3(512), LDS_BYTES, stream, a); }
#endif
}
```

```cpp
#include <hip/hip_runtime.h>
#include <cstdio>
#include <cstdint>

#define LAS __attribute__((address_space(3)))
#define GAS __attribute__((address_space(1)))
typedef unsigned short bf16_t;
typedef short bf16x8 __attribute__((ext_vector_type(8)));
typedef short s16x4 __attribute__((ext_vector_type(4)));
typedef float f32x4 __attribute__((ext_vector_type(4)));
typedef float f32x2 __attribute__((ext_vector_type(2)));
typedef unsigned u32x4 __attribute__((ext_vector_type(4)));
typedef unsigned u32x2 __attribute__((ext_vector_type(2)));
#define DI __device__ __forceinline__

constexpr int D = 2048, NSEQ = 20, NPROMPT = 16, TP = 2064, TS = 4112, LP = 2048, LS = 4096, NMETA = 16;
constexpr int MPROMPT = NPROMPT * TP;
constexpr int MTOK = MPROMPT + 4 * TS;
constexpr int MP = 49664;
constexpr int DFF = 5632;
constexpr float NORM_EPS = 1e-6f;
DI int seq_off(int b) { return b < NPROMPT ? b * TP : MPROMPT + (b - NPROMPT) * TS; }
DI int seq_len(int b) { return b < NPROMPT ? TP : TS; }
DI void row_bt(int R, int& b, int& t) { if (R < MPROMPT) { b = R / TP; t = R - b * TP; } else { const int q = (R - MPROMPT) / TS; b = NPROMPT + q; t = R - MPROMPT - q * TS; } }

typedef __bf16 bf16v2_ __attribute__((ext_vector_type(2)));
DI unsigned cvt_pk_bf16(float lo, float hi) { const bf16v2_ r = __builtin_convertvector((f32x2){lo, hi}, bf16v2_); return __builtin_bit_cast(unsigned, r); }
DI float bf_lo(unsigned w) { return __uint_as_float(w << 16); }
DI float bf_hi(unsigned w) { return __uint_as_float(w & 0xffff0000u); }
DI float bf2f(bf16_t h) { return __uint_as_float(((unsigned)h) << 16); }
DI bf16_t f2bf(float f) { return (bf16_t)(cvt_pk_bf16(f, 0.f) & 0xffffu); }
DI float fast_rcp(float x) { return __builtin_amdgcn_rcpf(x); }
DI float sigmoidf_(float x) { return fast_rcp(1.f + __expf(-x)); }
DI float siluf_(float x) { return x * sigmoidf_(x); }
DI float softplusf_(float x) { return x > 20.f ? x : log1pf(__expf(x)); }
DI float softplus_lite(float x) { const float e = __expf(x), u = 1.f + e, d = u - 1.f; return x > 20.f ? x : (d == 0.f ? e : __logf(u) * e * fast_rcp(d)); }
DI float gelu_tanh_(float x) { const float u = 1.5957691216057308f * (x + 0.044715f * x * x * x); return x * sigmoidf_(u); }
DI int lane_id() { int r; asm volatile("v_mbcnt_lo_u32_b32 %0, -1, 0\n\tv_mbcnt_hi_u32_b32 %0, -1, %0" : "=&v"(r)); return r; }
DI float wave_sum(float v) {
#pragma unroll
    for (int o = 1; o < 64; o <<= 1) v += __shfl_xor(v, o);
    return v;
}

#define XB_TMO      128
#define XB_XCNT(j)  (256  + 64 * (j))
#define XB_XSUB(j)  (1280 + 64 * (j))
#define XB_XGEN(j)  (2304 + 64 * (j))
#define XB_TOP      3328
#define XB_TOPGEN   3392
#define XCD_BAR_WORDS 3456
#define XB_SPIN_CAP (1u << 22)
DI unsigned xb_ld(unsigned* p)              { return __hip_atomic_load(p, __ATOMIC_RELAXED, __HIP_MEMORY_SCOPE_AGENT); }
DI unsigned xb_add(unsigned* p, unsigned v) { return __hip_atomic_fetch_add(p, v, __ATOMIC_RELAXED, __HIP_MEMORY_SCOPE_AGENT); }
DI unsigned xb_xcc_id() { return (unsigned)__builtin_amdgcn_s_getreg((3 << 11) | 20) & 0xFu; }
#define XB_SPIN(cond, bar) do { unsigned _sp = 0; while (cond) { __builtin_amdgcn_s_sleep(1); \
    if ((++_sp & 255u) == 0u) { if (xb_ld(&(bar)[XB_TMO])) break; if (_sp > XB_SPIN_CAP) { atomicAdd(&(bar)[XB_TMO], 1u); break; } } } } while (0)
struct XcdBarrier { unsigned* bar; unsigned x; volatile LAS unsigned* st; };
DI XcdBarrier xcd_barrier_post(unsigned* bar, volatile LAS unsigned* st, bool leader) {
    XcdBarrier b; b.bar = bar; b.x = xb_xcc_id(); b.st = st;
    if (leader) (void)xb_add(&bar[XB_XCNT(b.x)], 1u);
    return b;
}
DI void xcd_barrier_complete(unsigned* bar, unsigned x, unsigned& nloc, unsigned& nx) {
    const unsigned G = gridDim.x * gridDim.y * gridDim.z;
    unsigned sum, cnt, mine, sp = 0u;
    for (;;) {
        sum = 0u; cnt = 0u; mine = 0u;
#pragma unroll
        for (unsigned j = 0; j < 16; ++j) { const unsigned c = xb_ld(&bar[XB_XCNT(j)]); sum += c; cnt += (c > 0u) ? 1u : 0u; mine = (j == x) ? c : mine; }
        if (sum == G) break;
        __builtin_amdgcn_s_sleep(1);
        if ((++sp & 255u) == 0u) { if (xb_ld(&bar[XB_TMO])) break; if (sp > XB_SPIN_CAP) { atomicAdd(&bar[XB_TMO], 1u); break; } }
    }
    nloc = mine > 0u ? mine : 1u; nx = cnt > 0u ? cnt : 1u;
}
DI void xcd_barrier(const XcdBarrier& b, bool leader) {
    asm volatile("s_waitcnt vmcnt(0)" ::: "memory");
    __syncthreads();
    if (leader) {
        unsigned* bar = b.bar;
        __builtin_amdgcn_s_waitcnt(0);
        unsigned nloc = b.st[0], nx = b.st[1];
        if (nloc == 0u) { xcd_barrier_complete(bar, b.x, nloc, nx); b.st[0] = nloc; b.st[1] = nx; }
        const unsigned old = xb_add(&bar[XB_XSUB(b.x)], 1u);
        const unsigned gen = old / nloc;
        if (old + 1u == (gen + 1u) * nloc) {
            __builtin_amdgcn_fence(__ATOMIC_RELEASE, "agent");
            asm volatile("s_waitcnt vmcnt(0)" ::: "memory");
            const unsigned og = xb_add(&bar[XB_TOP], 1u);
            const unsigned tg = og / nx;
            if (og + 1u == (tg + 1u) * nx) xb_add(&bar[XB_TOPGEN], 1u);
            else XB_SPIN(xb_ld(&bar[XB_TOPGEN]) == tg, bar);
            __builtin_amdgcn_fence(__ATOMIC_ACQUIRE, "agent");
            xb_add(&bar[XB_XGEN(b.x)], 1u);
            asm volatile("s_waitcnt vmcnt(0)" ::: "memory");
        } else {
            XB_SPIN(xb_ld(&bar[XB_XGEN(b.x)]) == gen, bar);
            __builtin_amdgcn_fence(__ATOMIC_ACQUIRE, "agent");
            asm volatile("s_waitcnt vmcnt(0)" ::: "memory");
        }
    }
    __syncthreads();
}

namespace pg8 {
constexpr int BM = 256, BK = 64, HALF = 128, HTB = HALF * BK * 2, STAGE_BYTES = 8 * HTB, NXCD = 8;
__host__ __device__ __forceinline__ int lds_byte(int r, int c) { const int st = (r >> 4) * 2 + (c >> 5), rr = r & 15, cc = c & 31, ob = rr * 64 + cc * 2; return st * 1024 + (ob ^ (((ob >> 9) & 1) << 5)); }
__host__ __device__ __forceinline__ void stage_rc(int b, int& R, int& C) { const int st = b / 1024, sb = b % 1024, swz = sb ^ (((sb >> 9) & 1) << 5); R = (st >> 1) * 16 + swz / 64; C = (st & 1) * 32 + (swz % 64) / 2; }
__host__ __device__ __forceinline__ int perm32(int rho) { const int n = rho >> 4, i = rho & 15; return 8 * (i >> 2) + 4 * n + (i & 3); }

struct Unit { int pm, pn; long aoff, boff; int nt, sub; };
struct Gemm { const char* A; const char* B; unsigned lda, ldb; long hstepA, hstepB; int nt; };
struct TileOrder {
    int nM, nN, nwg, G, c, WGM;
    DI void init(int nM_, int nN_, int G_, int c_, int wgm_ = 4) { nM = nM_; nN = nN_; nwg = nM * nN; G = G_; c = c_; WGM = wgm_; }
    DI bool tile(int i, int& pm, int& pn) const {
        const long L = (long)i * G + c; if (L >= nwg) return false;
        int wgid = (int)L; { const int q = nwg / NXCD, r = nwg % NXCD, xcd = wgid % NXCD, off = wgid / NXCD; wgid = (xcd < r ? xcd * (q + 1) : r * (q + 1) + (xcd - r) * q) + off; }
        const int nig = WGM * nN, gid = wgid / nig, fm = gid * WGM, gsz = (nM - fm) < WGM ? (nM - fm) : WGM;
        pm = fm + ((wgid % nig) % gsz); pn = (wgid % nig) / gsz; return true;
    }
};

template <class Epi, class Sched, bool ALIGN_EPI>
DI void gemm_phase(LAS unsigned char* lds, const Gemm g, const Sched& S, const Epi& E, int wave_id) {
    int tid_ = wave_id * 64 + lane_id(); asm volatile("" : "+v"(tid_));
    const int tid = tid_, wid = __builtin_amdgcn_readfirstlane(tid >> 6), lane = tid & 63, wr = wid >> 2, wc = wid & 3, fr = lane & 15, fq = lane >> 4;
    unsigned voffA[2], voffB[2];
#pragma unroll
    for (int i = 0; i < 2; ++i) { int R, C; stage_rc(tid * 16 + i * 8192, R, C); const int Rb = Epi::PERM ? ((R & ~31) + perm32(R & 31)) : R;
        voffA[i] = (unsigned)R * g.lda + (unsigned)C * 2u; voffB[i] = (unsigned)Rb * g.ldb + (unsigned)C * 2u; }
    const long kstep = (long)(BK * 2);
    const long hA = g.hstepA, hB = g.hstepB;
    const unsigned ldsw = (unsigned)wid * 1024u;
    const int aoff = lds_byte(wr * 64 + fr, fq * 8), boff = lds_byte(wc * 32 + fr, fq * 8);
#define PG8_SA(b, h) (((b) * 2 + (h)) * HTB)
#define PG8_SB(b, h) ((4 + (b) * 2 + (h)) * HTB)
#define PG8_STAGE(bufoff, gbase, voff) do { _Pragma("unroll") for (int _i = 0; _i < 2; ++_i) \
        __builtin_amdgcn_global_load_lds((const unsigned*)((const char*)(gbase) + (voff)[_i]), (LAS unsigned*)(lds + (bufoff) + ldsw + _i * 8192), 16, 0, 0); } while (0)
#define PG8_LDA(dst, b, h) do { _Pragma("unroll") for (int m = 0; m < 4; ++m) _Pragma("unroll") for (int k = 0; k < 2; ++k) dst[m][k] = *(const LAS bf16x8*)(lds + PG8_SA(b, h) + aoff + m * 2048 + k * 1024); } while (0)
#define PG8_LDB(dst, b, h) do { _Pragma("unroll") for (int n = 0; n < 2; ++n) _Pragma("unroll") for (int k = 0; k < 2; ++k) dst[n][k] = *(const LAS bf16x8*)(lds + PG8_SB(b, h) + boff + n * 2048 + k * 1024); } while (0)
#define PG8_MMA(ai, bj, At, Bt) do { __builtin_amdgcn_s_setprio(1); _Pragma("unroll") for (int m = 0; m < 4; ++m) _Pragma("unroll") for (int n = 0; n < 2; ++n) _Pragma("unroll") for (int k = 0; k < 2; ++k) \
        acc[ai][bj][m][n] = __builtin_amdgcn_mfma_f32_16x16x32_bf16(Bt[n][k], At[m][k], acc[ai][bj][m][n], 0, 0, 0); __builtin_amdgcn_s_setprio(0); } while (0)
#define PG8_WAIT_V(n) asm volatile("s_waitcnt vmcnt(" #n ")" ::: "memory")
#define PG8_WAIT_L(n) asm volatile("s_waitcnt lgkmcnt(" #n ")" ::: "memory")
#define PG8_BAR __builtin_amdgcn_s_barrier()
#define PG8_SCHED __builtin_amdgcn_sched_barrier(0)
    Unit cur, nxt; int ui = 0;
    if (!S.next(0, cur)) return;
    f32x4 acc[2][2][4][2];
#pragma unroll
    for (int a = 0; a < 2; ++a)
#pragma unroll
        for (int b = 0; b < 2; ++b)
#pragma unroll
            for (int m = 0; m < 4; ++m)
#pragma unroll
                for (int n = 0; n < 2; ++n) acc[a][b][m][n] = (f32x4){0.f, 0.f, 0.f, 0.f};
    bf16x8 At[4][2], B0[2][2], B1[2][2];
    const char* cA = g.A + cur.aoff; const char* cB = g.B + cur.boff;
    PG8_STAGE(PG8_SB(0, 0), cB, voffB); PG8_STAGE(PG8_SB(0, 1), cB + hB, voffB); PG8_STAGE(PG8_SA(0, 0), cA, voffA); PG8_STAGE(PG8_SA(0, 1), cA + hA, voffA);
    if (wr == 1) PG8_BAR;
    PG8_WAIT_V(2); PG8_BAR;
    PG8_STAGE(PG8_SB(1, 0), cB + kstep, voffB); PG8_STAGE(PG8_SA(1, 0), cA + kstep, voffA); PG8_STAGE(PG8_SB(1, 1), cB + hB + kstep, voffB);
    PG8_WAIT_V(6); PG8_BAR;
    for (;;) {
        const bool has_next = S.next(ui + 1, nxt);
        const char* nA = has_next ? g.A + nxt.aoff : cA; const char* nB = has_next ? g.B + nxt.boff : cB;
        const int nt = cur.nt;
        for (int t = 0; t < nt; t += 2) {
            const bool last = (t == nt - 2);
            const char* a1 = cA + (long)(t + 1) * kstep;
            const char* a2 = last ? nA : cA + (long)(t + 2) * kstep; const char* b2 = last ? nB : cB + (long)(t + 2) * kstep;
            const char* a3 = a2 + kstep; const char* b3 = b2 + kstep;
            PG8_LDB(B0, 0, 0); PG8_LDB(B1, 0, 1); PG8_SCHED; PG8_LDA(At, 0, 0); PG8_STAGE(PG8_SA(1, 1), a1 + hA, voffA);
            PG8_WAIT_V(8); PG8_WAIT_L(0); PG8_BAR; PG8_MMA(0, 0, At, B0); PG8_MMA(0, 1, At, B1); PG8_BAR; PG8_SCHED;
            PG8_LDA(At, 0, 1); PG8_STAGE(PG8_SB(0, 0), b2, voffB); PG8_STAGE(PG8_SB(0, 1), b2 + hB, voffB); PG8_STAGE(PG8_SA(0, 0), a2, voffA);
            PG8_WAIT_V(8); PG8_WAIT_L(0); PG8_BAR; PG8_MMA(1, 0, At, B0); PG8_MMA(1, 1, At, B1); PG8_BAR; PG8_SCHED;
            PG8_LDB(B0, 1, 0); PG8_LDB(B1, 1, 1); PG8_SCHED; PG8_LDA(At, 1, 0); PG8_STAGE(PG8_SA(0, 1), a2 + hA, voffA);
            PG8_WAIT_V(8); PG8_WAIT_L(0); PG8_BAR; PG8_MMA(0, 0, At, B0); PG8_MMA(0, 1, At, B1); PG8_BAR; PG8_SCHED;
            PG8_LDA(At, 1, 1); PG8_STAGE(PG8_SB(1, 0), b3, voffB); PG8_STAGE(PG8_SB(1, 1), b3 + hB, voffB); PG8_STAGE(PG8_SA(1, 0), a3, voffA);
            PG8_WAIT_V(8); PG8_WAIT_L(0); PG8_BAR; PG8_MMA(1, 0, At, B0); PG8_MMA(1, 1, At, B1); PG8_BAR; PG8_SCHED;
        }
        if constexpr (ALIGN_EPI) { if (wr == 0) PG8_BAR; }
        E(acc, cur, ui, wr, wc, fr, fq);
        if (!has_next) break;
#pragma unroll
        for (int a = 0; a < 2; ++a)
#pragma unroll
            for (int b = 0; b < 2; ++b)
#pragma unroll
                for (int m = 0; m < 4; ++m)
#pragma unroll
                    for (int n = 0; n < 2; ++n) acc[a][b][m][n] = (f32x4){0.f, 0.f, 0.f, 0.f};
        cur = nxt; cA = nA; cB = nB; ++ui;
        if constexpr (ALIGN_EPI) { if (wr == 1) PG8_BAR; }
    }
    PG8_WAIT_V(0);
    if constexpr (!ALIGN_EPI) { if (wr == 0) PG8_BAR; }
    PG8_BAR;
#undef PG8_SA
#undef PG8_SB
#undef PG8_STAGE
#undef PG8_LDA
#undef PG8_LDB
#undef PG8_MMA
#undef PG8_WAIT_V
#undef PG8_WAIT_L
#undef PG8_BAR
#undef PG8_SCHED
}
}
constexpr size_t MiB = (size_t)1 << 20;
constexpr size_t WS_CTL = 0, CTL_ZERO_BYTES = 64 * 1024;
constexpr size_t WS_WMIX = 1 * MiB, WS_WFFN = 67 * MiB, WS_XN = 133 * MiB, WS_H = 328 * MiB, WS_SCR = 716 * MiB, WS_END = 1524 * MiB;
constexpr size_t B194 = (size_t)MP * D * 2;
static_assert(B194 == 194 * MiB, "buffer size");
static_assert(WS_XN + 4096 + B194 <= WS_H && WS_H + 2 * B194 <= WS_SCR && WS_SCR + 4 * B194 <= WS_END, "ws map");
static_assert((size_t)MP * DFF * 2 <= WS_END - WS_SCR && (size_t)MP * 6144 * 2 <= WS_END - WS_SCR && WS_SCR + 4 * B194 + (size_t)MP * 128 <= WS_END, "scratch");
constexpr int CW_BAR = 1024;
constexpr int MISC_OFF = 163840 - 256, RING_BYTES = 131072, EDGE_OFF = 131072, EDGE_BYTES = 8192, LDS_BYTES = 163840;

struct Args { const float* in[30]; float* out; unsigned char* ws; int ph_lo, ph_hi; };

struct Frame {
    LAS unsigned char* lds;
    int wave, G, bid;
    DI int lane() const { return lane_id(); }
    DI int tid() const { return wave * 64 + lane_id(); }
    const float* const* in;
    float* out; unsigned char* ws;
    DI const float* I(int i) const { return in[i]; }
    DI bf16_t* XN() const { return (bf16_t*)(ws + WS_XN + 4096); }
    DI bf16_t* XC() const { return (bf16_t*)(ws + WS_H); }
    DI unsigned char* SCR() const { return ws + WS_SCR; }
    DI unsigned char* WMIX() const { return ws + WS_WMIX; }
    DI unsigned char* WFFN() const { return ws + WS_WFFN; }
};

struct SchedLin {
    pg8::TileOrder o; long a_base, a_tile, b_base, b_tile; int nt;
    DI bool next(int i, pg8::Unit& u) const { if (!o.tile(i, u.pm, u.pn)) return false; u.aoff = a_base + (long)u.pm * a_tile; u.boff = b_base + (long)u.pn * b_tile; u.nt = nt; u.sub = -1; return true; }
};
struct SchedGates {
    pg8::TileOrder o;
    DI bool next(int i, pg8::Unit& u) const { if (!o.tile(i, u.pm, u.pn)) return false; const int dir = u.pn >> 4, blk = (u.pn >> 1) & 7, hh = u.pn & 1;
        u.aoff = (long)u.pm * 256 * (D * 2) + blk * 512; u.boff = (long)((dir * 2) * 8 + blk) * 131072 + hh * 65536; u.nt = 4; u.sub = -1; return true; }
};

constexpr int RES_MAIN_PM = 192, RES_ROW0 = RES_MAIN_PM * 256, RES_NSPLIT = 4;
struct SchedRes {
    pg8::TileOrder o; long a_tile, b_base, b_tile; int nt; int G, c;
    DI void init(int G_, int c_, long a_tile_, long b_base_, long b_tile_, int nt_, int wgm_ = 4) { o.init(RES_MAIN_PM, 8, G_, c_, wgm_); G = G_; c = c_; a_tile = a_tile_; b_base = b_base_; b_tile = b_tile_; nt = nt_; }
    DI bool next(int i, pg8::Unit& u) const {
        const long L = (long)i * G + c;
        if (L < RES_MAIN_PM * 8) { o.tile(i, u.pm, u.pn); u.aoff = (long)u.pm * a_tile; u.boff = b_base + (long)u.pn * b_tile; u.nt = nt; u.sub = -1; return true; }
        const int r = (int)(L - RES_MAIN_PM * 8); if (r >= 16 * RES_NSPLIT) return false;
        const int s = r % RES_NSPLIT, t = r / RES_NSPLIT, nts = nt / RES_NSPLIT;
        u.pm = RES_MAIN_PM + (t >> 3); u.pn = t & 7; u.aoff = (long)u.pm * a_tile + (long)s * nts * 128; u.boff = b_base + (long)u.pn * b_tile + (long)s * nts * 128; u.nt = nts; u.sub = s; return true; }
};

DI float row_rs(const float* rsv, int row, int) { return rsv[row]; }
#ifndef NT_STORES
#define NT_STORES 0
#endif
template <class T> DI void st_stream(T* p, const T v) { if (NT_STORES) __builtin_nontemporal_store(v, p); else *p = v; }
DI u32x4 pack8(const f32x4 v0, const f32x4 v1) { u32x4 w; w.x = cvt_pk_bf16(v0[0], v0[1]); w.y = cvt_pk_bf16(v0[2], v0[3]); w.z = cvt_pk_bf16(v1[0], v1[1]); w.w = cvt_pk_bf16(v1[2], v1[3]); return w; }

struct EpiRgIn {
    static constexpr bool PERM = true;
    bf16_t* ygate; bf16_t* yrec; const float* ss;
    DI void operator()(const f32x4 (&acc)[2][2][4][2], const pg8::Unit& u, int, int wr, int wc, int fr, int fq) const {
        const bool isg = u.pn < 8; bf16_t* base = isg ? ygate : yrec; const int colt = (isg ? u.pn : u.pn - 8) * 256;
        const int row0 = u.pm * 256 + wr * 64 + fr, col0 = colt + wc * 32 + 8 * fq;
        float rs8[2][4];
#pragma unroll
        for (int ai = 0; ai < 2; ++ai)
#pragma unroll
            for (int m = 0; m < 4; ++m) rs8[ai][m] = row_rs(ss, row0 + ai * 128 + m * 16, fq);
#pragma unroll
        for (int ai = 0; ai < 2; ++ai)
#pragma unroll
            for (int m = 0; m < 4; ++m) { bf16_t* rowp = base + (size_t)(row0 + ai * 128 + m * 16) * D + col0; const float rs = rs8[ai][m];
#pragma unroll
                for (int bj = 0; bj < 2; ++bj) { f32x4 v0 = acc[ai][bj][m][0] * rs, v1 = acc[ai][bj][m][1] * rs;
                    if (isg) {
#pragma unroll
                        for (int j = 0; j < 4; ++j) { v0[j] = gelu_tanh_(v0[j]); v1[j] = gelu_tanh_(v1[j]); } }
                    st_stream((u32x4*)(rowp + bj * 128), pack8(v0, v1)); } }
    }
};
struct EpiPlainBf16 {
    static constexpr bool PERM = true;
    bf16_t* O; int ldc; const float* ss;
    DI void operator()(const f32x4 (&acc)[2][2][4][2], const pg8::Unit& u, int, int wr, int wc, int fr, int fq) const {
        const int row0 = u.pm * 256 + wr * 64 + fr, col0 = u.pn * 256 + wc * 32 + 8 * fq;
        float rs8[2][4];
#pragma unroll
        for (int ai = 0; ai < 2; ++ai)
#pragma unroll
            for (int m = 0; m < 4; ++m) rs8[ai][m] = row_rs(ss, row0 + ai * 128 + m * 16, fq);
#pragma unroll
        for (int ai = 0; ai < 2; ++ai)
#pragma unroll
            for (int m = 0; m < 4; ++m) { bf16_t* rowp = O + (size_t)(row0 + ai * 128 + m * 16) * ldc + col0; const float rs = rs8[ai][m];
#pragma unroll
                for (int bj = 0; bj < 2; ++bj) st_stream((u32x4*)(rowp + bj * 128), pack8(acc[ai][bj][m][0] * rs, acc[ai][bj][m][1] * rs)); }
    }
};
struct EpiGdnProj {
    static constexpr bool PERM = true;
    bf16_t* qkv; bf16_t* z; float* bg; const float* a_log; const float* dt_bias; bf16_t* halo; const float* ss;
    DI void operator()(const f32x4 (&acc)[2][2][4][2], const pg8::Unit& u, int, int wr, int wc, int fr, int fq) const {
        const int row0 = u.pm * 256 + wr * 64 + fr;
        float rs8[2][4];
#pragma unroll
        for (int ai = 0; ai < 2; ++ai)
#pragma unroll
            for (int m = 0; m < 4; ++m) rs8[ai][m] = row_rs(ss, row0 + ai * 128 + m * 16, fq);
        if (u.pn < 24) {
            bf16_t* base; int ldc, colt; if (u.pn < 16) { base = qkv; ldc = 4096; colt = u.pn * 256; } else { base = z; ldc = 2048; colt = (u.pn - 16) * 256; }
            const int col0 = colt + wc * 32 + 8 * fq;
#pragma unroll
            for (int ai = 0; ai < 2; ++ai)
#pragma unroll
                for (int m = 0; m < 4; ++m) { const int row = row0 + ai * 128 + m * 16; bf16_t* rowp = base + (size_t)row * ldc + col0;
                    const int r64 = row & 63, rb = row >> 6;
                    bf16_t* hp = nullptr;
                    if (u.pn < 16) { if (r64 == 63) hp = halo + ((size_t)(rb + 1) * 3 + 0) * 4096 + col0; else if (r64 == 0 && rb > 0) hp = halo + ((size_t)(rb - 1) * 3 + 1) * 4096 + col0; else if (r64 == 1 && rb > 0) hp = halo + ((size_t)(rb - 1) * 3 + 2) * 4096 + col0; }
                    const float rs = rs8[ai][m];
#pragma unroll
                    for (int bj = 0; bj < 2; ++bj) { const u32x4 w = pack8(acc[ai][bj][m][0] * rs, acc[ai][bj][m][1] * rs); st_stream((u32x4*)(rowp + bj * 128), w); if (hp) *(u32x4*)(hp + bj * 128) = w; } }
        } else {
            const int c0 = wc * 32 + 8 * fq;
            float al[8], db[8];
#pragma unroll
            for (int j = 0; j < 8; ++j) { const int c = c0 + j; al[j] = c >= 64 ? __expf(a_log[c - 64]) : 0.f; db[j] = c >= 64 ? dt_bias[c - 64] : 0.f; }
#pragma unroll
            for (int ai = 0; ai < 2; ++ai)
#pragma unroll
                for (int m = 0; m < 4; ++m) { float* rowp = bg + (size_t)(row0 + ai * 128 + m * 16) * 128 + c0; const float rs = rs8[ai][m];
                    f32x4 o[2];
#pragma unroll
                    for (int n = 0; n < 2; ++n)
#pragma unroll
                        for (int j = 0; j < 4; ++j) { const float x = acc[ai][0][m][n][j] * rs; const int jj = n * 4 + j;
                            o[n][j] = (c0 >= 64) ? -al[jj] * softplusf_(x + db[jj]) : sigmoidf_(x); }
                    *(f32x4*)(rowp) = o[0]; *(f32x4*)(rowp + 4) = o[1]; }
        }
    }
};
struct EpiResAdd {
    static constexpr bool PERM = true;
    const bf16_t* xin; bf16_t* xn; float* ss; float* slab;
    DI void operator()(const f32x4 (&acc)[2][2][4][2], const pg8::Unit& u, int, int wr, int wc, int fr, int fq) const {
        const int row0 = u.pm * 256 + wr * 64 + fr, col0 = u.pn * 256 + wc * 32 + 8 * fq;
        if (u.sub >= 0) {
#pragma unroll
            for (int ai = 0; ai < 2; ++ai)
#pragma unroll
                for (int m = 0; m < 4; ++m) { float* sp = slab + ((size_t)u.sub * 512 + (row0 + ai * 128 + m * 16 - RES_ROW0)) * D + col0;
#pragma unroll
                    for (int bj = 0; bj < 2; ++bj) { *(f32x4*)(sp + bj * 128) = acc[ai][bj][m][0]; *(f32x4*)(sp + bj * 128 + 4) = acc[ai][bj][m][1]; } }
            return; }
        const int l_ = lane_id(); const unsigned voff = (unsigned)((l_ & 15) * D + 8 * (l_ >> 4)) * 2u;
        const char* xi_u = (const char*)xin + ((size_t)(u.pm * 256 + wr * 64) * D + u.pn * 256 + wc * 32) * 2;
        char* xn_u = (char*)xn + ((size_t)(u.pm * 256 + wr * 64) * D + u.pn * 256 + wc * 32) * 2;
        u32x4 v[2][4][2];
#pragma unroll
        for (int ai = 0; ai < 2; ++ai)
#pragma unroll
            for (int m = 0; m < 4; ++m)
#pragma unroll
                for (int bj = 0; bj < 2; ++bj) v[ai][m][bj] = *(const u32x4*)(xi_u + (size_t)(ai * 128 + m * 16) * (D * 2) + bj * 256 + voff);
#pragma unroll
        for (int ai = 0; ai < 2; ++ai) {
#pragma unroll
            for (int m = 0; m < 4; ++m) { const int row = row0 + ai * 128 + m * 16; char* rowp = xn_u + (size_t)(ai * 128 + m * 16) * (D * 2);
                float sq = 0.f;
#pragma unroll
                for (int bj = 0; bj < 2; ++bj) { const u32x4 vv = v[ai][m][bj];
                    const f32x4 h0 = (f32x4){bf_lo(vv.x), bf_hi(vv.x), bf_lo(vv.y), bf_hi(vv.y)} + acc[ai][bj][m][0], h1 = (f32x4){bf_lo(vv.z), bf_hi(vv.z), bf_lo(vv.w), bf_hi(vv.w)} + acc[ai][bj][m][1];
                    const u32x4 w = pack8(h0, h1); *(u32x4*)(rowp + bj * 256 + voff) = w;
                    if (ss) { const float r0 = bf_lo(w.x), r1 = bf_hi(w.x), r2 = bf_lo(w.y), r3 = bf_hi(w.y), r4 = bf_lo(w.z), r5 = bf_hi(w.z), r6 = bf_lo(w.w), r7 = bf_hi(w.w);
                        sq += ((r0 * r0 + r1 * r1) + (r2 * r2 + r3 * r3)) + ((r4 * r4 + r5 * r5) + (r6 * r6 + r7 * r7)); } }
                if (ss) { sq += __shfl_xor(sq, 16); sq += __shfl_xor(sq, 32); if (fq == 0) ss[((size_t)u.pm * 32 + u.pn * 4 + wc) * 256 + (row & 255)] = sq; } }
        }
    }
};
#ifndef GATES_TOP
#define GATES_TOP 4
#endif
struct EpiGates {
    static constexpr bool PERM = true;
    const bf16_t* xc; bf16_t* la; bf16_t* uu;
    size_t dstride; const float* b_a; const float* b_i; const float* lam;
    LAS float* cl;
    DI void operator()(const f32x4 (&acc)[2][2][4][2], const pg8::Unit& u, int, int wr, int wc, int fr, int fq) const {
        const int dir = u.pn >> 4, blk = (u.pn >> 1) & 7, hh = u.pn & 1;
        const int row0 = u.pm * 256 + wr * 64 + fr, c0 = blk * 256 + hh * 128 + wc * 32 + 8 * fq;
        LAS float* cw_ = cl + (wr * 4 + wc) * 96;
        { const int lane = lane_id(); if (lane < 32) { const int c = dir * D + blk * 256 + hh * 128 + wc * 32 + lane;
            cw_[lane] = b_a[c]; cw_[32 + lane] = b_i[c]; cw_[64 + lane] = -8.0f * softplus_lite(-lam[c]); } }
        const int l_ = lane_id(); const unsigned voff = (unsigned)((l_ & 15) * D + 8 * (l_ >> 4)) * 2u;
        const size_t uoff = ((size_t)(u.pm * 256 + wr * 64) * D + blk * 256 + hh * 128 + wc * 32) * 2;
        const char* xc_u = (const char*)xc + uoff; char* la_u = (char*)(la + dir * dstride) + uoff; char* uu_u = (char*)(uu + dir * dstride) + uoff;
        u32x4 xw4[2][4];
#pragma unroll
        for (int g = 0; g < GATES_TOP; ++g) xw4[g >> 2][g & 3] = *(const u32x4*)(xc_u + (size_t)((g >> 2) * 128 + (g & 3) * 16) * (D * 2) + voff);
#pragma unroll
        for (int ai = 0; ai < 2; ++ai) {
#pragma unroll
            for (int m = 0; m < 4; ++m) { const size_t off = (size_t)(ai * 128 + m * 16) * (D * 2);
                const u32x4 xw = xw4[ai][m];
                float xv[8]; xv[0] = bf_lo(xw.x); xv[1] = bf_hi(xw.x); xv[2] = bf_lo(xw.y); xv[3] = bf_hi(xw.y); xv[4] = bf_lo(xw.z); xv[5] = bf_hi(xw.z); xv[6] = bf_lo(xw.w); xv[7] = bf_hi(xw.w);
                f32x4 lo[2], uo[2];
#pragma unroll
                for (int n = 0; n < 2; ++n) { LAS float* cp = cw_ + 8 * fq; asm volatile("" : "+v"(cp));
                    const f32x4 ba = *(const LAS f32x4*)(cp + 4 * n), bi = *(const LAS f32x4*)(cp + 32 + 4 * n), sp = *(const LAS f32x4*)(cp + 64 + 4 * n);
#pragma unroll
                    for (int jp = 0; jp < 2; ++jp) { const int j = 2 * jp, jj = n * 4 + j;
                        const f32x2 NL2E = (f32x2){-1.4426950408889634f, -1.4426950408889634f}, ONE = (f32x2){1.f, 1.f};
                        const f32x2 ta = ((f32x2){acc[ai][0][m][n][j], acc[ai][0][m][n][j + 1]} + (f32x2){ba[j], ba[j + 1]}) * NL2E;
                        const f32x2 ti = ((f32x2){acc[ai][1][m][n][j], acc[ai][1][m][n][j + 1]} + (f32x2){bi[j], bi[j + 1]}) * NL2E;
                        const f32x2 da = (f32x2){__builtin_amdgcn_exp2f(ta[0]), __builtin_amdgcn_exp2f(ta[1])} + ONE, di = (f32x2){__builtin_amdgcn_exp2f(ti[0]), __builtin_amdgcn_exp2f(ti[1])} + ONE;
                        const f32x2 r = (f32x2){fast_rcp(da[0]), fast_rcp(da[1])}, ig = (f32x2){fast_rcp(di[0]), fast_rcp(di[1])};
                        const f32x2 l = (f32x2){sp[j], sp[j + 1]} * r;
                        lo[n][j] = l[0]; lo[n][j + 1] = l[1];
                        const f32x2 x2 = l + l;
                        const f32x2 te = x2 * (f32x2){1.4426950408889634f, 1.4426950408889634f};
                        const f32x2 om_e = ONE - (f32x2){__builtin_amdgcn_exp2f(te[0]), __builtin_amdgcn_exp2f(te[1])};
                        const f32x2 om_s = (x2 * (f32x2){0.5f, 0.5f} + ONE) * (-x2);
                        const float om0 = x2[0] > -0.0009765625f ? om_s[0] : om_e[0], om1 = x2[1] > -0.0009765625f ? om_s[1] : om_e[1];
                        const f32x2 sq = (f32x2){__builtin_amdgcn_sqrtf(fmaxf(om0, 0.f)), __builtin_amdgcn_sqrtf(fmaxf(om1, 0.f))};
                        const f32x2 u2 = sq * (ig * (f32x2){xv[jj], xv[jj + 1]});
                        uo[n][j] = u2[0]; uo[n][j + 1] = u2[1]; }
                    __builtin_amdgcn_sched_barrier(0); }
                *(u32x4*)(la_u + off + voff) = pack8(lo[0], lo[1]);
                *(u32x4*)(uu_u + off + voff) = pack8(uo[0], uo[1]);
                __builtin_amdgcn_sched_barrier(0);
                if (ai == 0 && m == 0) {
#pragma unroll
                    for (int g = GATES_TOP; g < 8; ++g) xw4[g >> 2][g & 3] = *(const u32x4*)(xc_u + (size_t)((g >> 2) * 128 + (g & 3) * 16) * (D * 2) + voff);
                    __builtin_amdgcn_sched_barrier(0); } }
        }
    }
};
struct EpiFfnUp {
    static constexpr bool PERM = true;
    bf16_t* act; const float* cw; const float* cb; LAS float* edge; const float* ss; const unsigned char* rflag;
    DI void operator()(f32x4 (&acc)[2][2][4][2], const pg8::Unit& u, int ui, int wr, int wc, int fr, int fq) const {
        const int lane = fq * 16 + fr;
        LAS float* ef = edge + (ui & 1) * 1024, * el = ef + 512;
        LAS float* tapl = edge + 2048 + (wr * 4 + wc) * 128;
        const int cg0 = wc * 32 + 8 * fq;
        float rs8[2][4]; unsigned flp[2] = {0u, 0u};
#pragma unroll
        for (int ai = 0; ai < 2; ++ai)
#pragma unroll
            for (int m = 0; m < 4; ++m) { const int r = 128 * ai + 64 * wr + 16 * m + fr; const int R = 254 * u.pm - 1 + r; const int Rc = R < 0 ? 0 : R;
                rs8[ai][m] = row_rs(ss, Rc, fq); flp[ai] |= ((__float_as_uint(rs8[ai][m]) & 3u) | ((r >= 1 && r <= 254 && R < MTOK) ? 4u : 0u)) << (8 * m); }
        if (lane < 32) { const int a = lane >> 3, c = lane & 7; const float* src = (a < 3 ? cw + (size_t)a * DFF : cb) + u.pn * 128 + wc * 32 + 4 * c;
            *(LAS f32x4*)(tapl + a * 32 + 4 * c) = *(const f32x4*)src; }
#pragma unroll
        for (int ai = 0; ai < 2; ++ai)
#pragma unroll
            for (int m = 0; m < 4; ++m)
#pragma unroll
                for (int bj = 0; bj < 2; ++bj)
#pragma unroll
                    for (int n = 0; n < 2; ++n) acc[ai][bj][m][n] = acc[ai][bj][m][n] * rs8[ai][m];
        __builtin_amdgcn_sched_barrier(0);
#pragma unroll
        for (int ai = 0; ai < 2; ++ai) { const int sg = 2 * ai + wr;
            if (fr == 0) { *(LAS f32x4*)(ef + sg * 128 + cg0) = acc[ai][0][0][0]; *(LAS f32x4*)(ef + sg * 128 + cg0 + 4) = acc[ai][0][0][1]; }
            if (fr == 15) { *(LAS f32x4*)(el + sg * 128 + cg0) = acc[ai][0][3][0]; *(LAS f32x4*)(el + sg * 128 + cg0 + 4) = acc[ai][0][3][1]; } }
        asm volatile("s_waitcnt lgkmcnt(0)" ::: "memory"); __builtin_amdgcn_s_barrier(); asm volatile("" ::: "memory");
        const int cf0 = u.pn * 128 + cg0;
#ifdef FFU_EPI_REP
        int reps_ = FFU_EPI_REP; asm volatile("" : "+s"(reps_));
        for (int rep_ = 0; rep_ < reps_; ++rep_)
#endif
#pragma unroll
        for (int ai = 0; ai < 2; ++ai) { const int sg = 2 * ai + wr;
#pragma unroll
            for (int n = 0; n < 2; ++n) {
                const f32x4 w0 = *(const LAS f32x4*)(tapl + 8 * fq + 4 * n), w1 = *(const LAS f32x4*)(tapl + 32 + 8 * fq + 4 * n), w2 = *(const LAS f32x4*)(tapl + 64 + 8 * fq + 4 * n), bb = *(const LAS f32x4*)(tapl + 96 + 8 * fq + 4 * n);
                const f32x4 htop = sg > 0 ? *(LAS f32x4*)(el + (sg - 1) * 128 + cg0 + 4 * n) : (f32x4){0.f, 0.f, 0.f, 0.f};
                const f32x4 hbot = sg < 3 ? *(LAS f32x4*)(ef + (sg + 1) * 128 + cg0 + 4 * n) : (f32x4){0.f, 0.f, 0.f, 0.f};
                unsigned pk[4][2];
#pragma unroll
                for (int jp = 0; jp < 2; ++jp) {
                    float pvv[2][4], nvv[2][4], vv[2][4];
#pragma unroll
                    for (int j2 = 0; j2 < 2; ++j2) { const int j = 2 * jp + j2;
                        float upv[4], dnv[4];
#pragma unroll
                        for (int m = 0; m < 4; ++m) { vv[j2][m] = acc[ai][0][m][n][j];
                            upv[m] = __int_as_float(__builtin_amdgcn_update_dpp(0, __float_as_int(vv[j2][m]), 0x121, 0xf, 0xf, false));
                            dnv[m] = __int_as_float(__builtin_amdgcn_update_dpp(0, __float_as_int(vv[j2][m]), 0x12F, 0xf, 0xf, false)); }
#pragma unroll
                        for (int m = 0; m < 4; ++m) {
                            float pv = fr > 0 ? upv[m] : (m > 0 ? upv[m > 0 ? m - 1 : 0] : htop[j]);
                            float nv = fr < 15 ? dnv[m] : (m < 3 ? dnv[m < 3 ? m + 1 : 3] : hbot[j]);
                            pvv[j2][m] = (flp[ai] & (1u << (8 * m))) ? 0.f : pv; nvv[j2][m] = (flp[ai] & (2u << (8 * m))) ? 0.f : nv; } }
                    const f32x2 W0 = (f32x2){w0[2 * jp], w0[2 * jp + 1]}, W1 = (f32x2){w1[2 * jp], w1[2 * jp + 1]}, W2 = (f32x2){w2[2 * jp], w2[2 * jp + 1]}, BB = (f32x2){bb[2 * jp], bb[2 * jp + 1]};
#pragma unroll
                    for (int m = 0; m < 4; ++m) {
                        const f32x2 P = (f32x2){pvv[0][m], pvv[1][m]}, V = (f32x2){vv[0][m], vv[1][m]}, N = (f32x2){nvv[0][m], nvv[1][m]};
                        const f32x2 a = W0 * P + (W1 * V + (W2 * N + BB));
                        const f32x2 t = a * (f32x2){-1.4426950408889634f, -1.4426950408889634f};
                        const f32x2 den = (f32x2){__builtin_amdgcn_exp2f(t[0]), __builtin_amdgcn_exp2f(t[1])} + (f32x2){1.f, 1.f};
                        const f32x2 r = (f32x2){fast_rcp(den[0]), fast_rcp(den[1])};
                        const f32x2 o = (a * r) * (f32x2){acc[ai][1][m][n][2 * jp], acc[ai][1][m][n][2 * jp + 1]};
                        pk[m][jp] = cvt_pk_bf16(o[0], o[1]); }
                    __builtin_amdgcn_sched_barrier(0);
                }
#pragma unroll
                for (int m = 0; m < 4; ++m) if (flp[ai] & (4u << (8 * m))) { u32x2 w; w.x = pk[m][0]; w.y = pk[m][1];
                    st_stream((u32x2*)(act + (size_t)(254 * u.pm - 1 + 128 * ai + 64 * wr + 16 * m + fr) * DFF + cf0 + 4 * n), w); }
                __builtin_amdgcn_sched_barrier(0);
            }
        }
    }
};
#define LDS_WAIT() asm volatile("s_waitcnt lgkmcnt(0)" ::: "memory")
DI void cvt_item(const float* W, int ldw, int col0, bf16_t* WT, int ldt, int k0, int n0, LAS float* scr, int lane, const float* gain = nullptr) {
    { float w[32]; const float* wp = W + (size_t)(k0 + (lane >> 5)) * ldw + col0 + n0 + (lane & 31);
#pragma unroll
        for (int i = 0; i < 32; ++i) w[i] = wp[(size_t)(2 * i) * ldw];
        if (gain) {
#pragma unroll
            for (int i = 0; i < 32; ++i) w[i] *= gain[k0 + 2 * i + (lane >> 5)]; }
#pragma unroll
        for (int i = 0; i < 32; ++i) scr[(2 * i + (lane >> 5)) * 33 + (lane & 31)] = w[i]; }
    LDS_WAIT(); asm volatile("" ::: "memory");
    const int c = lane & 7;
#pragma unroll
    for (int j = 0; j < 4; ++j) { const int n = (lane >> 3) + 8 * j; const LAS float* s = scr + (8 * c) * 33 + n;
        u32x4 o; o.x = cvt_pk_bf16(s[0 * 33], s[1 * 33]); o.y = cvt_pk_bf16(s[2 * 33], s[3 * 33]); o.z = cvt_pk_bf16(s[4 * 33], s[5 * 33]); o.w = cvt_pk_bf16(s[6 * 33], s[7 * 33]);
        *(u32x4*)(WT + (size_t)(n0 + n) * ldt + k0 + 8 * c) = o; }
    LDS_WAIT(); asm volatile("" ::: "memory");
}
struct CvtCursor { int cur, base, step; };
DI void cvt_job(CvtCursor& cc, const float* W, int ldw, int col0, int ncols, int K, bf16_t* WT, int ldt, LAS float* scr, int lane, const float* gain = nullptr) {
    const int nb = ncols / 32, n = (K / 64) * nb;
    while (cc.cur < cc.base + n) { const int it = cc.cur - cc.base; cvt_item(W, ldw, col0, WT, ldt, 64 * (it / nb), 32 * (it % nb), scr, lane, gain); cc.cur += cc.step; }
    cc.base += n;
}
DI void cvt_ffn(Frame& F, CvtCursor& cc, int li, LAS float* scr) {
    bf16_t* wg = (bf16_t*)F.WFFN(); bf16_t* wu = wg + (size_t)DFF * D; bf16_t* wd = wu + (size_t)DFF * D;
    cvt_job(cc, F.I(25) + (size_t)li * D * DFF, DFF, 0, DFF, D, wg, D, scr, F.lane(), F.I(4) + (size_t)li * D);
    cvt_job(cc, F.I(26) + (size_t)li * D * DFF, DFF, 0, DFF, D, wu, D, scr, F.lane(), F.I(4) + (size_t)li * D);
    cvt_job(cc, F.I(29) + (size_t)li * DFF * D, D, 0, D, DFF, wd, DFF, scr, F.lane());
}
DI void cvt_rg(Frame& F, CvtCursor& cc, int j, int li, LAS float* scr) {
    bf16_t* win = (bf16_t*)F.WMIX(); bf16_t* gates = win + (size_t)4096 * D; bf16_t* wout = gates + (size_t)32 * 65536;
    cvt_job(cc, F.I(6) + (size_t)j * D * 4096, 4096, 0, 4096, D, win, D, scr, F.lane(), F.I(3) + (size_t)li * D);
    {
        const int n = 32 * 32;
        while (cc.cur < cc.base + n) { const int it = cc.cur - cc.base; const int bid = it >> 5, sub = it & 31; const int gate = bid >> 4, dir = (bid >> 3) & 1, blk = bid & 7;
            const float* src = F.I(gate ? 11 : 9) + (size_t)((j * 2 + dir) * 8 + blk) * 65536;
            cvt_item(src, 256, 0, gates + (size_t)((dir * 2 + gate) * 8 + blk) * 65536, 256, 64 * (sub >> 3), 32 * (sub & 7), scr, F.lane()); cc.cur += cc.step; }
        cc.base += n; }
    cvt_job(cc, F.I(14) + (size_t)j * D * D, D, 0, D, D, wout, D, scr, F.lane());
}
DI void cvt_na(Frame& F, CvtCursor& cc, LAS float* scr) {
    bf16_t* wqkv = (bf16_t*)F.WMIX(); bf16_t* wo = wqkv + (size_t)6144 * D;
    cvt_job(cc, F.I(15), 6144, 0, 6144, D, wqkv, D, scr, F.lane(), F.I(3) + (size_t)1 * D);
    cvt_job(cc, F.I(18), D, 0, D, D, wo, D, scr, F.lane());
}
DI void cvt_gdn(Frame& F, CvtCursor& cc, LAS float* scr) {
    bf16_t* w0 = (bf16_t*)F.WMIX(); bf16_t* w1 = w0 + (size_t)6400 * D; bf16_t* wout = w1 + (size_t)6144 * D;
    const float* W = F.I(19);
    for (int g = 0; g < 2; ++g) { bf16_t* w = g ? w1 : w0;
        cvt_job(cc, W, 12416, g * 1024, 1024, D, w, D, scr, F.lane(), F.I(3) + (size_t)2 * D);
        cvt_job(cc, W, 12416, 2048 + g * 1024, 1024, D, w + (size_t)1024 * D, D, scr, F.lane(), F.I(3) + (size_t)2 * D);
        cvt_job(cc, W, 12416, 4096 + g * 2048, 2048, D, w + (size_t)2048 * D, D, scr, F.lane(), F.I(3) + (size_t)2 * D);
        cvt_job(cc, W, 12416, 8192 + g * 2048, 2048, D, w + (size_t)4096 * D, D, scr, F.lane(), F.I(3) + (size_t)2 * D); }
    cvt_job(cc, W, 12416, 12288, 128, D, w0 + (size_t)6144 * D, D, scr, F.lane(), F.I(3) + (size_t)2 * D);
    cvt_job(cc, F.I(24), D, 0, D, 4096, wout, 4096, scr, F.lane());
}

DI float rs_tag(int R, float rs) { int b, t; row_bt(R, b, t); const unsigned f = (t == 0 ? 1u : 0u) | ((b < NSEQ && t == seq_len(b) - 1) ? 2u : 0u); return __uint_as_float((__float_as_uint(rs) & ~3u) | f); }
template <int MODE> DI void norm_phase(Frame& F, bf16_t* X, const float* gain, float* rsv, const bf16_t* xin2 = nullptr, const float* slab = nullptr) {
    const int gw = F.bid * 8 + F.wave, NGW = F.G * 8, lane = F.lane();
    if (MODE == 1) {
        for (int i = F.bid * 512 + F.tid(); i < (MP - MTOK + 1) * (D / 8); i += F.G * 512) { const int r = i / (D / 8), c = i % (D / 8); const int R = r == 0 ? -1 : MTOK + r - 1;
            *(u32x4*)(X + (long)R * D + c * 8) = (u32x4){0u, 0u, 0u, 0u}; }
        for (int i = F.bid * 512 + F.tid(); i < MP - MTOK; i += F.G * 512) rsv[MTOK + i] = 0.f;
    }
    for (int R = gw; R < MTOK; R += NGW) {
        int b, t; row_bt(R, b, t);
        bf16_t* xr = X + (size_t)R * D;
        if (MODE == 2 && t < NMETA) continue;
        f32x4 v[8]; float s = 0.f;
        if (MODE == 1) {
            const float* src; if (t < NMETA) src = F.I(2) + (size_t)t * D; else if (b < NPROMPT) src = F.I(0) + ((size_t)b * LP + (t - NMETA)) * D; else src = F.I(1) + ((size_t)(b - NPROMPT) * LS + (t - NMETA)) * D;
#pragma unroll
            for (int j = 0; j < 8; ++j) { const f32x4 x = *(const f32x4*)(src + 4 * (lane + 64 * j)); u32x2 w; w.x = cvt_pk_bf16(x[0], x[1]); w.y = cvt_pk_bf16(x[2], x[3]); *(u32x2*)(xr + 4 * (lane + 64 * j)) = w;
                v[j] = (f32x4){bf_lo(w.x), bf_hi(w.x), bf_lo(w.y), bf_hi(w.y)}; }
        } else {
#pragma unroll
            for (int j = 0; j < 8; ++j) { const u32x2 w = *(const u32x2*)((R >= RES_ROW0 && xin2 ? xin2 + (size_t)R * D : xr) + 4 * (lane + 64 * j)); v[j] = (f32x4){bf_lo(w.x), bf_hi(w.x), bf_lo(w.y), bf_hi(w.y)}; }
            if (R >= RES_ROW0 && slab) {
#pragma unroll
                for (int s = 0; s < RES_NSPLIT; ++s)
#pragma unroll
                    for (int j = 0; j < 8; ++j) v[j] += *(const f32x4*)(slab + ((size_t)s * 512 + (R - RES_ROW0)) * D + 4 * (lane + 64 * j));
#pragma unroll
                for (int j = 0; j < 8; ++j) { const unsigned w0 = cvt_pk_bf16(v[j][0], v[j][1]), w1 = cvt_pk_bf16(v[j][2], v[j][3]); v[j] = (f32x4){bf_lo(w0), bf_hi(w0), bf_lo(w1), bf_hi(w1)}; } }
        }
#pragma unroll
        for (int j = 0; j < 8; ++j) s += (v[j][0] * v[j][0] + v[j][1] * v[j][1]) + (v[j][2] * v[j][2] + v[j][3] * v[j][3]);
        const float rs = 1.0f / sqrtf(wave_sum(s) * (1.0f / D) + NORM_EPS);
        if (MODE == 1) { if (lane == 0) rsv[R] = rs_tag(R, rs); }
        else {
            float* orow = F.out + (b < NPROMPT ? ((size_t)b * LP + (t - NMETA)) : ((size_t)NPROMPT * LP + (size_t)(b - NPROMPT) * LS + (t - NMETA))) * D;
#pragma unroll
            for (int j = 0; j < 8; ++j) { const f32x4 gv = *(const f32x4*)(gain + 4 * (lane + 64 * j)); *(f32x4*)(orow + 4 * (lane + 64 * j)) = v[j] * rs * gv; }
        }
    }
}
DI void ss_final_phase(Frame& F, const float* ssp, float* rsv, const bf16_t* xin, bf16_t* xout, const float* slab0, const float* slab1) {
    for (int R = F.bid * 512 + F.tid(); R < RES_ROW0; R += F.G * 512) { const float* p = ssp + (size_t)(R >> 8) * 32 * 256 + (R & 255); float s = 0.f;
#pragma unroll
        for (int i = 0; i < 8; ++i) s += (p[(4 * i) * 256] + p[(4 * i + 1) * 256]) + (p[(4 * i + 2) * 256] + p[(4 * i + 3) * 256]);
        rsv[R] = rs_tag(R, 1.0f / sqrtf(s * (1.0f / D) + NORM_EPS)); }
    const int lane = F.lane();
    for (int R = RES_ROW0 + F.bid * 8 + F.wave; R < MP; R += F.G * 8) {
        float v[32];
#pragma unroll
        for (int i = 0; i < 4; ++i) { const u32x4 x = *(const u32x4*)(xin + (size_t)R * D + lane * 32 + 8 * i); const unsigned w[4] = {x.x, x.y, x.z, x.w};
#pragma unroll
            for (int k = 0; k < 4; ++k) { v[8 * i + 2 * k] = bf_lo(w[k]); v[8 * i + 2 * k + 1] = bf_hi(w[k]); } }
#pragma unroll
        for (int set = 0; set < 2; ++set) { const float* sl = set ? slab1 : slab0; if (!sl) continue;
#pragma unroll
            for (int s = 0; s < RES_NSPLIT; ++s) { const float* p = sl + ((size_t)s * 512 + (R - RES_ROW0)) * D + lane * 32;
#pragma unroll
                for (int i = 0; i < 8; ++i) { const f32x4 a = *(const f32x4*)(p + 4 * i); v[4 * i] += a[0]; v[4 * i + 1] += a[1]; v[4 * i + 2] += a[2]; v[4 * i + 3] += a[3]; } } }
        float sq = 0.f;
#pragma unroll
        for (int i = 0; i < 4; ++i) { u32x4 w; unsigned ww[4];
#pragma unroll
            for (int k = 0; k < 4; ++k) { ww[k] = cvt_pk_bf16(v[8 * i + 2 * k], v[8 * i + 2 * k + 1]); const float a = bf_lo(ww[k]), b = bf_hi(ww[k]); sq += a * a + b * b; }
            w.x = ww[0]; w.y = ww[1]; w.z = ww[2]; w.w = ww[3]; *(u32x4*)(xout + (size_t)R * D + lane * 32 + 8 * i) = w; }
        const float tot = wave_sum(sq);
        if (lane == 0) rsv[R] = rs_tag(R, 1.0f / sqrtf(tot * (1.0f / D) + NORM_EPS));
    }
}
DI void fill_rflag(Frame& F, unsigned char* rf) { for (int R = F.bid * 512 + F.tid(); R < MP; R += F.G * 512) { int b, t; row_bt(R, b, t); rf[R] = (unsigned char)((t == 0 ? 1 : 0) | ((b < NSEQ && t == seq_len(b) - 1) ? 2 : 0)); } }

DI void rg_conv_phase(Frame& F, const bf16_t* yrec, bf16_t* xc, const float* cw, const float* cb) {
    const int tid = F.tid(), cg = tid & 255, c0 = cg * 8;
    float w[4][8], bb[8];
#pragma unroll
    for (int j = 0; j < 4; ++j)
#pragma unroll
        for (int e = 0; e < 8; ++e) w[j][e] = cw[j * D + c0 + e];
#pragma unroll
    for (int e = 0; e < 8; ++e) bb[e] = cb[c0 + e];
    for (int s = F.bid * 2 + (tid >> 8); s < MTOK / 16; s += F.G * 2) {
        const int R0 = 16 * s; int b, t0; row_bt(R0, b, t0); const int T = seq_len(b);
        const bf16_t* yp = yrec + (size_t)R0 * D + c0;
        u32x4 x0 = (u32x4){0u, 0u, 0u, 0u}, x1, x2, x3;
        if (t0 > 0) x0 = *(const u32x4*)(yp - D);
        x1 = *(const u32x4*)(yp); x2 = *(const u32x4*)(yp + D); x3 = *(const u32x4*)(yp + 2 * D);
#pragma unroll
        for (int i = 0; i < 16; ++i) {
            u32x4 xn = (u32x4){0u, 0u, 0u, 0u};
            if (i < 15 && t0 + i + 3 < T) xn = *(const u32x4*)(yp + (size_t)(i + 3) * D);
            float a[8];
#pragma unroll
            for (int e = 0; e < 8; ++e) a[e] = bb[e];
            const u32x4 xs[4] = {x0, x1, x2, x3};
#pragma unroll
            for (int j = 0; j < 4; ++j) { const u32x4 x = xs[j];
                a[0] += w[j][0] * bf_lo(x.x); a[1] += w[j][1] * bf_hi(x.x); a[2] += w[j][2] * bf_lo(x.y); a[3] += w[j][3] * bf_hi(x.y);
                a[4] += w[j][4] * bf_lo(x.z); a[5] += w[j][5] * bf_hi(x.z); a[6] += w[j][6] * bf_lo(x.w); a[7] += w[j][7] * bf_hi(x.w); }
            u32x4 o; o.x = cvt_pk_bf16(a[0], a[1]); o.y = cvt_pk_bf16(a[2], a[3]); o.z = cvt_pk_bf16(a[4], a[5]); o.w = cvt_pk_bf16(a[6], a[7]);
            *(u32x4*)(xc + (size_t)(R0 + i) * D + c0) = o;
            x0 = x1; x1 = x2; x2 = x3; x3 = xn;
        }
    }
}

template <int N, bool REV> DI void rg_ld(const bf16_t* p, size_t base, int t0, unsigned (&w)[8]) {
#pragma unroll
    for (int i = 0; i < 8; ++i) if (i < N) w[i] = *(const unsigned*)(p + base + (size_t)(REV ? t0 - i : t0 + i) * D);
}
DI void rg_scan_phase(Frame& F, const bf16_t* laf, const bf16_t* uf, const bf16_t* lab, bf16_t* ub, const bf16_t* ygate) {
    int tid_ = F.wave * 64 + lane_id(); asm volatile("" : "+v"(tid_));
    const int tid = tid_, lane = tid & 63, wave = __builtin_amdgcn_readfirstlane(tid >> 6), seg = 2 * wave + (lane >> 5), l32 = lane & 31;
    LAS float* AGG = (LAS float*)F.lds;
    LAS float* CB = AGG + 2 * 16 * 256;
    int items[3]; int ni = 0;
    if (F.G == 256) { if (F.bid < 128) { items[0] = F.bid; items[1] = 128 + F.bid; items[2] = 0; ni = 2; } else { const int b0 = 256 + 3 * (F.bid - 128); items[0] = b0; items[1] = b0 + 1; items[2] = b0 + 2; ni = 3; } }
    for (int ii = 0; ; ++ii) {
        int id;
        if (F.G == 256) { if (ii >= ni) break; id = ii == 0 ? items[0] : (ii == 1 ? items[1] : items[2]); } else { id = F.bid + ii * F.G; if (id >= 640) break; }
        const int b = id < 128 ? NPROMPT + (id >> 5) : ((id - 128) >> 5), cg = id & 31;
        const int T = seq_len(b), SL = T >> 4, NC = T >> 7, nb = NC >> 4;
        const size_t base = (size_t)seq_off(b) * D + cg * 64 + l32 * 2;
        {
            const int s1 = seg * SL + SL - 1;
            float slb0 = 0.f, slb1 = 0.f, hb0 = 0.f, hb1 = 0.f, r1s0 = 0.f, r1s1 = 0.f, r1h0 = 0.f, r1h1 = 0.f, r2s0 = 0.f, r2s1 = 0.f, r2h0 = 0.f, r2h1 = 0.f;
            const int w1 = seg, w2 = 128 + seg;
            unsigned lb[8], ub_[8], lr[8], ur[8];
            rg_ld<1, true>(lab, base, s1 - (SL - 1), lr); rg_ld<1, true>(ub, base, s1 - (SL - 1), ur);
            rg_ld<8, true>(lab, base, s1, lb); rg_ld<8, true>(ub, base, s1, ub_);
            for (int i0 = 0; i0 + 8 <= SL; i0 += 8) {
                unsigned lbn[8], ubn[8];
#pragma unroll
                for (int i = 0; i < 8; ++i) { lbn[i] = 0u; ubn[i] = 0u; }
                if (i0 + 16 <= SL) { rg_ld<8, true>(lab, base, s1 - i0 - 8, lbn); rg_ld<8, true>(ub, base, s1 - i0 - 8, ubn); }
#pragma unroll
                for (int i = 0; i < 8; ++i) { const float c0 = bf_lo(lb[i]), c1 = bf_hi(lb[i]); slb0 += c0; slb1 += c1; hb0 = __expf(c0) * hb0 + bf_lo(ub_[i]); hb1 = __expf(c1) * hb1 + bf_hi(ub_[i]);
                    const bool q1 = (i0 + i == w1), q2 = (i0 + i == w2);
                    r1s0 = q1 ? slb0 : r1s0; r1s1 = q1 ? slb1 : r1s1; r1h0 = q1 ? hb0 : r1h0; r1h1 = q1 ? hb1 : r1h1;
                    r2s0 = q2 ? slb0 : r2s0; r2s1 = q2 ? slb1 : r2s1; r2h0 = q2 ? hb0 : r2h0; r2h1 = q2 ? hb1 : r2h1; }
#pragma unroll
                for (int i = 0; i < 8; ++i) { lb[i] = lbn[i]; ub_[i] = ubn[i]; }
            }
            { const float c0 = bf_lo(lr[0]), c1 = bf_hi(lr[0]); slb0 += c0; slb1 += c1; hb0 = __expf(c0) * hb0 + bf_lo(ur[0]); hb1 = __expf(c1) * hb1 + bf_hi(ur[0]);
                const bool q1 = (SL - 1 == w1), q2 = (SL - 1 == w2);
                r1s0 = q1 ? slb0 : r1s0; r1s1 = q1 ? slb1 : r1s1; r1h0 = q1 ? hb0 : r1h0; r1h1 = q1 ? hb1 : r1h1;
                r2s0 = q2 ? slb0 : r2s0; r2s1 = q2 ? slb1 : r2s1; r2h0 = q2 ? hb0 : r2h0; r2h1 = q2 ? hb1 : r2h1; }
            __syncthreads();
            { LAS float* a = AGG + seg * 256 + 2 * l32; *(LAS f32x2*)(a) = (f32x2){slb0, slb1}; *(LAS f32x2*)(a + 64) = (f32x2){hb0, hb1}; }
            __syncthreads();
            float cb0 = 0.f, cb1 = 0.f;
            for (int v = 15; v > seg; --v) { const LAS float* a = AGG + v * 256 + 2 * l32; const f32x2 sl = *(const LAS f32x2*)(a), hh = *(const LAS f32x2*)(a + 64); cb0 = hh[0] + __expf(sl[0]) * cb0; cb1 = hh[1] + __expf(sl[1]) * cb1; }
            *(LAS f32x2*)(CB + (nb * seg + nb) * 64 + 2 * l32) = (f32x2){r1h0 + __expf(r1s0) * cb0, r1h1 + __expf(r1s1) * cb1};
            if (nb == 2) *(LAS f32x2*)(CB + (nb * seg + nb - 1) * 64 + 2 * l32) = (f32x2){r2h0 + __expf(r2s0) * cb0, r2h1 + __expf(r2s1) * cb1};
            __syncthreads();
        }
        float CF0 = 0.f, CF1 = 0.f;
        unsigned A_lf[8], A_uf[8], A_lb[8], A_ub[8], A_g[8];
        { const int t0 = 8 * seg; rg_ld<8, false>(laf, base, t0, A_lf); rg_ld<8, false>(uf, base, t0, A_uf); rg_ld<8, false>(lab, base, t0, A_lb); rg_ld<8, false>(ub, base, t0, A_ub); rg_ld<8, false>(ygate, base, t0, A_g); }
        for (int c = 0; c <= NC; ++c) {
            const bool tail = (c == NC);
            const int tb = 128 * c + (tail ? seg : 8 * seg);
            unsigned B_lf[8], B_uf[8], B_lb[8], B_ub[8], B_g[8];
#pragma unroll
            for (int i = 0; i < 8; ++i) { B_lf[i] = 0u; B_uf[i] = 0u; B_lb[i] = 0u; B_ub[i] = 0u; B_g[i] = 0u; }
            if (c + 1 < NC) { const int t0 = 128 * (c + 1) + 8 * seg; rg_ld<8, false>(laf, base, t0, B_lf); rg_ld<8, false>(uf, base, t0, B_uf); rg_ld<8, false>(lab, base, t0, B_lb); rg_ld<8, false>(ub, base, t0, B_ub); rg_ld<8, false>(ygate, base, t0, B_g); }
            else if (c + 1 == NC) { const int t0 = 128 * NC + seg; rg_ld<1, false>(laf, base, t0, B_lf); rg_ld<1, false>(uf, base, t0, B_uf); rg_ld<1, false>(lab, base, t0, B_lb); rg_ld<1, false>(ub, base, t0, B_ub); rg_ld<1, false>(ygate, base, t0, B_g); }
            float af0[8], af1[8], ab0[8], ab1[8];
            float slf0 = 0.f, slf1 = 0.f, hf0 = 0.f, hf1 = 0.f, slb0 = 0.f, slb1 = 0.f, hb0 = 0.f, hb1 = 0.f;
#pragma unroll
            for (int i = 0; i < 8; ++i) { const float a0 = bf_lo(A_lf[i]), a1 = bf_hi(A_lf[i]); slf0 += a0; slf1 += a1; af0[i] = __expf(a0); af1[i] = __expf(a1); hf0 = af0[i] * hf0 + bf_lo(A_uf[i]); hf1 = af1[i] * hf1 + bf_hi(A_uf[i]); }
#pragma unroll
            for (int i = 7; i >= 0; --i) { const float c0 = bf_lo(A_lb[i]), c1 = bf_hi(A_lb[i]); slb0 += c0; slb1 += c1; ab0[i] = __expf(c0); ab1[i] = __expf(c1); hb0 = ab0[i] * hb0 + bf_lo(A_ub[i]); hb1 = ab1[i] * hb1 + bf_hi(A_ub[i]); }
            LAS float* ag = AGG + (c & 1) * 4096;
            { LAS float* a = ag + seg * 256 + 2 * l32; *(LAS f32x2*)(a) = (f32x2){slf0, slf1}; *(LAS f32x2*)(a + 64) = (f32x2){hf0, hf1}; *(LAS f32x2*)(a + 128) = (f32x2){slb0, slb1}; *(LAS f32x2*)(a + 192) = (f32x2){hb0, hb1}; }
            __syncthreads();
            float cf0 = CF0, cf1 = CF1;
            for (int v = 0; v < seg; ++v) { const LAS float* a = ag + v * 256 + 2 * l32; const f32x2 sl = *(const LAS f32x2*)(a), hh = *(const LAS f32x2*)(a + 64); cf0 = hh[0] + __expf(sl[0]) * cf0; cf1 = hh[1] + __expf(sl[1]) * cf1; }
            { float e0 = cf0, e1 = cf1;
                for (int v = seg; v < 16; ++v) { const LAS float* a = ag + v * 256 + 2 * l32; const f32x2 sl = *(const LAS f32x2*)(a), hh = *(const LAS f32x2*)(a + 64); e0 = hh[0] + __expf(sl[0]) * e0; e1 = hh[1] + __expf(sl[1]) * e1; }
                CF0 = e0; CF1 = e1; }
            float cb0 = 0.f, cb1 = 0.f;
            if (!tail) { const f32x2 r = *(const LAS f32x2*)(CB + (c + 1) * 64 + 2 * l32); cb0 = r[0]; cb1 = r[1]; }
            for (int v = 15; v > seg; --v) { const LAS float* a = ag + v * 256 + 2 * l32; const f32x2 sl = *(const LAS f32x2*)(a + 128), hh = *(const LAS f32x2*)(a + 192); cb0 = hh[0] + __expf(sl[0]) * cb0; cb1 = hh[1] + __expf(sl[1]) * cb1; }
            float f0[8], f1[8];
#pragma unroll
            for (int i = 0; i < 8; ++i) { cf0 = af0[i] * cf0 + bf_lo(A_uf[i]); cf1 = af1[i] * cf1 + bf_hi(A_uf[i]); f0[i] = cf0; f1[i] = cf1; }
#pragma unroll
            for (int i = 7; i >= 0; --i) { cb0 = ab0[i] * cb0 + bf_lo(A_ub[i]); cb1 = ab1[i] * cb1 + bf_hi(A_ub[i]);
                f0[i] = bf_lo(A_g[i]) * (f0[i] + cb0); f1[i] = bf_hi(A_g[i]) * (f1[i] + cb1); }
            if (!tail) {
#pragma unroll
                for (int i = 0; i < 8; ++i) *(unsigned*)(ub + base + (size_t)(tb + i) * D) = cvt_pk_bf16(f0[i], f1[i]);
            } else *(unsigned*)(ub + base + (size_t)tb * D) = cvt_pk_bf16(f0[0], f1[0]);
#pragma unroll
            for (int i = 0; i < 8; ++i) { A_lf[i] = B_lf[i]; A_uf[i] = B_uf[i]; A_lb[i] = B_lb[i]; A_ub[i] = B_ub[i]; A_g[i] = B_g[i]; }
        }
    }
}
constexpr int NA_VPITCH = 144;
constexpr int NA_WAVE_LDS = 32 * NA_VPITCH * 2 + 2048;
DI void na_attn_phase(Frame& F, const bf16_t* qkv, bf16_t* O, const float* rpb, const float* mbias) {
    int tid_ = F.wave * 64 + lane_id(); asm volatile("" : "+v"(tid_));
    const int lane = tid_ & 63, l15 = lane & 15, quad = lane >> 4;
    LAS unsigned char* wl = F.lds + F.wave * NA_WAVE_LDS;
    LAS bf16_t* vt = (LAS bf16_t*)wl;
    LAS float* rp = (LAS float*)(wl + 32 * NA_VPITCH * 2);
    int cached_h = -1;
    const float scale = 0.08838834764831845f;
    const int NITEMS = MTOK;
    for (int id = F.bid * 8 + F.wave; id < NITEMS; id += F.G * 8) {
        int b, h, it, rows;
        if (id < MPROMPT) { const int bh = id / 129; it = id - bh * 129; b = bh >> 4; h = bh & 15; rows = 32; }
        else { const int i2 = id - MPROMPT; const int bh = i2 / 257; it = i2 - bh * 257; b = NPROMPT + (bh >> 4); h = bh & 15; rows = 64; }
        const bool is_meta = (it == rows * 4);
        const int r = it >> 2, n = it & 3;
        const int so = seq_off(b);
        if (h != cached_h) {
            __builtin_amdgcn_wave_barrier();
            for (int i = lane; i < 465; i += 64) rp[i] = rpb[h * 465 + i];
            if (lane < 16) rp[480 + lane] = mbias[h * 16 + lane];
            cached_h = h; LDS_WAIT(); __builtin_amdgcn_wave_barrier(); asm volatile("" ::: "memory");
        }
        int rs = r - 4; rs = rs < 0 ? 0 : (rs > rows - 8 ? rows - 8 : rs);
        int ks = 16 * n - 8; ks = ks < 0 ? 0 : (ks > 32 ? 32 : ks);
        const int qrow = is_meta ? so + l15 : so + NMETA + 64 * r + 16 * n + l15;
        const int qcol = 16 * n + l15; int cs = qcol - 8; cs = cs < 0 ? 0 : (cs > 48 ? 48 : cs);
        bf16x8 qf[4];
#pragma unroll
        for (int s = 0; s < 4; ++s) qf[s] = *(const bf16x8*)(qkv + (size_t)qrow * 6144 + h * 128 + 32 * s + 8 * quad);
        f32x4 sv[17];
#pragma unroll
        for (int kb = 0; kb < 17; ++kb) sv[kb] = (f32x4){-1e30f, -1e30f, -1e30f, -1e30f};
        if (!is_meta) {
#pragma unroll
            for (int kb0 = 0; kb0 < 16; kb0 += 8) {
                bf16x8 kf[8][4];
#pragma unroll
                for (int i = 0; i < 8; ++i) { const int kb = kb0 + i, kr = kb >> 1; const int krow = so + NMETA + 64 * (rs + kr) + ks + 16 * (kb & 1) + l15;
#pragma unroll
                    for (int s = 0; s < 4; ++s) kf[i][s] = *(const bf16x8*)(qkv + (size_t)krow * 6144 + 2048 + h * 128 + 32 * s + 8 * quad); }
#pragma unroll
                for (int i = 0; i < 8; ++i) { const int kb = kb0 + i, kr = kb >> 1;
                    f32x4 st = (f32x4){0.f, 0.f, 0.f, 0.f};
#pragma unroll
                    for (int s = 0; s < 4; ++s) st = __builtin_amdgcn_mfma_f32_16x16x32_bf16(kf[i][s], qf[s], st, 0, 0, 0);
                    const int roff = (rs + kr) - r + 7;
#pragma unroll
                    for (int g = 0; g < 4; ++g) { const int keycol = ks + 16 * (kb & 1) + 4 * quad + g; const bool valid = (keycol >= cs) && (keycol < cs + 16);
                        int coff = keycol - qcol; coff = coff < -15 ? -15 : (coff > 15 ? 15 : coff);
                        sv[kb][g] = valid ? st[g] * scale + rp[roff * 31 + coff + 15] : -1e30f; }
                }
            }
        }
        {
            const int krow = so + l15;
            f32x4 st = (f32x4){0.f, 0.f, 0.f, 0.f};
#pragma unroll
            for (int s = 0; s < 4; ++s) { const bf16x8 kf = *(const bf16x8*)(qkv + (size_t)krow * 6144 + 2048 + h * 128 + 32 * s + 8 * quad);
                st = __builtin_amdgcn_mfma_f32_16x16x32_bf16(kf, qf[s], st, 0, 0, 0); }
#pragma unroll
            for (int g = 0; g < 4; ++g) sv[16][g] = st[g] * scale + rp[480 + 4 * quad + g];
        }
#define NA_LDV(B_, KR_) do { _Pragma("unroll") for (int i = 0; i < 8; ++i) { const int cid = i * 64 + lane, vr = cid >> 4, c16 = cid & 15; B_[i] = (u32x4){0u, 0u, 0u, 0u}; \
            if ((KR_) < 8) B_[i] = *(const u32x4*)(qkv + (size_t)(so + NMETA + 64 * (rs + (KR_)) + ks + vr) * 6144 + 4096 + h * 128 + 8 * c16); \
            else if ((KR_) == 8 && vr < 16) B_[i] = *(const u32x4*)(qkv + (size_t)(so + vr) * 6144 + 4096 + h * 128 + 8 * c16); } } while (0)
        u32x4 vb[3][8];
        if (!is_meta) { NA_LDV(vb[0], 0); NA_LDV(vb[1], 1); NA_LDV(vb[2], 2); }
        else { NA_LDV(vb[2], 8);
#pragma unroll
            for (int i = 0; i < 8; ++i) { vb[0][i] = (u32x4){0u, 0u, 0u, 0u}; vb[1][i] = vb[0][i]; } }
        float mx = -1e30f;
#pragma unroll
        for (int kb = 0; kb < 17; ++kb)
#pragma unroll
            for (int g = 0; g < 4; ++g) mx = fmaxf(mx, sv[kb][g]);
        mx = fmaxf(mx, __shfl_xor(mx, 16)); mx = fmaxf(mx, __shfl_xor(mx, 32));
        float sum = 0.f;
#pragma unroll
        for (int kb = 0; kb < 17; ++kb)
#pragma unroll
            for (int g = 0; g < 4; ++g) { const float p = __expf(sv[kb][g] - mx); sv[kb][g] = p; sum += p; }
        sum += __shfl_xor(sum, 16); sum += __shfl_xor(sum, 32);
        const float inv = 1.0f / sum;
        f32x4 ot[8];
#pragma unroll
        for (int d = 0; d < 8; ++d) ot[d] = (f32x4){0.f, 0.f, 0.f, 0.f};
#pragma unroll
        for (int kr = 0; kr < 9; ++kr) {
            if (!(is_meta && kr < 8)) {
            __builtin_amdgcn_wave_barrier(); asm volatile("" ::: "memory");
#pragma unroll
            for (int i = 0; i < 8; ++i) { const int cid = i * 64 + lane, vr = cid >> 4, c16 = cid & 15; *(LAS u32x4*)(vt + vr * NA_VPITCH + 8 * c16) = vb[kr % 3][i]; }
            LDS_WAIT(); __builtin_amdgcn_wave_barrier(); asm volatile("" ::: "memory");
            if (!is_meta && kr + 3 <= 8) NA_LDV(vb[kr % 3], kr + 3);
            f32x4 p0, p1;
            if (kr < 8) { p0 = sv[2 * kr]; p1 = sv[2 * kr + 1]; } else { p0 = sv[16]; p1 = (f32x4){0.f, 0.f, 0.f, 0.f}; }
            u32x4 pw; pw.x = cvt_pk_bf16(p0[0] * inv, p0[1] * inv); pw.y = cvt_pk_bf16(p0[2] * inv, p0[3] * inv); pw.z = cvt_pk_bf16(p1[0] * inv, p1[1] * inv); pw.w = cvt_pk_bf16(p1[2] * inv, p1[3] * inv);
            const bf16x8 pf = __builtin_bit_cast(bf16x8, pw);
            const LAS bf16_t* tb = vt + (4 * quad + (l15 >> 2)) * NA_VPITCH + 4 * (l15 & 3);
#pragma unroll
            for (int d = 0; d < 8; ++d) {
                const s16x4 lo = __builtin_amdgcn_ds_read_tr16_b64_v4i16((LAS s16x4*)(tb + 16 * d)), hi = __builtin_amdgcn_ds_read_tr16_b64_v4i16((LAS s16x4*)(tb + 16 * NA_VPITCH + 16 * d));
                const bf16x8 vf = (bf16x8){lo[0], lo[1], lo[2], lo[3], hi[0], hi[1], hi[2], hi[3]};
                ot[d] = __builtin_amdgcn_mfma_f32_16x16x32_bf16(vf, pf, ot[d], 0, 0, 0);
            }
            }
        }
#pragma unroll
        for (int d = 0; d < 8; ++d) { u32x2 w; w.x = cvt_pk_bf16(ot[d][0], ot[d][1]); w.y = cvt_pk_bf16(ot[d][2], ot[d][3]);
            *(u32x2*)(O + (size_t)qrow * D + h * 128 + 16 * d + 4 * quad) = w; }
    }
}
constexpr int GD_QS = 0, GD_KS = 17408, GD_VS = 34816, GD_ABF = 52224, GD_ADG = 61440, GD_TIB = 66560, GD_KST = 68608, GD_QKM = 87040, GD_WB = 96256, GD_VEC = 113664, GD_CW = 114944, GD_END = 121088;
constexpr int GD_O = 114944;
constexpr int P_QS = 136, P_KST = 72, P_ADG = 20, P_O = 132;
typedef short bf16x4 __attribute__((ext_vector_type(4)));

DI void gdn_conv_phase(Frame& F, int half, bf16_t* qkvp, const bf16_t* halo, const float* conv_w) {
    int tid_ = F.wave * 64 + lane_id(); asm volatile("" : "+v"(tid_));
    const int tid = tid_, piece = tid & 63, tg = tid >> 6;
    constexpr int NIT = (MTOK / 64) * 8;
    for (int item = F.bid; item < NIT; item += F.G) {
        const bool ivld = true;
        const int rb = item >> 3, cs = item & 7, col = cs * 512 + piece * 8;
        const int X = col < 1024 ? 0 : (col < 2048 ? 1 : 2);
        const int wcol = X == 0 ? half * 1024 + col : (X == 1 ? 2048 + half * 1024 + (col - 1024) : 4096 + half * 2048 + (col - 2048));
        const int r0 = 64 * rb + 8 * tg; int b, t0; row_bt(r0, b, t0); const int T = seq_len(b);
        u32x4 xr[11];
#pragma unroll
        for (int r = 0; r < 11; ++r) { const int tt = t0 - 1 + r, w = r0 - 1 + r; xr[r] = (u32x4){0u, 0u, 0u, 0u};
            if (ivld && tt >= 0 && tt < T) { const bf16_t* p;
                if (w < 64 * rb) p = halo + ((size_t)rb * 3 + 0) * 4096 + col; else if (w >= 64 * rb + 64) p = halo + ((size_t)rb * 3 + 1 + (w - 64 * rb - 64)) * 4096 + col; else p = qkvp + (size_t)w * 4096 + col;
                xr[r] = *(const u32x4*)p; } }
        f32x4 wlo[4], whi[4];
#pragma unroll
        for (int j = 0; j < 4; ++j) { wlo[j] = *(const f32x4*)(conv_w + j * 8192 + wcol); whi[j] = *(const f32x4*)(conv_w + j * 8192 + wcol + 4); }
        u32x4 res[8];
#pragma unroll
        for (int ro = 0; ro < 8; ++ro) {
            float a[8];
#pragma unroll
            for (int e = 0; e < 8; ++e) a[e] = 0.f;
#pragma unroll
            for (int j = 0; j < 4; ++j) { const u32x4 x = xr[ro + j];
                a[0] += wlo[j][0] * bf_lo(x.x); a[1] += wlo[j][1] * bf_hi(x.x); a[2] += wlo[j][2] * bf_lo(x.y); a[3] += wlo[j][3] * bf_hi(x.y);
                a[4] += whi[j][0] * bf_lo(x.z); a[5] += whi[j][1] * bf_hi(x.z); a[6] += whi[j][2] * bf_lo(x.w); a[7] += whi[j][3] * bf_hi(x.w); }
            float ss = 0.f;
#pragma unroll
            for (int e = 0; e < 8; ++e) { a[e] = siluf_(a[e]); ss += a[e] * a[e]; }
            ss += __shfl_xor(ss, 1); ss += __shfl_xor(ss, 2); ss += __shfl_xor(ss, 4); ss += __shfl_xor(ss, 8);
            const float sc = X == 2 ? 1.0f : (1.0f / sqrtf(ss + 1e-6f)) * (X == 0 ? 0.08838834764831845f : 1.0f);
            res[ro] = (u32x4){cvt_pk_bf16(a[0] * sc, a[1] * sc), cvt_pk_bf16(a[2] * sc, a[3] * sc), cvt_pk_bf16(a[4] * sc, a[5] * sc), cvt_pk_bf16(a[6] * sc, a[7] * sc)};
        }
        __syncthreads();
        if (ivld) {
#pragma unroll
            for (int ro = 0; ro < 8; ++ro) *(u32x4*)(qkvp + (size_t)(r0 + ro) * 4096 + col) = res[ro]; }
    }
}
DI bf16x8 frag_perm(const LAS bf16_t* rowp, int kbase, int quad) {
    const s16x4 a = *(const LAS s16x4*)(rowp + kbase + 4 * quad), b = *(const LAS s16x4*)(rowp + kbase + 16 + 4 * quad);
    bf16x8 r; r[0] = a[0]; r[1] = a[1]; r[2] = a[2]; r[3] = a[3]; r[4] = b[0]; r[5] = b[1]; r[6] = b[2]; r[7] = b[3]; return r;
}
DI bf16x8 pack_acc(const f32x4 a, const f32x4 b) { const u32x4 w = pack8(a, b); return __builtin_bit_cast(bf16x8, w); }
DI bf16x4 pack4(const f32x4 a) { u32x2 w; w.x = cvt_pk_bf16(a[0], a[1]); w.y = cvt_pk_bf16(a[2], a[3]); return __builtin_bit_cast(bf16x4, w); }
#define MFMA16(a, b, c) __builtin_amdgcn_mfma_f32_16x16x16bf16_1k((a), (b), (c), 0, 0, 0)


DI void gd_tok_ab(int n, int dir, int& A, int& sg) { sg = dir ? -1 : 1; A = n == 0 ? (dir ? 15 : -48) : NMETA + 64 * (n - 1) + (dir ? 63 : 0); }
DI int gd_tok(int n, int dir, int slot) { int A, sg; gd_tok_ab(n, dir, A, sg); return A + sg * slot; }
DI void gd_fetch(const bf16_t* qkvp, const float* bg, int so, int hl, int ql, int hv, int n, int dir, int tid, int wave, u32x4 (&pf)[6], float& gv, float& bv) {
    int A, sg; gd_tok_ab(n, dir, A, sg);
    const int pc = tid & 15, cq = ql * 128 + 8 * pc, ck = 1024 + cq, cv = 2048 + hl * 128 + 8 * pc;
#pragma unroll
    for (int h2 = 0; h2 < 2; ++h2) { const int t = A + sg * ((tid >> 4) + 32 * h2);
        pf[h2] = pf[2 + h2] = pf[4 + h2] = (u32x4){0u, 0u, 0u, 0u};
        if (t >= 0) { const bf16_t* rp = qkvp + (size_t)(so + t) * 4096; pf[h2] = *(const u32x4*)(rp + cq); pf[2 + h2] = *(const u32x4*)(rp + ck); pf[4 + h2] = *(const u32x4*)(rp + cv); } }
    gv = 0.f; bv = 0.f;
    if (wave == 0) { const int t1 = A + sg * (tid & 63); if (t1 >= 0) { const float* p = bg + (size_t)(so + t1) * 128 + dir * 32 + hv; bv = p[0]; gv = p[64]; } }
}
#define GD_BAR() asm volatile("s_waitcnt lgkmcnt(0)\n\ts_barrier" ::: "memory")
#define GD_IDS() int tq_ = tid0; asm volatile("" : "+v"(tq_)); const int tid = tq_, lane = tid & 63, l15 = lane & 15, quad = lane >> 4, tau = tid >> 3, sub = tid & 7; (void)l15; (void)quad; (void)tau; (void)sub; (void)lane;
constexpr int GD_OB_SPLIT = 48640;
DI bf16_t* gd_ob_row(bf16_t* obA, bf16_t* obB, int R) { return R < GD_OB_SPLIT ? obA + (size_t)R * D : obB + (size_t)(R - GD_OB_SPLIT) * D; }
DI void gdn_core_phase(Frame& F, int half, const bf16_t* qkvp, const float* bg, bf16_t* og, bf16_t* obA, bf16_t* obB) {
    int tid_ = F.wave * 64 + lane_id(); asm volatile("" : "+v"(tid_));
    const int tid0 = tid_, wave = __builtin_amdgcn_readfirstlane(tid0 >> 6);
    LAS unsigned char* L = F.lds;
    LAS bf16_t* QS = (LAS bf16_t*)(L + GD_QS); LAS bf16_t* KS = (LAS bf16_t*)(L + GD_KS); LAS bf16_t* VS = (LAS bf16_t*)(L + GD_VS);
    LAS bf16_t* ABF = (LAS bf16_t*)(L + GD_ABF); LAS float* ADG = (LAS float*)(L + GD_ADG); LAS bf16_t* TIB = (LAS bf16_t*)(L + GD_TIB);
    LAS bf16_t* KST = (LAS bf16_t*)(L + GD_KST); LAS bf16_t* QKM = (LAS bf16_t*)(L + GD_QKM);
    LAS bf16_t* WB = (LAS bf16_t*)(L + GD_WB); LAS float* OL = (LAS float*)(L + GD_O);
    LAS float* GC = (LAS float*)(L + GD_VEC); LAS float* BETA = GC + 64; LAS float* EG = GC + 128; LAS float* EKL = GC + 192; LAS float* GL = GC + 256;
    for (int ii = 0; ; ++ii) {
        int id;
        if (F.G == 256) { if (F.bid < 128) { if (ii >= 2) break; id = ii == 0 ? F.bid : 128 + F.bid; } else { if (ii >= 3) break; id = 256 + 3 * (F.bid - 128) + ii; } }
        else { id = F.bid + ii * F.G; if (id >= NSEQ * 32) break; }
        const int s_ = id < 128 ? id : id - 128;
        const int b = id < 128 ? NPROMPT + (s_ >> 5) : (s_ >> 5), hl = (s_ >> 1) & 15, dir = s_ & 1, hv = half * 16 + hl, ql = hl >> 1;
        const int so = seq_off(b), T = seq_len(b), NC = 1 + (T - NMETA) / 64;
        __syncthreads();
        {
            f32x4 Sacc[8];
#pragma unroll
            for (int i = 0; i < 8; ++i) Sacc[i] = (f32x4){0.f, 0.f, 0.f, 0.f};
            u32x4 pf[6]; float pgv, pbv;
            gd_fetch(qkvp, bg, so, hl, ql, hv, dir ? NC - 1 : 0, dir, tid0, wave, pf, pgv, pbv);
#define GD_S5() do { if (tprev >= 0) { GD_IDS(); f32x4 o[4]; _Pragma("unroll") for (int i = 0; i < 4; ++i) o[i] = *(const LAS f32x4*)(OL + tau * P_O + 16 * sub + 4 * i); \
                *(u32x4*)(gpprev) = pack8(o[0], o[1]); *(u32x4*)(gpprev + 8) = pack8(o[2], o[3]); } } while (0)
            int tprev = -1; bf16_t* gpprev = og;
            for (int step = 0; step < NC; ++step) {
                const int n = dir ? NC - 1 - step : step;
                int t, R; float gv = 0.f, bv = 0.f; bf16_t* gp;
                GD_S5();
                { GD_IDS();
                t = gd_tok(n, dir, tau);
                R = so + (t < 0 ? 0 : t);
#pragma unroll
                for (int i = 0; i < 6; ++i) { const int X = i >> 1, slot = (tid >> 4) + 32 * (i & 1), pc = tid & 15;
                    LAS bf16_t* dst = (X == 0 ? QS : (X == 1 ? KS : VS)) + slot * P_QS + 8 * pc;
                    *(LAS u32x4*)(dst) = pf[i];
                    if (X == 1) { const unsigned w4[4] = {pf[i].x, pf[i].y, pf[i].z, pf[i].w};
#pragma unroll
                        for (int e = 0; e < 8; ++e) KST[(8 * pc + e) * P_KST + slot] = (bf16_t)((e & 1) ? (w4[e >> 1] >> 16) : (w4[e >> 1] & 0xffffu)); } }
                gv = pgv; bv = pbv;
                if (step + 1 < NC) gd_fetch(qkvp, bg, so, hl, ql, hv, dir ? NC - 2 - step : step + 1, dir, tid, wave, pf, pgv, pbv);
                gp = (dir ? gd_ob_row(obA, obB, R) : og + (size_t)R * D) + hl * 128 + 16 * sub;
                }
                if (wave == 0) { GD_IDS();
                    float c = gv;
#pragma unroll
                    for (int o = 1; o < 64; o <<= 1) { const float y = __shfl_up(c, o); if (lane >= o) c += y; }
                    const float gl = __shfl(c, 63);
                    GC[lane] = c; BETA[lane] = bv; EG[lane] = __expf(c); EKL[lane] = __expf(gl - c); if (lane == 0) GL[0] = __expf(gl);
                }
                GD_BAR();
                { GD_IDS();
                    const int cb = wave >> 1;
                    bf16x8 ka[4], qa[4];
#pragma unroll
                    for (int ks = 0; ks < 4; ++ks) { ka[ks] = *(const LAS bf16x8*)(KS + (16 * cb + l15) * P_QS + 32 * ks + 8 * quad); qa[ks] = *(const LAS bf16x8*)(QS + (16 * cb + l15) * P_QS + 32 * ks + 8 * quad); }
                    const f32x4 gcc = *(const LAS f32x4*)(GC + 16 * cb + 4 * quad), btc = *(const LAS f32x4*)(BETA + 16 * cb + 4 * quad);
#pragma unroll
                    for (int s2 = 0; s2 < 2; ++s2) { const int sb = 2 * (wave & 1) + s2;
                        f32x4 kk = (f32x4){0.f, 0.f, 0.f, 0.f}, qk = kk;
#pragma unroll
                        for (int ks = 0; ks < 4; ++ks) { const bf16x8 kb = *(const LAS bf16x8*)(KS + (16 * sb + l15) * P_QS + 32 * ks + 8 * quad);
                            kk = __builtin_amdgcn_mfma_f32_16x16x32_bf16(ka[ks], kb, kk, 0, 0, 0); qk = __builtin_amdgcn_mfma_f32_16x16x32_bf16(qa[ks], kb, qk, 0, 0, 0); }
                        const int s = 16 * sb + l15; const float gcs = GC[s];
#pragma unroll
                        for (int g = 0; g < 4; ++g) { const int c = 16 * cb + 4 * quad + g;
                            const float dec = (s <= c) ? __expf(fminf(gcc[g] - gcs, 0.f)) : 0.f;
                            const float av = (s < c) ? btc[g] * kk[g] * dec : 0.f;
                            QKM[c * P_KST + s] = f2bf(qk[g] * dec);
                            ABF[c * P_KST + s] = f2bf(av);
                            if (sb == cb) ADG[(cb * 16 + 4 * quad + g) * P_ADG + l15] = av; }
                    }
                }
                GD_BAR();
                if (wave == 0) { GD_IDS();
                    float tcol[16];
#pragma unroll
                    for (int r = 0; r < 16; ++r) { float acc = (r == l15) ? 1.f : 0.f;
                        const LAS float* lr = ADG + (quad * 16 + r) * P_ADG;
#pragma unroll
                        for (int s4 = 0; s4 < (r + 3) / 4; ++s4) { const f32x4 lv = *(const LAS f32x4*)(lr + 4 * s4);
#pragma unroll
                            for (int e = 0; e < 4; ++e) if (4 * s4 + e < r) acc -= lv[e] * tcol[4 * s4 + e]; }
                        tcol[r] = acc; TIB[(quad * 16 + r) * 16 + l15] = f2bf(acc); }
                }
                f32x4 ru[4], rw[4];
                { GD_IDS();
#pragma unroll
                for (int k = 0; k < 4; ++k) { const f32x4 bt = *(const LAS f32x4*)(BETA + 16 * k + 4 * quad), eg = *(const LAS f32x4*)(EG + 16 * k + 4 * quad);
#pragma unroll
                    for (int g = 0; g < 4; ++g) { const int c = 16 * k + 4 * quad + g;
                        ru[k][g] = bf2f(VS[c * P_QS + 16 * wave + l15]) * bt[g]; rw[k][g] = bf2f(KS[c * P_QS + 16 * wave + l15]) * (bt[g] * eg[g]); } } }
                GD_BAR();
                f32x4 uu[4];
                { GD_IDS();
                    bf16x4 xu[4], xw[4];
#pragma unroll
                    for (int k = 0; k < 4; ++k) {
                        f32x4 su = (f32x4){0.f, 0.f, 0.f, 0.f}, sw = su;
#pragma unroll
                        for (int j = 0; j < 4; ++j) if (j < k) { const bf16x4 af = *(const LAS bf16x4*)(ABF + (16 * k + l15) * P_KST + 16 * j + 4 * quad);
                            su = MFMA16(af, xu[j], su); sw = MFMA16(af, xw[j], sw); }
                        const bf16x4 tf = *(const LAS bf16x4*)(TIB + (k * 16 + l15) * 16 + 4 * quad);
                        const f32x4 z4 = (f32x4){0.f, 0.f, 0.f, 0.f};
                        const f32x4 xuk = MFMA16(tf, pack4(ru[k] - su), z4), xwk = MFMA16(tf, pack4(rw[k] - sw), z4);
                        uu[k] = xuk; xu[k] = pack4(xuk); xw[k] = pack4(xwk);
#pragma unroll
                        for (int g = 0; g < 4; ++g) WB[(16 * k + 4 * quad + g) * P_QS + 16 * wave + l15] = f2bf(xwk[g]);
                    }
                }
                GD_BAR();
                { GD_IDS();
                    bf16x8 Sb[4];
#pragma unroll
                    for (int ks = 0; ks < 4; ++ks) Sb[ks] = pack_acc(Sacc[2 * ks], Sacc[2 * ks + 1]);
                    f32x4 vn[4], oo[4];
#pragma unroll
                    for (int cb = 0; cb < 4; ++cb) {
                        f32x4 ws = (f32x4){0.f, 0.f, 0.f, 0.f}, qs = ws;
#pragma unroll
                        for (int ks = 0; ks < 4; ++ks) { ws = __builtin_amdgcn_mfma_f32_16x16x32_bf16(frag_perm(WB + (16 * cb + l15) * P_QS, 32 * ks, quad), Sb[ks], ws, 0, 0, 0);
                            qs = __builtin_amdgcn_mfma_f32_16x16x32_bf16(frag_perm(QS + (16 * cb + l15) * P_QS, 32 * ks, quad), Sb[ks], qs, 0, 0, 0); }
                        const f32x4 egc = *(const LAS f32x4*)(EG + 16 * cb + 4 * quad);
                        vn[cb] = uu[cb] - ws; oo[cb] = egc * qs;
                    }
                    bf16x8 vb[2];
#pragma unroll
                    for (int kc = 0; kc < 2; ++kc) vb[kc] = pack_acc(vn[2 * kc], vn[2 * kc + 1]);
#pragma unroll
                    for (int cb = 0; cb < 4; ++cb) {
#pragma unroll
                        for (int kc = 0; kc < 2; ++kc) oo[cb] = __builtin_amdgcn_mfma_f32_16x16x32_bf16(frag_perm(QKM + (16 * cb + l15) * P_KST, 32 * kc, quad), vb[kc], oo[cb], 0, 0, 0);
#pragma unroll
                        for (int g = 0; g < 4; ++g) OL[(16 * cb + 4 * quad + g) * P_O + 16 * wave + l15] = oo[cb][g];
                        const f32x4 ek = *(const LAS f32x4*)(EKL + 16 * cb + 4 * quad);
                        vn[cb] = vn[cb] * ek;
                    }
#pragma unroll
                    for (int kc = 0; kc < 2; ++kc) vb[kc] = pack_acc(vn[2 * kc], vn[2 * kc + 1]);
                    const float egl = GL[0];
#pragma unroll
                    for (int db = 0; db < 8; ++db) { f32x4 s = Sacc[db] * egl;
#pragma unroll
                        for (int kc = 0; kc < 2; ++kc) s = __builtin_amdgcn_mfma_f32_16x16x32_bf16(frag_perm(KST + (16 * db + l15) * P_KST, 32 * kc, quad), vb[kc], s, 0, 0, 0);
                        Sacc[db] = s; }
                }
                GD_BAR();
                tprev = t; gpprev = gp;
            }
            GD_S5();
        }
    }
}

DI void gdn_combine_phase(Frame& F, bf16_t* og, bf16_t* obA, bf16_t* obB, const bf16_t* zb, const float* norm_w) {
    const int lane = F.lane(), e0 = (lane & 15) * 8;
    f32x4 nw0 = *(const f32x4*)(norm_w + e0), nw1 = *(const f32x4*)(norm_w + e0 + 4);
    for (int R = F.bid * 8 + F.wave; R < MTOK; R += F.G * 8) {
        bf16_t* op = og + (size_t)R * D + lane * 8; const bf16_t* bp = gd_ob_row(obA, obB, R) + lane * 8; const bf16_t* zp = zb + (size_t)R * D + lane * 8;
        u32x4 f[4], g[4], z[4];
#pragma unroll
        for (int q = 0; q < 4; ++q) { f[q] = *(const u32x4*)(op + 512 * q); g[q] = *(const u32x4*)(bp + 512 * q); z[q] = *(const u32x4*)(zp + 512 * q); }
#pragma unroll
        for (int q = 0; q < 4; ++q) {
            const unsigned fw[4] = {f[q].x, f[q].y, f[q].z, f[q].w}, gw[4] = {g[q].x, g[q].y, g[q].z, g[q].w}, zw[4] = {z[q].x, z[q].y, z[q].z, z[q].w};
            float o[8], zz[8]; float ss = 0.f;
#pragma unroll
            for (int k = 0; k < 4; ++k) { o[2 * k] = bf_lo(fw[k]) + bf_lo(gw[k]); o[2 * k + 1] = bf_hi(fw[k]) + bf_hi(gw[k]); zz[2 * k] = bf_lo(zw[k]); zz[2 * k + 1] = bf_hi(zw[k]); }
#pragma unroll
            for (int e = 0; e < 8; ++e) ss += o[e] * o[e];
            ss += __shfl_xor(ss, 1); ss += __shfl_xor(ss, 2); ss += __shfl_xor(ss, 4); ss += __shfl_xor(ss, 8);
            const float rn = 1.0f / sqrtf(ss * (1.0f / 128.0f) + NORM_EPS);
            f32x4 a, b2;
#pragma unroll
            for (int k = 0; k < 4; ++k) { a[k] = o[k] * rn * nw0[k] * siluf_(zz[k]); b2[k] = o[4 + k] * rn * nw1[k] * siluf_(zz[4 + k]); }
            *(u32x4*)(op + 512 * q) = pack8(a, b2);
        }
    }
}
constexpr int N_PHASES = 38;
#ifndef ALIGN_RES
#define ALIGN_RES true
#endif
#ifndef ALIGN_CONS
#define ALIGN_CONS true
#endif
#ifndef WGM_DEF
#define WGM_DEF 4
#endif
#ifndef WGM_RES
#define WGM_RES 4
#endif
#ifndef WGM_FFU
#define WGM_FFU 4
#endif
#ifndef WGM_GATES
#define WGM_GATES 4
#endif
DI pg8::Gemm mk_gemm(const void* A, unsigned lda, const void* B, unsigned ldb, long hB, int nt) { pg8::Gemm g; g.A = (const char*)A; g.B = (const char*)B; g.lda = lda; g.ldb = ldb; g.hstepA = 128L * lda; g.hstepB = hB; g.nt = nt; return g; }
DI SchedLin mk_lin(Frame& F, int nM, int nN, long a_base, long a_tile, long b_base, long b_tile, int nt = 32, int wgm = WGM_DEF) { SchedLin s; s.o.init(nM, nN, F.G, F.bid, wgm); s.a_base = a_base; s.a_tile = a_tile; s.b_base = b_base; s.b_tile = b_tile; s.nt = nt; return s; }
DI SchedRes mk_res(Frame& F, long a_tile, long b_base, long b_tile, int nt, int wgm = WGM_RES) { SchedRes s; s.init(F.G, F.bid, a_tile, b_base, b_tile, nt, wgm); return s; }

__global__ void __launch_bounds__(512, 2) trunk_fwd(Args args) {
    extern __shared__ __attribute__((aligned(16))) unsigned char lds_raw[];
    Frame F;
    F.lds = (LAS unsigned char*)lds_raw;
    F.wave = __builtin_amdgcn_readfirstlane(threadIdx.x >> 6); F.G = gridDim.x; F.bid = blockIdx.x;
    F.in = args.in; F.out = args.out; F.ws = args.ws;
    volatile LAS unsigned* MISC = (volatile LAS unsigned*)(F.lds + MISC_OFF);
    if (F.tid() < 16) MISC[F.tid()] = 0u;
    __syncthreads();
    const int lo = args.ph_lo, hi = args.ph_hi;
    unsigned* ctl = (unsigned*)(F.ws + WS_CTL);
    XcdBarrier bar; bar.bar = ctl + CW_BAR; bar.x = 0; bar.st = nullptr;
    if (hi - lo > 1) bar = xcd_barrier_post(ctl + CW_BAR, MISC + 8, F.wave == 0 && lane_id() == 0);
#define IN(k) (lo <= (k) && (k) < hi)
#define SEAM(k) do { if (IN(k) && IN((k) + 1)) xcd_barrier(bar, F.wave == 0 && lane_id() == 0); } while (0)
#ifndef REP_MASK
#define REP_MASK 0ull
#endif
#define PHASE(k, ...) if (IN(k)) { if constexpr (((REP_MASK) >> (k)) & 1ull) { __VA_ARGS__; xcd_barrier(bar, F.wave == 0 && lane_id() == 0); } __VA_ARGS__; } SEAM(k);
    LAS float* cscr = (LAS float*)(F.lds + F.wave * 16384);
    bf16_t* const XNp = F.XN(); bf16_t* const XCp = F.XC(); unsigned char* const SCR = F.SCR();
    bf16_t* const OUTB = (bf16_t*)F.out;
    constexpr unsigned LD2K = 4096;


#define CVT_BEGIN() CvtCursor cc{F.bid * 8 + F.wave, 0, F.G * 8}
#define CVT_BEGIN_RES() CvtCursor cc{(F.G == 256) ? (F.bid >= 64 ? (F.bid - 64) * 8 + F.wave : 0x3fffffff) : F.bid * 8 + F.wave, 0, (F.G == 256) ? 192 * 8 : F.G * 8}
#define PH_FIN(XI_, XO_, S1_, ...) { CVT_BEGIN(); __VA_ARGS__; ss_final_phase(F, ssp, rsv, XI_, XO_, SLAB0, S1_); }
#define PH_FFN_UP(LI_, X_) { bf16_t* wg = (bf16_t*)F.WFFN(); \
        pg8::Gemm g = mk_gemm(X_, LD2K, wg, LD2K, (long)DFF * LD2K, 32); SchedLin S = mk_lin(F, 195, 44, -(long)LD2K, 254L * LD2K, 0, 128L * LD2K, 32, WGM_FFU); \
        EpiFfnUp E{(bf16_t*)SCR, F.I(27) + (size_t)(LI_) * 3 * DFF, F.I(28) + (size_t)(LI_) * DFF, (LAS float*)(F.lds + EDGE_OFF), rsv, (const unsigned char*)(F.ws + WS_CTL + 768 * 1024)}; \
        pg8::gemm_phase<EpiFfnUp, SchedLin, true>(F.lds, g, S, E, F.wave); }
#define PH_FFN_DOWN(XI_, XO_, SS_, ...) { bf16_t* wd = (bf16_t*)F.WFFN() + (size_t)2 * DFF * D; \
        pg8::Gemm g = mk_gemm(SCR, DFF * 2, wd, DFF * 2, 128L * DFF * 2, 88); SchedRes S = mk_res(F, 256L * DFF * 2, 0, 256L * DFF * 2, 88); \
        EpiResAdd E{XI_, XO_, SS_, SLAB0}; pg8::gemm_phase<EpiResAdd, SchedRes, ALIGN_RES>(F.lds, g, S, E, F.wave); { CVT_BEGIN_RES(); __VA_ARGS__; } }
#define PH_RG_IN(X_) { bf16_t* win = (bf16_t*)F.WMIX(); \
        pg8::Gemm g = mk_gemm(X_, LD2K, win, LD2K, 128L * LD2K, 32); SchedLin S = mk_lin(F, 194, 16, 0, 256L * LD2K, 0, 256L * LD2K); \
        EpiRgIn E{OUTB, (bf16_t*)SCR, rsv}; pg8::gemm_phase<EpiRgIn, SchedLin, ALIGN_CONS>(F.lds, g, S, E, F.wave); }
#define PH_RG_CONV(J_) { rg_conv_phase(F, (const bf16_t*)SCR, XCp, F.I(7) + (size_t)(J_) * 4 * D, F.I(8) + (size_t)(J_) * D); }
#define PH_RG_GATES(J_) { bf16_t* gates = (bf16_t*)F.WMIX() + (size_t)4096 * D; \
        pg8::Gemm g = mk_gemm(XCp, LD2K, gates, 512, 8L * 131072, 4); SchedGates S; S.o.init(194, 32, F.G, F.bid, WGM_GATES); \
        EpiGates E{XCp, (bf16_t*)SCR, (bf16_t*)(SCR + B194), B194, F.I(10) + (size_t)(J_) * 2 * D, F.I(12) + (size_t)(J_) * 2 * D, F.I(13) + (size_t)(J_) * 2 * D, (LAS float*)(F.lds + EDGE_OFF)}; \
        pg8::gemm_phase<EpiGates, SchedGates, true>(F.lds, g, S, E, F.wave); }
#define PH_RG_SCAN() { rg_scan_phase(F, (const bf16_t*)SCR, (bf16_t*)(SCR + B194), (const bf16_t*)(SCR + 2 * B194), (bf16_t*)(SCR + 3 * B194), OUTB); }
#define PH_RG_OUT(XI_, XO_, ...) { bf16_t* wout = (bf16_t*)F.WMIX() + (size_t)4096 * D + (size_t)32 * 65536; \
        pg8::Gemm g = mk_gemm(SCR + 3 * B194, LD2K, wout, LD2K, 128L * LD2K, 32); SchedRes S = mk_res(F, 256L * LD2K, 0, 256L * LD2K, 32); \
        EpiResAdd E{XI_, XO_, ssp, SLAB0}; pg8::gemm_phase<EpiResAdd, SchedRes, ALIGN_RES>(F.lds, g, S, E, F.wave); { CVT_BEGIN_RES(); __VA_ARGS__; } }
#define PH_GDN_PROJ(HALF_, X_) { bf16_t* w = (bf16_t*)F.WMIX() + ((HALF_) ? (size_t)6400 * D : 0); \
        pg8::Gemm g = mk_gemm(X_, LD2K, w, LD2K, 128L * LD2K, 32); SchedLin S = mk_lin(F, 194, (HALF_) ? 24 : 25, 0, 256L * LD2K, 0, 256L * LD2K); \
        EpiGdnProj E{(bf16_t*)SCR, (HALF_) ? (bf16_t*)(SCR + 2 * B194) : XB, (float*)(SCR + 3 * B194), F.I(21), F.I(22), (bf16_t*)(SCR + 3 * B194 + 26 * MiB), rsv}; pg8::gemm_phase<EpiGdnProj, SchedLin, ALIGN_CONS>(F.lds, g, S, E, F.wave); }
#define PH_GDN_CONV(HALF_) { gdn_conv_phase(F, HALF_, (bf16_t*)SCR, (const bf16_t*)(SCR + 3 * B194 + 26 * MiB), F.I(20)); }
#define GD_OBA (OUTB + (size_t)MP * D)
#define GD_OBB ((bf16_t*)(SCR + 3 * B194 + 48 * MiB))
#define PH_GDN_CORE(HALF_) { gdn_core_phase(F, HALF_, (const bf16_t*)SCR, (const float*)(SCR + 3 * B194), (HALF_) ? XCp : OUTB, GD_OBA, GD_OBB); }
#define PH_GDN_COMB(HALF_) { gdn_combine_phase(F, (HALF_) ? XCp : OUTB, GD_OBA, GD_OBB, (HALF_) ? (const bf16_t*)(SCR + 2 * B194) : (const bf16_t*)XB, F.I(23)); }
#define PH_GDN_OUT(HALF_, XI_, XO_, SS_, ...) { bf16_t* wout = (bf16_t*)F.WMIX() + (size_t)(6400 + 6144) * D; \
        pg8::Gemm g = mk_gemm((HALF_) ? XCp : OUTB, LD2K, wout, 8192, 128L * 8192, 32); SchedRes S = mk_res(F, 256L * LD2K, (long)(HALF_) * 4096, 256L * 8192, 32); \
        EpiResAdd E{XI_, XO_, SS_, (HALF_) ? SLAB1 : SLAB0}; pg8::gemm_phase<EpiResAdd, SchedRes, ALIGN_RES>(F.lds, g, S, E, F.wave); { CVT_BEGIN_RES(); __VA_ARGS__; } }
    float* const SLAB0 = (float*)(SCR + 784 * MiB); float* const SLAB1 = (float*)(SCR + 640 * MiB); float* const NOSLAB = nullptr;
    float* const ssp = (float*)(SCR + 4 * B194);
    float* const rsv = (float*)(F.ws + WS_CTL + 256 * 1024);
    bf16_t* const NOXN = nullptr; float* const NOSS = nullptr; (void)NOXN;

    bf16_t* const XA = XNp; bf16_t* const XB = (bf16_t*)(F.ws + WS_H + B194);
    PHASE(0, { CVT_BEGIN(); cvt_rg(F, cc, 0, 0, cscr); cvt_ffn(F, cc, 0, cscr); fill_rflag(F, (unsigned char*)(F.ws + WS_CTL + 768 * 1024)); norm_phase<1>(F, XA, F.I(3), rsv); })
    PHASE(1, PH_RG_IN(XA)) PHASE(2, PH_RG_CONV(0)) PHASE(3, PH_RG_GATES(0)) PHASE(4, PH_RG_SCAN()) PHASE(5, PH_RG_OUT(XA, XB, (void)cc))
    PHASE(6, PH_FIN(XA, XB, NOSLAB, (void)cc))
    PHASE(7, PH_FFN_UP(0, XB)) PHASE(8, PH_FFN_DOWN(XB, XA, ssp, cvt_na(F, cc, cscr))) PHASE(9, PH_FIN(XB, XA, NOSLAB, (void)cc))
    PHASE(10, { pg8::Gemm g = mk_gemm(XA, LD2K, F.WMIX(), LD2K, 128L * LD2K, 32); SchedLin S = mk_lin(F, 194, 24, 0, 256L * LD2K, 0, 256L * LD2K);
        EpiPlainBf16 E{(bf16_t*)SCR, 6144, rsv}; pg8::gemm_phase<EpiPlainBf16, SchedLin, ALIGN_CONS>(F.lds, g, S, E, F.wave); })
    PHASE(11, { na_attn_phase(F, (const bf16_t*)SCR, OUTB, F.I(16), F.I(17)); })
    PHASE(12, { bf16_t* wo = (bf16_t*)F.WMIX() + (size_t)6144 * D;
        pg8::Gemm g = mk_gemm(OUTB, LD2K, wo, LD2K, 128L * LD2K, 32); SchedRes S = mk_res(F, 256L * LD2K, 0, 256L * LD2K, 32);
        EpiResAdd E{XA, XB, ssp, SLAB0}; pg8::gemm_phase<EpiResAdd, SchedRes, ALIGN_RES>(F.lds, g, S, E, F.wave); { CVT_BEGIN_RES(); cvt_ffn(F, cc, 1, cscr); } })
    PHASE(13, PH_FIN(XA, XB, NOSLAB, (void)cc))
    PHASE(14, PH_FFN_UP(1, XB)) PHASE(15, PH_FFN_DOWN(XB, XA, ssp, cvt_gdn(F, cc, cscr))) PHASE(16, PH_FIN(XB, XA, NOSLAB, (void)cc))
    PHASE(17, PH_GDN_PROJ(0, XA)) PHASE(18, PH_GDN_CONV(0)) PHASE(19, PH_GDN_CORE(0))
    PHASE(20, { PH_GDN_COMB(0) PH_GDN_PROJ(1, XA) }) PHASE(21, PH_GDN_CONV(1)) PHASE(22, PH_GDN_CORE(1))
    PHASE(23, { PH_GDN_COMB(1) PH_GDN_OUT(0, XA, XB, NOSS, cvt_ffn(F, cc, 2, cscr)) })
    PHASE(24, PH_GDN_OUT(1, XB, XA, ssp, (void)cc))
    PHASE(25, PH_FIN(XA, XA, SLAB1, (void)cc))
    PHASE(26, PH_FFN_UP(2, XA)) PHASE(27, PH_FFN_DOWN(XA, XB, ssp, cvt_rg(F, cc, 1, 3, cscr))) PHASE(28, PH_FIN(XA, XB, NOSLAB, (void)cc))
    PHASE(29, PH_RG_IN(XB)) PHASE(30, PH_RG_CONV(1)) PHASE(31, PH_RG_GATES(1)) PHASE(32, PH_RG_SCAN()) PHASE(33, PH_RG_OUT(XB, XA, cvt_ffn(F, cc, 3, cscr)))
    PHASE(34, PH_FIN(XB, XA, NOSLAB, (void)cc))
    PHASE(35, PH_FFN_UP(3, XA)) PHASE(36, PH_FFN_DOWN(XA, XB, NOSS, (void)cc))
    PHASE(37, { norm_phase<2>(F, XB, F.I(5), nullptr, XA, SLAB0); })
#undef IN
#undef SEAM
}

__global__ void fill_k(float* o, size_t n, float v) { for (size_t i = (size_t)blockIdx.x * blockDim.x + threadIdx.x; i < n; i += (size_t)gridDim.x * blockDim.x) o[i] = v; }
#ifndef MK_ONE_LAUNCH
#define MK_ONE_LAUNCH 1
#endif
extern "C" void kernel_launch(void* const* d_in, const int* in_sizes, int n_in, void* d_out, int out_size, void* d_ws, size_t ws_size, hipStream_t stream) {
    static int grid = 0;
    if (grid == 0) {
        int dev = 0, cus = 0;
        hipError_t e = hipGetDevice(&dev); if (e == hipSuccess) e = hipDeviceGetAttribute(&cus, hipDeviceAttributeMultiprocessorCount, dev);
        if (e == hipSuccess) e = hipFuncSetAttribute((const void*)trunk_fwd, hipFuncAttributeMaxDynamicSharedMemorySize, LDS_BYTES);
        if (e != hipSuccess || n_in != 30 || ws_size < WS_END || cus < 1) { fprintf(stderr, "kernel_launch: setup failed (%s), n_in %d, ws %zu\n", hipGetErrorName(e), n_in, ws_size); grid = -1; }
        else grid = cus;
        (void)hipGetLastError();
    }
    if (grid < 0) { fill_k<<<1024, 256, 0, stream>>>((float*)d_out, (size_t)out_size, 7.0f); return; }
    (void)hipMemsetAsync((char*)d_ws + WS_CTL, 0, CTL_ZERO_BYTES, stream);
    Args a{};
    for (int i = 0; i < 30; ++i) a.in[i] = (const float*)d_in[i];
    a.out = (float*)d_out; a.ws = (unsigned char*)d_ws;
#if MK_ONE_LAUNCH
    a.ph_lo = 0; a.ph_hi = N_PHASES;
    hipLaunchKernelGGL(trunk_fwd, dim3(grid), dim3(512), LDS_BYTES, stream, a);
#else
    for (int p = 0; p < N_PHASES; ++p) { a.ph_lo = p; a.ph_hi = p + 1; hipLaunchKernelGGL(trunk_fwd, dim3(grid), dim3(512), LDS_BYTES, stream, a); }
#endif
}
```

```cpp
#include <hip/hip_runtime.h>
#include <cstdio>
#include <cstdint>
#include <type_traits>

#define LAS __attribute__((address_space(3)))
#define GAS __attribute__((address_space(1)))
typedef unsigned short bf16_t;
typedef short bf16x8 __attribute__((ext_vector_type(8)));
typedef short s16x4 __attribute__((ext_vector_type(4)));
typedef float f32x4 __attribute__((ext_vector_type(4)));
typedef float f32x2 __attribute__((ext_vector_type(2)));
typedef unsigned u32x4 __attribute__((ext_vector_type(4)));
typedef unsigned u32x2 __attribute__((ext_vector_type(2)));
#define DI __device__ __forceinline__

constexpr int D = 2048, NSEQ = 20, NPROMPT = 16, TP = 2064, TS = 4112, LP = 2048, LS = 4096, NMETA = 16;
constexpr int MPROMPT = NPROMPT * TP;
constexpr int MTOK = MPROMPT + 4 * TS;
constexpr int MP = 49664;
constexpr int DFF = 5632;
constexpr float NORM_EPS = 1e-6f;
DI int seq_off(int b) { return b < NPROMPT ? b * TP : MPROMPT + (b - NPROMPT) * TS; }
DI int seq_len(int b) { return b < NPROMPT ? TP : TS; }
DI void row_bt(int R, int& b, int& t) { if (R < MPROMPT) { b = R / TP; t = R - b * TP; } else { const int q = (R - MPROMPT) / TS; b = NPROMPT + q; t = R - MPROMPT - q * TS; } }

typedef __bf16 bf16v2_ __attribute__((ext_vector_type(2)));
DI unsigned cvt_pk_bf16(float lo, float hi) { const bf16v2_ r = __builtin_convertvector((f32x2){lo, hi}, bf16v2_); return __builtin_bit_cast(unsigned, r); }
DI float bf_lo(unsigned w) { return __uint_as_float(w << 16); }
DI float bf_hi(unsigned w) { return __uint_as_float(w & 0xffff0000u); }
DI float bf2f(bf16_t h) { return __uint_as_float(((unsigned)h) << 16); }
DI bf16_t f2bf(float f) { return (bf16_t)(cvt_pk_bf16(f, 0.f) & 0xffffu); }
DI float fast_rcp(float x) { return __builtin_amdgcn_rcpf(x); }
DI float sigmoidf_(float x) { return fast_rcp(1.f + __expf(-x)); }
DI float siluf_(float x) { return x * sigmoidf_(x); }
DI float softplusf_(float x) { return x > 20.f ? x : log1pf(__expf(x)); }
DI float softplus_lite(float x) { const float e = __expf(x), u = 1.f + e, d = u - 1.f; return x > 20.f ? x : (d == 0.f ? e : __logf(u) * e * fast_rcp(d)); }
DI float gelu_tanh_(float x) { const float u = 1.5957691216057308f * (x + 0.044715f * x * x * x); return x * sigmoidf_(u); }
DI int lane_id() { int r; asm volatile("v_mbcnt_lo_u32_b32 %0, -1, 0\n\tv_mbcnt_hi_u32_b32 %0, -1, %0" : "=&v"(r)); return r; }
DI float wave_sum(float v) {
#pragma unroll
    for (int o = 1; o < 64; o <<= 1) v += __shfl_xor(v, o);
    return v;
}

#define XB_TMO      128
#define XB_XCNT(j)  (256  + 64 * (j))
#define XB_XSUB(j)  (1280 + 64 * (j))
#define XB_XGEN(j)  (2304 + 64 * (j))
#define XB_TOP      3328
#define XB_TOPGEN   3392
#define XCD_BAR_WORDS 3456
#define XB_SPIN_CAP (1u << 22)
DI unsigned xb_ld(unsigned* p)              { return __hip_atomic_load(p, __ATOMIC_RELAXED, __HIP_MEMORY_SCOPE_AGENT); }
DI unsigned xb_add(unsigned* p, unsigned v) { return __hip_atomic_fetch_add(p, v, __ATOMIC_RELAXED, __HIP_MEMORY_SCOPE_AGENT); }
DI unsigned xb_xcc_id() { return (unsigned)__builtin_amdgcn_s_getreg((3 << 11) | 20) & 0xFu; }
#define XB_SPIN(cond, bar) do { unsigned _sp = 0; while (cond) { __builtin_amdgcn_s_sleep(1); \
    if ((++_sp & 255u) == 0u) { if (xb_ld(&(bar)[XB_TMO])) break; if (_sp > XB_SPIN_CAP) { atomicAdd(&(bar)[XB_TMO], 1u); break; } } } } while (0)
struct XcdBarrier { unsigned* bar; unsigned x; volatile LAS unsigned* st; };
DI XcdBarrier xcd_barrier_post(unsigned* bar, volatile LAS unsigned* st, bool leader) {
    XcdBarrier b; b.bar = bar; b.x = xb_xcc_id(); b.st = st;
    if (leader) (void)xb_add(&bar[XB_XCNT(b.x)], 1u);
    return b;
}
DI void xcd_barrier_complete(unsigned* bar, unsigned x, unsigned& nloc, unsigned& nx) {
    const unsigned G = gridDim.x * gridDim.y * gridDim.z;
    unsigned sum, cnt, mine, sp = 0u;
    for (;;) {
        sum = 0u; cnt = 0u; mine = 0u;
#pragma unroll
        for (unsigned j = 0; j < 16; ++j) { const unsigned c = xb_ld(&bar[XB_XCNT(j)]); sum += c; cnt += (c > 0u) ? 1u : 0u; mine = (j == x) ? c : mine; }
        if (sum == G) break;
        __builtin_amdgcn_s_sleep(1);
        if ((++sp & 255u) == 0u) { if (xb_ld(&bar[XB_TMO])) break; if (sp > XB_SPIN_CAP) { atomicAdd(&bar[XB_TMO], 1u); break; } }
    }
    nloc = mine > 0u ? mine : 1u; nx = cnt > 0u ? cnt : 1u;
}
DI void xcd_barrier(const XcdBarrier& b, bool leader) {
    asm volatile("s_waitcnt vmcnt(0)" ::: "memory");
    __syncthreads();
    if (leader) {
        unsigned* bar = b.bar;
        __builtin_amdgcn_s_waitcnt(0);
        unsigned nloc = b.st[0], nx = b.st[1];
        if (nloc == 0u) { xcd_barrier_complete(bar, b.x, nloc, nx); b.st[0] = nloc; b.st[1] = nx; }
        const unsigned old = xb_add(&bar[XB_XSUB(b.x)], 1u);
        const unsigned gen = old / nloc;
        if (old + 1u == (gen + 1u) * nloc) {
            __builtin_amdgcn_fence(__ATOMIC_RELEASE, "agent");
            asm volatile("s_waitcnt vmcnt(0)" ::: "memory");
            const unsigned og = xb_add(&bar[XB_TOP], 1u);
            const unsigned tg = og / nx;
            if (og + 1u == (tg + 1u) * nx) xb_add(&bar[XB_TOPGEN], 1u);
            else XB_SPIN(xb_ld(&bar[XB_TOPGEN]) == tg, bar);
            __builtin_amdgcn_fence(__ATOMIC_ACQUIRE, "agent");
            xb_add(&bar[XB_XGEN(b.x)], 1u);
            asm volatile("s_waitcnt vmcnt(0)" ::: "memory");
        } else {
            XB_SPIN(xb_ld(&bar[XB_XGEN(b.x)]) == gen, bar);
            __builtin_amdgcn_fence(__ATOMIC_ACQUIRE, "agent");
            asm volatile("s_waitcnt vmcnt(0)" ::: "memory");
        }
    }
    __syncthreads();
}

namespace pg8 {
constexpr int BM = 256, BK = 64, HALF = 128, HTB = HALF * BK * 2, STAGE_BYTES = 8 * HTB, NXCD = 8;
__host__ __device__ __forceinline__ int lds_byte(int r, int c) { const int st = (r >> 4) * 2 + (c >> 5), rr = r & 15, cc = c & 31, ob = rr * 64 + cc * 2; return st * 1024 + (ob ^ (((ob >> 9) & 1) << 5)); }
__host__ __device__ __forceinline__ void stage_rc(int b, int& R, int& C) { const int st = b / 1024, sb = b % 1024, swz = sb ^ (((sb >> 9) & 1) << 5); R = (st >> 1) * 16 + swz / 64; C = (st & 1) * 32 + (swz % 64) / 2; }
__host__ __device__ __forceinline__ int perm32(int rho) { const int n = rho >> 4, i = rho & 15; return 8 * (i >> 2) + 4 * n + (i & 3); }

struct Unit { int pm, pn; long aoff, boff; int nt, sub; };
struct Gemm { const char* A; const char* B; unsigned lda, ldb; long hstepA, hstepB; int nt; };
struct TileOrder {
    int nM, nN, nwg, G, c, WGM;
    DI void init(int nM_, int nN_, int G_, int c_, int wgm_ = 4) { nM = nM_; nN = nN_; nwg = nM * nN; G = G_; c = c_; WGM = wgm_; }
    DI bool tile(int i, int& pm, int& pn) const {
        const long L = (long)i * G + c; if (L >= nwg) return false;
        int wgid = (int)L; { const int q = nwg / NXCD, r = nwg % NXCD, xcd = wgid % NXCD, off = wgid / NXCD; wgid = (xcd < r ? xcd * (q + 1) : r * (q + 1) + (xcd - r) * q) + off; }
        const int nig = WGM * nN, gid = wgid / nig, fm = gid * WGM, gsz = (nM - fm) < WGM ? (nM - fm) : WGM;
        pm = fm + ((wgid % nig) % gsz); pn = (wgid % nig) / gsz; return true;
    }
};

template <class Epi, class Sched, bool ALIGN_EPI>
DI void gemm_phase(LAS unsigned char* lds, const Gemm g, const Sched& S, const Epi& E, int wave_id) {
    int tid_ = wave_id * 64 + lane_id(); asm volatile("" : "+v"(tid_));
    const int tid = tid_, wid = __builtin_amdgcn_readfirstlane(tid >> 6), lane = tid & 63, wr = wid >> 2, wc = wid & 3, fr = lane & 15, fq = lane >> 4;
    unsigned voffA[2], voffB[2];
#pragma unroll
    for (int i = 0; i < 2; ++i) { int R, C; stage_rc(tid * 16 + i * 8192, R, C); const int Rb = Epi::PERM ? ((R & ~31) + perm32(R & 31)) : R;
        voffA[i] = (unsigned)R * g.lda + (unsigned)C * 2u; voffB[i] = (unsigned)Rb * g.ldb + (unsigned)C * 2u; }
    const long kstep = (long)(BK * 2);
    const long hA = g.hstepA, hB = g.hstepB;
    const unsigned ldsw = (unsigned)wid * 1024u;
    const int aoff = lds_byte(wr * 64 + fr, fq * 8), boff = lds_byte(wc * 32 + fr, fq * 8);
#define PG8_SA(b, h) (((b) * 2 + (h)) * HTB)
#define PG8_SB(b, h) ((4 + (b) * 2 + (h)) * HTB)
#define PG8_STAGE(bufoff, gbase, voff) do { _Pragma("unroll") for (int _i = 0; _i < 2; ++_i) \
        __builtin_amdgcn_global_load_lds((const unsigned*)((const char*)(gbase) + (voff)[_i]), (LAS unsigned*)(lds + (bufoff) + ldsw + _i * 8192), 16, 0, 0); } while (0)
#define PG8_LDA(dst, b, h) do { _Pragma("unroll") for (int m = 0; m < 4; ++m) _Pragma("unroll") for (int k = 0; k < 2; ++k) dst[m][k] = *(const LAS bf16x8*)(lds + PG8_SA(b, h) + aoff + m * 2048 + k * 1024); } while (0)
#define PG8_LDB(dst, b, h) do { _Pragma("unroll") for (int n = 0; n < 2; ++n) _Pragma("unroll") for (int k = 0; k < 2; ++k) dst[n][k] = *(const LAS bf16x8*)(lds + PG8_SB(b, h) + boff + n * 2048 + k * 1024); } while (0)
#define PG8_MMA(ai, bj, At, Bt) do { __builtin_amdgcn_s_setprio(1); _Pragma("unroll") for (int m = 0; m < 4; ++m) _Pragma("unroll") for (int n = 0; n < 2; ++n) _Pragma("unroll") for (int k = 0; k < 2; ++k) \
        acc[ai][bj][m][n] = __builtin_amdgcn_mfma_f32_16x16x32_bf16(Bt[n][k], At[m][k], acc[ai][bj][m][n], 0, 0, 0); __builtin_amdgcn_s_setprio(0); } while (0)
#define PG8_WAIT_V(n) asm volatile("s_waitcnt vmcnt(" #n ")" ::: "memory")
#define PG8_WAIT_L(n) asm volatile("s_waitcnt lgkmcnt(" #n ")" ::: "memory")
#define PG8_BAR __builtin_amdgcn_s_barrier()
#define PG8_SCHED __builtin_amdgcn_sched_barrier(0)
    Unit cur, nxt; int ui = 0;
    if (!S.next(0, cur)) return;
    f32x4 acc[2][2][4][2];
#pragma unroll
    for (int a = 0; a < 2; ++a)
#pragma unroll
        for (int b = 0; b < 2; ++b)
#pragma unroll
            for (int m = 0; m < 4; ++m)
#pragma unroll
                for (int n = 0; n < 2; ++n) acc[a][b][m][n] = (f32x4){0.f, 0.f, 0.f, 0.f};
    bf16x8 At[4][2], B0[2][2], B1[2][2];
    const char* cA = g.A + cur.aoff; const char* cB = g.B + cur.boff;
    PG8_STAGE(PG8_SB(0, 0), cB, voffB); PG8_STAGE(PG8_SB(0, 1), cB + hB, voffB); PG8_STAGE(PG8_SA(0, 0), cA, voffA); PG8_STAGE(PG8_SA(0, 1), cA + hA, voffA);
    if (wr == 1) PG8_BAR;
    PG8_WAIT_V(2); PG8_BAR;
    PG8_STAGE(PG8_SB(1, 0), cB + kstep, voffB); PG8_STAGE(PG8_SA(1, 0), cA + kstep, voffA); PG8_STAGE(PG8_SB(1, 1), cB + hB + kstep, voffB);
    PG8_WAIT_V(6); PG8_BAR;
    for (;;) {
        const bool has_next = S.next(ui + 1, nxt);
        const char* nA = has_next ? g.A + nxt.aoff : cA; const char* nB = has_next ? g.B + nxt.boff : cB;
        const int nt = cur.nt;
        for (int t = 0; t < nt; t += 2) {
            const bool last = (t == nt - 2);
            const char* a1 = cA + (long)(t + 1) * kstep;
            const char* a2 = last ? nA : cA + (long)(t + 2) * kstep; const char* b2 = last ? nB : cB + (long)(t + 2) * kstep;
            const char* a3 = a2 + kstep; const char* b3 = b2 + kstep;
            PG8_LDB(B0, 0, 0); PG8_LDB(B1, 0, 1); PG8_SCHED; PG8_LDA(At, 0, 0); PG8_STAGE(PG8_SA(1, 1), a1 + hA, voffA);
            PG8_WAIT_V(8); PG8_WAIT_L(0); PG8_BAR; PG8_MMA(0, 0, At, B0); PG8_MMA(0, 1, At, B1); PG8_BAR; PG8_SCHED;
            PG8_LDA(At, 0, 1); PG8_STAGE(PG8_SB(0, 0), b2, voffB); PG8_STAGE(PG8_SB(0, 1), b2 + hB, voffB); PG8_STAGE(PG8_SA(0, 0), a2, voffA);
            PG8_WAIT_V(8); PG8_WAIT_L(0); PG8_BAR; PG8_MMA(1, 0, At, B0); PG8_MMA(1, 1, At, B1); PG8_BAR; PG8_SCHED;
            PG8_LDB(B0, 1, 0); PG8_LDB(B1, 1, 1); PG8_SCHED; PG8_LDA(At, 1, 0); PG8_STAGE(PG8_SA(0, 1), a2 + hA, voffA);
            PG8_WAIT_V(8); PG8_WAIT_L(0); PG8_BAR; PG8_MMA(0, 0, At, B0); PG8_MMA(0, 1, At, B1); PG8_BAR; PG8_SCHED;
            PG8_LDA(At, 1, 1); PG8_STAGE(PG8_SB(1, 0), b3, voffB); PG8_STAGE(PG8_SB(1, 1), b3 + hB, voffB); PG8_STAGE(PG8_SA(1, 0), a3, voffA);
            PG8_WAIT_V(8); PG8_WAIT_L(0); PG8_BAR; PG8_MMA(1, 0, At, B0); PG8_MMA(1, 1, At, B1); PG8_BAR; PG8_SCHED;
        }
        if constexpr (ALIGN_EPI) { if (wr == 0) PG8_BAR; }
        E(acc, cur, ui, wr, wc, fr, fq);
        if (!has_next) break;
#pragma unroll
        for (int a = 0; a < 2; ++a)
#pragma unroll
            for (int b = 0; b < 2; ++b)
#pragma unroll
                for (int m = 0; m < 4; ++m)
#pragma unroll
                    for (int n = 0; n < 2; ++n) acc[a][b][m][n] = (f32x4){0.f, 0.f, 0.f, 0.f};
        cur = nxt; cA = nA; cB = nB; ++ui;
        if constexpr (ALIGN_EPI) { if (wr == 1) PG8_BAR; }
    }
    PG8_WAIT_V(0);
    if constexpr (!ALIGN_EPI) { if (wr == 0) PG8_BAR; }
    PG8_BAR;
#undef PG8_SA
#undef PG8_SB
#undef PG8_STAGE
#undef PG8_LDA
#undef PG8_LDB
#undef PG8_MMA
#undef PG8_WAIT_V
#undef PG8_WAIT_L
#undef PG8_BAR
#undef PG8_SCHED
}
}
constexpr size_t MiB = (size_t)1 << 20;
constexpr size_t WS_CTL = 0, CTL_ZERO_BYTES = 64 * 1024;
constexpr size_t WS_WMIX = 1 * MiB, WS_WFFN = 67 * MiB, WS_XN = 133 * MiB, WS_H = 328 * MiB, WS_SCR = 716 * MiB, WS_END = 1524 * MiB;
constexpr size_t B194 = (size_t)MP * D * 2;
static_assert(B194 == 194 * MiB, "buffer size");
static_assert(WS_XN + 4096 + B194 <= WS_H && WS_H + 2 * B194 <= WS_SCR && WS_SCR + 4 * B194 <= WS_END, "ws map");
static_assert((size_t)MP * DFF * 2 <= WS_END - WS_SCR && (size_t)MP * 6144 * 2 <= WS_END - WS_SCR && WS_SCR + 4 * B194 + (size_t)MP * 128 <= WS_END, "scratch");
constexpr int CW_BAR = 1024;
constexpr int MISC_OFF = 163840 - 256, RING_BYTES = 131072, EDGE_OFF = 131072, EDGE_BYTES = 8192, LDS_BYTES = 163840;

struct Args { const float* in[30]; float* out; unsigned char* ws; int ph_lo, ph_hi; };

struct Frame {
    LAS unsigned char* lds;
    int wave, G, bid;
    DI int lane() const { return lane_id(); }
    DI int tid() const { return wave * 64 + lane_id(); }
    const float* const* in;
    float* out; unsigned char* ws;
    DI const float* I(int i) const { return in[i]; }
    DI bf16_t* XN() const { return (bf16_t*)(ws + WS_XN + 4096); }
    DI bf16_t* XC() const { return (bf16_t*)(ws + WS_H); }
    DI unsigned char* SCR() const { return ws + WS_SCR; }
    DI unsigned char* WMIX() const { return ws + WS_WMIX; }
    DI unsigned char* WFFN() const { return ws + WS_WFFN; }
};

struct SchedLin {
    pg8::TileOrder o; long a_base, a_tile, b_base, b_tile; int nt;
    DI bool next(int i, pg8::Unit& u) const { if (!o.tile(i, u.pm, u.pn)) return false; u.aoff = a_base + (long)u.pm * a_tile; u.boff = b_base + (long)u.pn * b_tile; u.nt = nt; u.sub = -1; return true; }
};
struct SchedGates {
    pg8::TileOrder o;
    DI bool next(int i, pg8::Unit& u) const { if (!o.tile(i, u.pm, u.pn)) return false; const int dir = u.pn >> 4, blk = (u.pn >> 1) & 7, hh = u.pn & 1;
        u.aoff = (long)u.pm * 256 * (D * 2) + blk * 512; u.boff = (long)((dir * 2) * 8 + blk) * 131072 + hh * 65536; u.nt = 4; u.sub = -1; return true; }
};

constexpr int RES_MAIN_PM = 192, RES_ROW0 = RES_MAIN_PM * 256, RES_NSPLIT = 4;
struct SchedRes {
    pg8::TileOrder o; long a_tile, b_base, b_tile; int nt; int G, c;
    DI void init(int G_, int c_, long a_tile_, long b_base_, long b_tile_, int nt_, int wgm_ = 4) { o.init(RES_MAIN_PM, 8, G_, c_, wgm_); G = G_; c = c_; a_tile = a_tile_; b_base = b_base_; b_tile = b_tile_; nt = nt_; }
    DI bool next(int i, pg8::Unit& u) const {
        const long L = (long)i * G + c;
        if (L < RES_MAIN_PM * 8) { o.tile(i, u.pm, u.pn); u.aoff = (long)u.pm * a_tile; u.boff = b_base + (long)u.pn * b_tile; u.nt = nt; u.sub = -1; return true; }
        const int r = (int)(L - RES_MAIN_PM * 8); if (r >= 16 * RES_NSPLIT) return false;
        const int s = r % RES_NSPLIT, t = r / RES_NSPLIT, nts = nt / RES_NSPLIT;
        u.pm = RES_MAIN_PM + (t >> 3); u.pn = t & 7; u.aoff = (long)u.pm * a_tile + (long)s * nts * 128; u.boff = b_base + (long)u.pn * b_tile + (long)s * nts * 128; u.nt = nts; u.sub = s; return true; }
};

DI float row_rs(const float* rsv, int row, int) { return rsv[row]; }
#ifndef NT_STORES
#define NT_STORES 0
#endif
template <class T> DI void st_stream(T* p, const T v) { if (NT_STORES) __builtin_nontemporal_store(v, p); else *p = v; }
DI u32x4 pack8(const f32x4 v0, const f32x4 v1) { u32x4 w; w.x = cvt_pk_bf16(v0[0], v0[1]); w.y = cvt_pk_bf16(v0[2], v0[3]); w.z = cvt_pk_bf16(v1[0], v1[1]); w.w = cvt_pk_bf16(v1[2], v1[3]); return w; }

struct EpiRgIn {
    static constexpr bool PERM = true;
    bf16_t* ygate; bf16_t* yrec; const float* ss;
    DI void operator()(const f32x4 (&acc)[2][2][4][2], const pg8::Unit& u, int, int wr, int wc, int fr, int fq) const {
        const bool isg = u.pn < 8; bf16_t* base = isg ? ygate : yrec; const int colt = (isg ? u.pn : u.pn - 8) * 256;
        const int row0 = u.pm * 256 + wr * 64 + fr, col0 = colt + wc * 32 + 8 * fq;
        float rs8[2][4];
#pragma unroll
        for (int ai = 0; ai < 2; ++ai)
#pragma unroll
            for (int m = 0; m < 4; ++m) rs8[ai][m] = row_rs(ss, row0 + ai * 128 + m * 16, fq);
#pragma unroll
        for (int ai = 0; ai < 2; ++ai)
#pragma unroll
            for (int m = 0; m < 4; ++m) { bf16_t* rowp = base + (size_t)(row0 + ai * 128 + m * 16) * D + col0; const float rs = rs8[ai][m];
#pragma unroll
                for (int bj = 0; bj < 2; ++bj) { f32x4 v0 = acc[ai][bj][m][0] * rs, v1 = acc[ai][bj][m][1] * rs;
                    if (isg) {
#pragma unroll
                        for (int j = 0; j < 4; ++j) { v0[j] = gelu_tanh_(v0[j]); v1[j] = gelu_tanh_(v1[j]); } }
                    st_stream((u32x4*)(rowp + bj * 128), pack8(v0, v1)); } }
    }
};
struct EpiPlainBf16 {
    static constexpr bool PERM = true;
    bf16_t* O; int ldc; const float* ss;
    DI void operator()(const f32x4 (&acc)[2][2][4][2], const pg8::Unit& u, int, int wr, int wc, int fr, int fq) const {
        const int row0 = u.pm * 256 + wr * 64 + fr, col0 = u.pn * 256 + wc * 32 + 8 * fq;
        float rs8[2][4];
#pragma unroll
        for (int ai = 0; ai < 2; ++ai)
#pragma unroll
            for (int m = 0; m < 4; ++m) rs8[ai][m] = row_rs(ss, row0 + ai * 128 + m * 16, fq);
#pragma unroll
        for (int ai = 0; ai < 2; ++ai)
#pragma unroll
            for (int m = 0; m < 4; ++m) { bf16_t* rowp = O + (size_t)(row0 + ai * 128 + m * 16) * ldc + col0; const float rs = rs8[ai][m];
#pragma unroll
                for (int bj = 0; bj < 2; ++bj) st_stream((u32x4*)(rowp + bj * 128), pack8(acc[ai][bj][m][0] * rs, acc[ai][bj][m][1] * rs)); }
    }
};
struct EpiGdnProj {
    static constexpr bool PERM = true;
    bf16_t* qkv; bf16_t* z; float* bg; const float* a_log; const float* dt_bias; bf16_t* halo; const float* ss;
    DI void operator()(const f32x4 (&acc)[2][2][4][2], const pg8::Unit& u, int, int wr, int wc, int fr, int fq) const {
        const int row0 = u.pm * 256 + wr * 64 + fr;
        float rs8[2][4];
#pragma unroll
        for (int ai = 0; ai < 2; ++ai)
#pragma unroll
            for (int m = 0; m < 4; ++m) rs8[ai][m] = row_rs(ss, row0 + ai * 128 + m * 16, fq);
        if (u.pn < 24) {
            bf16_t* base; int ldc, colt; if (u.pn < 16) { base = qkv; ldc = 4096; colt = u.pn * 256; } else { base = z; ldc = 2048; colt = (u.pn - 16) * 256; }
            const int col0 = colt + wc * 32 + 8 * fq;
#pragma unroll
            for (int ai = 0; ai < 2; ++ai)
#pragma unroll
                for (int m = 0; m < 4; ++m) { const int row = row0 + ai * 128 + m * 16; bf16_t* rowp = base + (size_t)row * ldc + col0;
                    const int r64 = row & 63, rb = row >> 6;
                    bf16_t* hp = nullptr;
                    if (u.pn < 16) { if (r64 == 63) hp = halo + ((size_t)(rb + 1) * 3 + 0) * 4096 + col0; else if (r64 == 0 && rb > 0) hp = halo + ((size_t)(rb - 1) * 3 + 1) * 4096 + col0; else if (r64 == 1 && rb > 0) hp = halo + ((size_t)(rb - 1) * 3 + 2) * 4096 + col0; }
                    const float rs = rs8[ai][m];
#pragma unroll
                    for (int bj = 0; bj < 2; ++bj) { const u32x4 w = pack8(acc[ai][bj][m][0] * rs, acc[ai][bj][m][1] * rs); st_stream((u32x4*)(rowp + bj * 128), w); if (hp) *(u32x4*)(hp + bj * 128) = w; } }
        } else {
            const int c0 = wc * 32 + 8 * fq;
            float al[8], db[8];
#pragma unroll
            for (int j = 0; j < 8; ++j) { const int c = c0 + j; al[j] = c >= 64 ? __expf(a_log[c - 64]) : 0.f; db[j] = c >= 64 ? dt_bias[c - 64] : 0.f; }
#pragma unroll
            for (int ai = 0; ai < 2; ++ai)
#pragma unroll
                for (int m = 0; m < 4; ++m) { float* rowp = bg + (size_t)(row0 + ai * 128 + m * 16) * 128 + c0; const float rs = rs8[ai][m];
                    f32x4 o[2];
#pragma unroll
                    for (int n = 0; n < 2; ++n)
#pragma unroll
                        for (int j = 0; j < 4; ++j) { const float x = acc[ai][0][m][n][j] * rs; const int jj = n * 4 + j;
                            o[n][j] = (c0 >= 64) ? -al[jj] * softplusf_(x + db[jj]) : sigmoidf_(x); }
                    *(f32x4*)(rowp) = o[0]; *(f32x4*)(rowp + 4) = o[1]; }
        }
    }
};
struct EpiResAdd {
    static constexpr bool PERM = true;
    const bf16_t* xin; bf16_t* xn; float* ss; float* slab;
    DI void operator()(const f32x4 (&acc)[2][2][4][2], const pg8::Unit& u, int, int wr, int wc, int fr, int fq) const {
        const int row0 = u.pm * 256 + wr * 64 + fr, col0 = u.pn * 256 + wc * 32 + 8 * fq;
        if (u.sub >= 0) {
#pragma unroll
            for (int ai = 0; ai < 2; ++ai)
#pragma unroll
                for (int m = 0; m < 4; ++m) { float* sp = slab + ((size_t)u.sub * 512 + (row0 + ai * 128 + m * 16 - RES_ROW0)) * D + col0;
#pragma unroll
                    for (int bj = 0; bj < 2; ++bj) { *(f32x4*)(sp + bj * 128) = acc[ai][bj][m][0]; *(f32x4*)(sp + bj * 128 + 4) = acc[ai][bj][m][1]; } }
            return; }
        const int l_ = lane_id(); const unsigned voff = (unsigned)((l_ & 15) * D + 8 * (l_ >> 4)) * 2u;
        const char* xi_u = (const char*)xin + ((size_t)(u.pm * 256 + wr * 64) * D + u.pn * 256 + wc * 32) * 2;
        char* xn_u = (char*)xn + ((size_t)(u.pm * 256 + wr * 64) * D + u.pn * 256 + wc * 32) * 2;
        u32x4 v[2][4][2];
#pragma unroll
        for (int ai = 0; ai < 2; ++ai)
#pragma unroll
            for (int m = 0; m < 4; ++m)
#pragma unroll
                for (int bj = 0; bj < 2; ++bj) v[ai][m][bj] = *(const u32x4*)(xi_u + (size_t)(ai * 128 + m * 16) * (D * 2) + bj * 256 + voff);
#pragma unroll
        for (int ai = 0; ai < 2; ++ai) {
#pragma unroll
            for (int m = 0; m < 4; ++m) { const int row = row0 + ai * 128 + m * 16; char* rowp = xn_u + (size_t)(ai * 128 + m * 16) * (D * 2);
                float sq = 0.f;
#pragma unroll
                for (int bj = 0; bj < 2; ++bj) { const u32x4 vv = v[ai][m][bj];
                    const f32x4 h0 = (f32x4){bf_lo(vv.x), bf_hi(vv.x), bf_lo(vv.y), bf_hi(vv.y)} + acc[ai][bj][m][0], h1 = (f32x4){bf_lo(vv.z), bf_hi(vv.z), bf_lo(vv.w), bf_hi(vv.w)} + acc[ai][bj][m][1];
                    const u32x4 w = pack8(h0, h1); *(u32x4*)(rowp + bj * 256 + voff) = w;
                    if (ss) { const float r0 = bf_lo(w.x), r1 = bf_hi(w.x), r2 = bf_lo(w.y), r3 = bf_hi(w.y), r4 = bf_lo(w.z), r5 = bf_hi(w.z), r6 = bf_lo(w.w), r7 = bf_hi(w.w);
                        sq += ((r0 * r0 + r1 * r1) + (r2 * r2 + r3 * r3)) + ((r4 * r4 + r5 * r5) + (r6 * r6 + r7 * r7)); } }
                if (ss) { sq += __shfl_xor(sq, 16); sq += __shfl_xor(sq, 32); if (fq == 0) ss[((size_t)u.pm * 32 + u.pn * 4 + wc) * 256 + (row & 255)] = sq; } }
        }
    }
};
#ifndef GATES_TOP
#define GATES_TOP 4
#endif
struct EpiGates {
    static constexpr bool PERM = true;
    const bf16_t* xc; bf16_t* la; bf16_t* uu;
    size_t dstride; const float* b_a; const float* b_i; const float* lam;
    LAS float* cl;
    DI void operator()(const f32x4 (&acc)[2][2][4][2], const pg8::Unit& u, int, int wr, int wc, int fr, int fq) const {
        const int dir = u.pn >> 4, blk = (u.pn >> 1) & 7, hh = u.pn & 1;
        const int row0 = u.pm * 256 + wr * 64 + fr, c0 = blk * 256 + hh * 128 + wc * 32 + 8 * fq;
        LAS float* cw_ = cl + (wr * 4 + wc) * 96;
        { const int lane = lane_id(); if (lane < 32) { const int c = dir * D + blk * 256 + hh * 128 + wc * 32 + lane;
            cw_[lane] = b_a[c]; cw_[32 + lane] = b_i[c]; cw_[64 + lane] = -8.0f * softplus_lite(-lam[c]); } }
        const int l_ = lane_id(); const unsigned voff = (unsigned)((l_ & 15) * D + 8 * (l_ >> 4)) * 2u;
        const size_t uoff = ((size_t)(u.pm * 256 + wr * 64) * D + blk * 256 + hh * 128 + wc * 32) * 2;
        const char* xc_u = (const char*)xc + uoff; char* la_u = (char*)(la + dir * dstride) + uoff; char* uu_u = (char*)(uu + dir * dstride) + uoff;
        u32x4 xw4[2][4];
#pragma unroll
        for (int g = 0; g < GATES_TOP; ++g) xw4[g >> 2][g & 3] = *(const u32x4*)(xc_u + (size_t)((g >> 2) * 128 + (g & 3) * 16) * (D * 2) + voff);
#pragma unroll
        for (int ai = 0; ai < 2; ++ai) {
#pragma unroll
            for (int m = 0; m < 4; ++m) { const size_t off = (size_t)(ai * 128 + m * 16) * (D * 2);
                const u32x4 xw = xw4[ai][m];
                float xv[8]; xv[0] = bf_lo(xw.x); xv[1] = bf_hi(xw.x); xv[2] = bf_lo(xw.y); xv[3] = bf_hi(xw.y); xv[4] = bf_lo(xw.z); xv[5] = bf_hi(xw.z); xv[6] = bf_lo(xw.w); xv[7] = bf_hi(xw.w);
                f32x4 lo[2], uo[2];
#pragma unroll
                for (int n = 0; n < 2; ++n) { LAS float* cp = cw_ + 8 * fq; asm volatile("" : "+v"(cp));
                    const f32x4 ba = *(const LAS f32x4*)(cp + 4 * n), bi = *(const LAS f32x4*)(cp + 32 + 4 * n), sp = *(const LAS f32x4*)(cp + 64 + 4 * n);
#pragma unroll
                    for (int jp = 0; jp < 2; ++jp) { const int j = 2 * jp, jj = n * 4 + j;
                        const f32x2 NL2E = (f32x2){-1.4426950408889634f, -1.4426950408889634f}, ONE = (f32x2){1.f, 1.f};
                        const f32x2 ta = ((f32x2){acc[ai][0][m][n][j], acc[ai][0][m][n][j + 1]} + (f32x2){ba[j], ba[j + 1]}) * NL2E;
                        const f32x2 ti = ((f32x2){acc[ai][1][m][n][j], acc[ai][1][m][n][j + 1]} + (f32x2){bi[j], bi[j + 1]}) * NL2E;
                        const f32x2 da = (f32x2){__builtin_amdgcn_exp2f(ta[0]), __builtin_amdgcn_exp2f(ta[1])} + ONE, di = (f32x2){__builtin_amdgcn_exp2f(ti[0]), __builtin_amdgcn_exp2f(ti[1])} + ONE;
                        const f32x2 r = (f32x2){fast_rcp(da[0]), fast_rcp(da[1])}, ig = (f32x2){fast_rcp(di[0]), fast_rcp(di[1])};
                        const f32x2 l = (f32x2){sp[j], sp[j + 1]} * r;
                        lo[n][j] = l[0]; lo[n][j + 1] = l[1];
                        const f32x2 x2 = l + l;
                        const f32x2 te = x2 * (f32x2){1.4426950408889634f, 1.4426950408889634f};
                        const f32x2 om_e = ONE - (f32x2){__builtin_amdgcn_exp2f(te[0]), __builtin_amdgcn_exp2f(te[1])};
                        const f32x2 om_s = (x2 * (f32x2){0.5f, 0.5f} + ONE) * (-x2);
                        const float om0 = x2[0] > -0.0009765625f ? om_s[0] : om_e[0], om1 = x2[1] > -0.0009765625f ? om_s[1] : om_e[1];
                        const f32x2 sq = (f32x2){__builtin_amdgcn_sqrtf(fmaxf(om0, 0.f)), __builtin_amdgcn_sqrtf(fmaxf(om1, 0.f))};
                        const f32x2 u2 = sq * (ig * (f32x2){xv[jj], xv[jj + 1]});
                        uo[n][j] = u2[0]; uo[n][j + 1] = u2[1]; }
                    __builtin_amdgcn_sched_barrier(0); }
                *(u32x4*)(la_u + off + voff) = pack8(lo[0], lo[1]);
                *(u32x4*)(uu_u + off + voff) = pack8(uo[0], uo[1]);
                __builtin_amdgcn_sched_barrier(0);
                if (ai == 0 && m == 0) {
#pragma unroll
                    for (int g = GATES_TOP; g < 8; ++g) xw4[g >> 2][g & 3] = *(const u32x4*)(xc_u + (size_t)((g >> 2) * 128 + (g & 3) * 16) * (D * 2) + voff);
                    __builtin_amdgcn_sched_barrier(0); } }
        }
    }
};
struct EpiFfnUp {
    static constexpr bool PERM = true;
    bf16_t* act; const float* cw; const float* cb; LAS float* edge; const float* ss; const unsigned char* rflag;
    DI void operator()(f32x4 (&acc)[2][2][4][2], const pg8::Unit& u, int ui, int wr, int wc, int fr, int fq) const {
        const int lane = fq * 16 + fr;
        LAS float* ef = edge + (ui & 1) * 1024, * el = ef + 512;
        LAS float* tapl = edge + 2048 + (wr * 4 + wc) * 128;
        const int cg0 = wc * 32 + 8 * fq;
        float rs8[2][4]; unsigned flp[2] = {0u, 0u};
#pragma unroll
        for (int ai = 0; ai < 2; ++ai)
#pragma unroll
            for (int m = 0; m < 4; ++m) { const int r = 128 * ai + 64 * wr + 16 * m + fr; const int R = 254 * u.pm - 1 + r; const int Rc = R < 0 ? 0 : R;
                rs8[ai][m] = row_rs(ss, Rc, fq); flp[ai] |= ((__float_as_uint(rs8[ai][m]) & 3u) | ((r >= 1 && r <= 254 && R < MTOK) ? 4u : 0u)) << (8 * m); }
        if (lane < 32) { const int a = lane >> 3, c = lane & 7; const float* src = (a < 3 ? cw + (size_t)a * DFF : cb) + u.pn * 128 + wc * 32 + 4 * c;
            *(LAS f32x4*)(tapl + a * 32 + 4 * c) = *(const f32x4*)src; }
#pragma unroll
        for (int ai = 0; ai < 2; ++ai)
#pragma unroll
            for (int m = 0; m < 4; ++m)
#pragma unroll
                for (int bj = 0; bj < 2; ++bj)
#pragma unroll
                    for (int n = 0; n < 2; ++n) acc[ai][bj][m][n] = acc[ai][bj][m][n] * rs8[ai][m];
        __builtin_amdgcn_sched_barrier(0);
#pragma unroll
        for (int ai = 0; ai < 2; ++ai) { const int sg = 2 * ai + wr;
            if (fr == 0) { *(LAS f32x4*)(ef + sg * 128 + cg0) = acc[ai][0][0][0]; *(LAS f32x4*)(ef + sg * 128 + cg0 + 4) = acc[ai][0][0][1]; }
            if (fr == 15) { *(LAS f32x4*)(el + sg * 128 + cg0) = acc[ai][0][3][0]; *(LAS f32x4*)(el + sg * 128 + cg0 + 4) = acc[ai][0][3][1]; } }
        asm volatile("s_waitcnt lgkmcnt(0)" ::: "memory"); __builtin_amdgcn_s_barrier(); asm volatile("" ::: "memory");
        const int cf0 = u.pn * 128 + cg0;
#ifdef FFU_EPI_REP
        int reps_ = FFU_EPI_REP; asm volatile("" : "+s"(reps_));
        for (int rep_ = 0; rep_ < reps_; ++rep_)
#endif
        auto conv = [&](auto bnd) { constexpr bool BND = decltype(bnd)::value;
#pragma unroll
        for (int ai = 0; ai < 2; ++ai) { const int sg = 2 * ai + wr;
#pragma unroll
            for (int n = 0; n < 2; ++n) {
                const f32x4 w0 = *(const LAS f32x4*)(tapl + 8 * fq + 4 * n), w1 = *(const LAS f32x4*)(tapl + 32 + 8 * fq + 4 * n), w2 = *(const LAS f32x4*)(tapl + 64 + 8 * fq + 4 * n), bb = *(const LAS f32x4*)(tapl + 96 + 8 * fq + 4 * n);
                const f32x4 htop = sg > 0 ? *(LAS f32x4*)(el + (sg - 1) * 128 + cg0 + 4 * n) : (f32x4){0.f, 0.f, 0.f, 0.f};
                const f32x4 hbot = sg < 3 ? *(LAS f32x4*)(ef + (sg + 1) * 128 + cg0 + 4 * n) : (f32x4){0.f, 0.f, 0.f, 0.f};
                unsigned pk[4][2];
#pragma unroll
                for (int jp = 0; jp < 2; ++jp) {
                    float pvv[2][4], nvv[2][4], vv[2][4];
#pragma unroll
                    for (int j2 = 0; j2 < 2; ++j2) { const int j = 2 * jp + j2;
                        float upv[4], dnv[4];
#pragma unroll
                        for (int m = 0; m < 4; ++m) { vv[j2][m] = acc[ai][0][m][n][j];
                            upv[m] = __int_as_float(__builtin_amdgcn_update_dpp(0, __float_as_int(vv[j2][m]), 0x121, 0xf, 0xf, false));
                            dnv[m] = __int_as_float(__builtin_amdgcn_update_dpp(0, __float_as_int(vv[j2][m]), 0x12F, 0xf, 0xf, false)); }
#pragma unroll
                        for (int m = 0; m < 4; ++m) {
                            float pv = fr > 0 ? upv[m] : (m > 0 ? upv[m > 0 ? m - 1 : 0] : htop[j]);
                            float nv = fr < 15 ? dnv[m] : (m < 3 ? dnv[m < 3 ? m + 1 : 3] : hbot[j]);
                            pvv[j2][m] = (BND && (flp[ai] & (1u << (8 * m)))) ? 0.f : pv; nvv[j2][m] = (BND && (flp[ai] & (2u << (8 * m)))) ? 0.f : nv; } }
                    const f32x2 W0 = (f32x2){w0[2 * jp], w0[2 * jp + 1]}, W1 = (f32x2){w1[2 * jp], w1[2 * jp + 1]}, W2 = (f32x2){w2[2 * jp], w2[2 * jp + 1]}, BB = (f32x2){bb[2 * jp], bb[2 * jp + 1]};
#pragma unroll
                    for (int m = 0; m < 4; ++m) {
                        const f32x2 P = (f32x2){pvv[0][m], pvv[1][m]}, V = (f32x2){vv[0][m], vv[1][m]}, N = (f32x2){nvv[0][m], nvv[1][m]};
                        const f32x2 a = W0 * P + (W1 * V + (W2 * N + BB));
                        const f32x2 t = a * (f32x2){-1.4426950408889634f, -1.4426950408889634f};
                        const f32x2 den = (f32x2){__builtin_amdgcn_exp2f(t[0]), __builtin_amdgcn_exp2f(t[1])} + (f32x2){1.f, 1.f};
                        const f32x2 r = (f32x2){fast_rcp(den[0]), fast_rcp(den[1])};
                        const f32x2 o = (a * r) * (f32x2){acc[ai][1][m][n][2 * jp], acc[ai][1][m][n][2 * jp + 1]};
                        pk[m][jp] = cvt_pk_bf16(o[0], o[1]); }
                    __builtin_amdgcn_sched_barrier(0);
                }
#pragma unroll
                for (int m = 0; m < 4; ++m) if (flp[ai] & (4u << (8 * m))) { u32x2 w; w.x = pk[m][0]; w.y = pk[m][1];
                    st_stream((u32x2*)(act + (size_t)(254 * u.pm - 1 + 128 * ai + 64 * wr + 16 * m + fr) * DFF + cf0 + 4 * n), w); }
                __builtin_amdgcn_sched_barrier(0);
            }
        }
        };
        const bool anyb = __builtin_amdgcn_ballot_w64(((flp[0] | flp[1]) & 0x03030303u) != 0u) != 0ull;
        if (anyb) conv(std::true_type{}); else conv(std::false_type{});
    }
};
#define LDS_WAIT() asm volatile("s_waitcnt lgkmcnt(0)" ::: "memory")
DI void cvt_item(const float* W, int ldw, int col0, bf16_t* WT, int ldt, int k0, int n0, LAS float* scr, int lane, const float* gain = nullptr) {
    { float w[32]; const float* wp = W + (size_t)(k0 + (lane >> 5)) * ldw + col0 + n0 + (lane & 31);
#pragma unroll
        for (int i = 0; i < 32; ++i) w[i] = wp[(size_t)(2 * i) * ldw];
        if (gain) {
#pragma unroll
            for (int i = 0; i < 32; ++i) w[i] *= gain[k0 + 2 * i + (lane >> 5)]; }
#pragma unroll
        for (int i = 0; i < 32; ++i) scr[(2 * i + (lane >> 5)) * 33 + (lane & 31)] = w[i]; }
    LDS_WAIT(); asm volatile("" ::: "memory");
    const int c = lane & 7;
#pragma unroll
    for (int j = 0; j < 4; ++j) { const int n = (lane >> 3) + 8 * j; const LAS float* s = scr + (8 * c) * 33 + n;
        u32x4 o; o.x = cvt_pk_bf16(s[0 * 33], s[1 * 33]); o.y = cvt_pk_bf16(s[2 * 33], s[3 * 33]); o.z = cvt_pk_bf16(s[4 * 33], s[5 * 33]); o.w = cvt_pk_bf16(s[6 * 33], s[7 * 33]);
        *(u32x4*)(WT + (size_t)(n0 + n) * ldt + k0 + 8 * c) = o; }
    LDS_WAIT(); asm volatile("" ::: "memory");
}
struct CvtCursor { int cur, base, step; };
DI void cvt_job(CvtCursor& cc, const float* W, int ldw, int col0, int ncols, int K, bf16_t* WT, int ldt, LAS float* scr, int lane, const float* gain = nullptr) {
    const int nb = ncols / 32, n = (K / 64) * nb;
    while (cc.cur < cc.base + n) { const int it = cc.cur - cc.base; cvt_item(W, ldw, col0, WT, ldt, 64 * (it / nb), 32 * (it % nb), scr, lane, gain); cc.cur += cc.step; }
    cc.base += n;
}
DI void cvt_ffn(Frame& F, CvtCursor& cc, int li, LAS float* scr) {
    bf16_t* wg = (bf16_t*)F.WFFN(); bf16_t* wu = wg + (size_t)DFF * D; bf16_t* wd = wu + (size_t)DFF * D;
    cvt_job(cc, F.I(25) + (size_t)li * D * DFF, DFF, 0, DFF, D, wg, D, scr, F.lane(), F.I(4) + (size_t)li * D);
    cvt_job(cc, F.I(26) + (size_t)li * D * DFF, DFF, 0, DFF, D, wu, D, scr, F.lane(), F.I(4) + (size_t)li * D);
    cvt_job(cc, F.I(29) + (size_t)li * DFF * D, D, 0, D, DFF, wd, DFF, scr, F.lane());
}
DI void cvt_rg(Frame& F, CvtCursor& cc, int j, int li, LAS float* scr) {
    bf16_t* win = (bf16_t*)F.WMIX(); bf16_t* gates = win + (size_t)4096 * D; bf16_t* wout = gates + (size_t)32 * 65536;
    cvt_job(cc, F.I(6) + (size_t)j * D * 4096, 4096, 0, 4096, D, win, D, scr, F.lane(), F.I(3) + (size_t)li * D);
    {
        const int n = 32 * 32;
        while (cc.cur < cc.base + n) { const int it = cc.cur - cc.base; const int bid = it >> 5, sub = it & 31; const int gate = bid >> 4, dir = (bid >> 3) & 1, blk = bid & 7;
            const float* src = F.I(gate ? 11 : 9) + (size_t)((j * 2 + dir) * 8 + blk) * 65536;
            cvt_item(src, 256, 0, gates + (size_t)((dir * 2 + gate) * 8 + blk) * 65536, 256, 64 * (sub >> 3), 32 * (sub & 7), scr, F.lane()); cc.cur += cc.step; }
        cc.base += n; }
    cvt_job(cc, F.I(14) + (size_t)j * D * D, D, 0, D, D, wout, D, scr, F.lane());
}
DI void cvt_na(Frame& F, CvtCursor& cc, LAS float* scr) {
    bf16_t* wqkv = (bf16_t*)F.WMIX(); bf16_t* wo = wqkv + (size_t)6144 * D;
    cvt_job(cc, F.I(15), 6144, 0, 6144, D, wqkv, D, scr, F.lane(), F.I(3) + (size_t)1 * D);
    cvt_job(cc, F.I(18), D, 0, D, D, wo, D, scr, F.lane());
}
DI void cvt_gdn(Frame& F, CvtCursor& cc, LAS float* scr) {
    bf16_t* w0 = (bf16_t*)F.WMIX(); bf16_t* w1 = w0 + (size_t)6400 * D; bf16_t* wout = w1 + (size_t)6144 * D;
    const float* W = F.I(19);
    for (int g = 0; g < 2; ++g) { bf16_t* w = g ? w1 : w0;
        cvt_job(cc, W, 12416, g * 1024, 1024, D, w, D, scr, F.lane(), F.I(3) + (size_t)2 * D);
        cvt_job(cc, W, 12416, 2048 + g * 1024, 1024, D, w + (size_t)1024 * D, D, scr, F.lane(), F.I(3) + (size_t)2 * D);
        cvt_job(cc, W, 12416, 4096 + g * 2048, 2048, D, w + (size_t)2048 * D, D, scr, F.lane(), F.I(3) + (size_t)2 * D);
        cvt_job(cc, W, 12416, 8192 + g * 2048, 2048, D, w + (size_t)4096 * D, D, scr, F.lane(), F.I(3) + (size_t)2 * D); }
    cvt_job(cc, W, 12416, 12288, 128, D, w0 + (size_t)6144 * D, D, scr, F.lane(), F.I(3) + (size_t)2 * D);
    cvt_job(cc, F.I(24), D, 0, D, 4096, wout, 4096, scr, F.lane());
}

DI float rs_tag(int R, float rs) { int b, t; row_bt(R, b, t); const unsigned f = (t == 0 ? 1u : 0u) | ((b < NSEQ && t == seq_len(b) - 1) ? 2u : 0u); return __uint_as_float((__float_as_uint(rs) & ~3u) | f); }
template <int MODE> DI void norm_phase(Frame& F, bf16_t* X, const float* gain, float* rsv, const bf16_t* xin2 = nullptr, const float* slab = nullptr) {
    const int gw = F.bid * 8 + F.wave, NGW = F.G * 8, lane = F.lane();
    if (MODE == 1) {
        for (int i = F.bid * 512 + F.tid(); i < (MP - MTOK + 1) * (D / 8); i += F.G * 512) { const int r = i / (D / 8), c = i % (D / 8); const int R = r == 0 ? -1 : MTOK + r - 1;
            *(u32x4*)(X + (long)R * D + c * 8) = (u32x4){0u, 0u, 0u, 0u}; }
        for (int i = F.bid * 512 + F.tid(); i < MP - MTOK; i += F.G * 512) rsv[MTOK + i] = 0.f;
    }
    for (int R = gw; R < MTOK; R += NGW) {
        int b, t; row_bt(R, b, t);
        bf16_t* xr = X + (size_t)R * D;
        if (MODE == 2 && t < NMETA) continue;
        f32x4 v[8]; float s = 0.f;
        if (MODE == 1) {
            const float* src; if (t < NMETA) src = F.I(2) + (size_t)t * D; else if (b < NPROMPT) src = F.I(0) + ((size_t)b * LP + (t - NMETA)) * D; else src = F.I(1) + ((size_t)(b - NPROMPT) * LS + (t - NMETA)) * D;
#pragma unroll
            for (int j = 0; j < 8; ++j) { const f32x4 x = *(const f32x4*)(src + 4 * (lane + 64 * j)); u32x2 w; w.x = cvt_pk_bf16(x[0], x[1]); w.y = cvt_pk_bf16(x[2], x[3]); *(u32x2*)(xr + 4 * (lane + 64 * j)) = w;
                v[j] = (f32x4){bf_lo(w.x), bf_hi(w.x), bf_lo(w.y), bf_hi(w.y)}; }
        } else {
#pragma unroll
            for (int j = 0; j < 8; ++j) { const u32x2 w = *(const u32x2*)((R >= RES_ROW0 && xin2 ? xin2 + (size_t)R * D : xr) + 4 * (lane + 64 * j)); v[j] = (f32x4){bf_lo(w.x), bf_hi(w.x), bf_lo(w.y), bf_hi(w.y)}; }
            if (R >= RES_ROW0 && slab) {
#pragma unroll
                for (int s = 0; s < RES_NSPLIT; ++s)
#pragma unroll
                    for (int j = 0; j < 8; ++j) v[j] += *(const f32x4*)(slab + ((size_t)s * 512 + (R - RES_ROW0)) * D + 4 * (lane + 64 * j));
#pragma unroll
                for (int j = 0; j < 8; ++j) { const unsigned w0 = cvt_pk_bf16(v[j][0], v[j][1]), w1 = cvt_pk_bf16(v[j][2], v[j][3]); v[j] = (f32x4){bf_lo(w0), bf_hi(w0), bf_lo(w1), bf_hi(w1)}; } }
        }
#pragma unroll
        for (int j = 0; j < 8; ++j) s += (v[j][0] * v[j][0] + v[j][1] * v[j][1]) + (v[j][2] * v[j][2] + v[j][3] * v[j][3]);
        const float rs = 1.0f / sqrtf(wave_sum(s) * (1.0f / D) + NORM_EPS);
        if (MODE == 1) { if (lane == 0) rsv[R] = rs_tag(R, rs); }
        else {
            float* orow = F.out + (b < NPROMPT ? ((size_t)b * LP + (t - NMETA)) : ((size_t)NPROMPT * LP + (size_t)(b - NPROMPT) * LS + (t - NMETA))) * D;
#pragma unroll
            for (int j = 0; j < 8; ++j) { const f32x4 gv = *(const f32x4*)(gain + 4 * (lane + 64 * j)); *(f32x4*)(orow + 4 * (lane + 64 * j)) = v[j] * rs * gv; }
        }
    }
}
DI void ss_final_phase(Frame& F, const float* ssp, float* rsv, const bf16_t* xin, bf16_t* xout, const float* slab0, const float* slab1) {
    for (int R = F.bid * 512 + F.tid(); R < RES_ROW0; R += F.G * 512) { const float* p = ssp + (size_t)(R >> 8) * 32 * 256 + (R & 255); float s = 0.f;
#pragma unroll
        for (int i = 0; i < 8; ++i) s += (p[(4 * i) * 256] + p[(4 * i + 1) * 256]) + (p[(4 * i + 2) * 256] + p[(4 * i + 3) * 256]);
        rsv[R] = rs_tag(R, 1.0f / sqrtf(s * (1.0f / D) + NORM_EPS)); }
    const int lane = F.lane();
    for (int R = RES_ROW0 + F.bid * 8 + F.wave; R < MP; R += F.G * 8) {
        float v[32];
#pragma unroll
        for (int i = 0; i < 4; ++i) { const u32x4 x = *(const u32x4*)(xin + (size_t)R * D + lane * 32 + 8 * i); const unsigned w[4] = {x.x, x.y, x.z, x.w};
#pragma unroll
            for (int k = 0; k < 4; ++k) { v[8 * i + 2 * k] = bf_lo(w[k]); v[8 * i + 2 * k + 1] = bf_hi(w[k]); } }
#pragma unroll
        for (int set = 0; set < 2; ++set) { const float* sl = set ? slab1 : slab0; if (!sl) continue;
#pragma unroll
            for (int s = 0; s < RES_NSPLIT; ++s) { const float* p = sl + ((size_t)s * 512 + (R - RES_ROW0)) * D + lane * 32;
#pragma unroll
                for (int i = 0; i < 8; ++i) { const f32x4 a = *(const f32x4*)(p + 4 * i); v[4 * i] += a[0]; v[4 * i + 1] += a[1]; v[4 * i + 2] += a[2]; v[4 * i + 3] += a[3]; } } }
        float sq = 0.f;
#pragma unroll
        for (int i = 0; i < 4; ++i) { u32x4 w; unsigned ww[4];
#pragma unroll
            for (int k = 0; k < 4; ++k) { ww[k] = cvt_pk_bf16(v[8 * i + 2 * k], v[8 * i + 2 * k + 1]); const float a = bf_lo(ww[k]), b = bf_hi(ww[k]); sq += a * a + b * b; }
            w.x = ww[0]; w.y = ww[1]; w.z = ww[2]; w.w = ww[3]; *(u32x4*)(xout + (size_t)R * D + lane * 32 + 8 * i) = w; }
        const float tot = wave_sum(sq);
        if (lane == 0) rsv[R] = rs_tag(R, 1.0f / sqrtf(tot * (1.0f / D) + NORM_EPS));
    }
}
DI void fill_rflag(Frame& F, unsigned char* rf) { for (int R = F.bid * 512 + F.tid(); R < MP; R += F.G * 512) { int b, t; row_bt(R, b, t); rf[R] = (unsigned char)((t == 0 ? 1 : 0) | ((b < NSEQ && t == seq_len(b) - 1) ? 2 : 0)); } }

DI void rg_conv_phase(Frame& F, const bf16_t* yrec, bf16_t* xc, const float* cw, const float* cb) {
    const int tid = F.tid(), cg = tid & 255, c0 = cg * 8;
    float w[4][8], bb[8];
#pragma unroll
    for (int j = 0; j < 4; ++j)
#pragma unroll
        for (int e = 0; e < 8; ++e) w[j][e] = cw[j * D + c0 + e];
#pragma unroll
    for (int e = 0; e < 8; ++e) bb[e] = cb[c0 + e];
    for (int s = F.bid * 2 + (tid >> 8); s < MTOK / 16; s += F.G * 2) {
        const int R0 = 16 * s; int b, t0; row_bt(R0, b, t0); const int T = seq_len(b);
        const bf16_t* yp = yrec + (size_t)R0 * D + c0;
        u32x4 x0 = (u32x4){0u, 0u, 0u, 0u}, x1, x2, x3;
        if (t0 > 0) x0 = *(const u32x4*)(yp - D);
        x1 = *(const u32x4*)(yp); x2 = *(const u32x4*)(yp + D); x3 = *(const u32x4*)(yp + 2 * D);
#pragma unroll
        for (int i = 0; i < 16; ++i) {
            u32x4 xn = (u32x4){0u, 0u, 0u, 0u};
            if (i < 15 && t0 + i + 3 < T) xn = *(const u32x4*)(yp + (size_t)(i + 3) * D);
            float a[8];
#pragma unroll
            for (int e = 0; e < 8; ++e) a[e] = bb[e];
            const u32x4 xs[4] = {x0, x1, x2, x3};
#pragma unroll
            for (int j = 0; j < 4; ++j) { const u32x4 x = xs[j];
                a[0] += w[j][0] * bf_lo(x.x); a[1] += w[j][1] * bf_hi(x.x); a[2] += w[j][2] * bf_lo(x.y); a[3] += w[j][3] * bf_hi(x.y);
                a[4] += w[j][4] * bf_lo(x.z); a[5] += w[j][5] * bf_hi(x.z); a[6] += w[j][6] * bf_lo(x.w); a[7] += w[j][7] * bf_hi(x.w); }
            u32x4 o; o.x = cvt_pk_bf16(a[0], a[1]); o.y = cvt_pk_bf16(a[2], a[3]); o.z = cvt_pk_bf16(a[4], a[5]); o.w = cvt_pk_bf16(a[6], a[7]);
            *(u32x4*)(xc + (size_t)(R0 + i) * D + c0) = o;
            x0 = x1; x1 = x2; x2 = x3; x3 = xn;
        }
    }
}

template <int N, bool REV> DI void rg_ld(const bf16_t* p, size_t base, int t0, unsigned (&w)[8]) {
#pragma unroll
    for (int i = 0; i < 8; ++i) if (i < N) w[i] = *(const unsigned*)(p + base + (size_t)(REV ? t0 - i : t0 + i) * D);
}
DI void rg_scan_phase(Frame& F, const bf16_t* laf, const bf16_t* uf, const bf16_t* lab, bf16_t* ub, const bf16_t* ygate) {
    int tid_ = F.wave * 64 + lane_id(); asm volatile("" : "+v"(tid_));
    const int tid = tid_, lane = tid & 63, wave = __builtin_amdgcn_readfirstlane(tid >> 6), seg = 2 * wave + (lane >> 5), l32 = lane & 31;
    LAS float* AGG = (LAS float*)F.lds;
    LAS float* CB = AGG + 2 * 16 * 256;
    int items[3]; int ni = 0;
    if (F.G == 256) { if (F.bid < 128) { items[0] = F.bid; items[1] = 128 + F.bid; items[2] = 0; ni = 2; } else { const int b0 = 256 + 3 * (F.bid - 128); items[0] = b0; items[1] = b0 + 1; items[2] = b0 + 2; ni = 3; } }
    for (int ii = 0; ; ++ii) {
        int id;
        if (F.G == 256) { if (ii >= ni) break; id = ii == 0 ? items[0] : (ii == 1 ? items[1] : items[2]); } else { id = F.bid + ii * F.G; if (id >= 640) break; }
        const int b = id < 128 ? NPROMPT + (id >> 5) : ((id - 128) >> 5), cg = id & 31;
        const int T = seq_len(b), SL = T >> 4, NC = T >> 7, nb = NC >> 4;
        const size_t base = (size_t)seq_off(b) * D + cg * 64 + l32 * 2;
        {
            const int s1 = seg * SL + SL - 1;
            float slb0 = 0.f, slb1 = 0.f, hb0 = 0.f, hb1 = 0.f, r1s0 = 0.f, r1s1 = 0.f, r1h0 = 0.f, r1h1 = 0.f, r2s0 = 0.f, r2s1 = 0.f, r2h0 = 0.f, r2h1 = 0.f;
            const int w1 = seg, w2 = 128 + seg;
            unsigned lb[8], ub_[8], lr[8], ur[8];
            rg_ld<1, true>(lab, base, s1 - (SL - 1), lr); rg_ld<1, true>(ub, base, s1 - (SL - 1), ur);
            rg_ld<8, true>(lab, base, s1, lb); rg_ld<8, true>(ub, base, s1, ub_);
            for (int i0 = 0; i0 + 8 <= SL; i0 += 8) {
                unsigned lbn[8], ubn[8];
#pragma unroll
                for (int i = 0; i < 8; ++i) { lbn[i] = 0u; ubn[i] = 0u; }
                if (i0 + 16 <= SL) { rg_ld<8, true>(lab, base, s1 - i0 - 8, lbn); rg_ld<8, true>(ub, base, s1 - i0 - 8, ubn); }
#pragma unroll
                for (int i = 0; i < 8; ++i) { const float c0 = bf_lo(lb[i]), c1 = bf_hi(lb[i]); slb0 += c0; slb1 += c1; hb0 = __expf(c0) * hb0 + bf_lo(ub_[i]); hb1 = __expf(c1) * hb1 + bf_hi(ub_[i]);
                    const bool q1 = (i0 + i == w1), q2 = (i0 + i == w2);
                    r1s0 = q1 ? slb0 : r1s0; r1s1 = q1 ? slb1 : r1s1; r1h0 = q1 ? hb0 : r1h0; r1h1 = q1 ? hb1 : r1h1;
                    r2s0 = q2 ? slb0 : r2s0; r2s1 = q2 ? slb1 : r2s1; r2h0 = q2 ? hb0 : r2h0; r2h1 = q2 ? hb1 : r2h1; }
#pragma unroll
                for (int i = 0; i < 8; ++i) { lb[i] = lbn[i]; ub_[i] = ubn[i]; }
            }
            { const float c0 = bf_lo(lr[0]), c1 = bf_hi(lr[0]); slb0 += c0; slb1 += c1; hb0 = __expf(c0) * hb0 + bf_lo(ur[0]); hb1 = __expf(c1) * hb1 + bf_hi(ur[0]);
                const bool q1 = (SL - 1 == w1), q2 = (SL - 1 == w2);
                r1s0 = q1 ? slb0 : r1s0; r1s1 = q1 ? slb1 : r1s1; r1h0 = q1 ? hb0 : r1h0; r1h1 = q1 ? hb1 : r1h1;
                r2s0 = q2 ? slb0 : r2s0; r2s1 = q2 ? slb1 : r2s1; r2h0 = q2 ? hb0 : r2h0; r2h1 = q2 ? hb1 : r2h1; }
            __syncthreads();
            { LAS float* a = AGG + seg * 256 + 2 * l32; *(LAS f32x2*)(a) = (f32x2){slb0, slb1}; *(LAS f32x2*)(a + 64) = (f32x2){hb0, hb1}; }
            __syncthreads();
            float cb0 = 0.f, cb1 = 0.f;
            for (int v = 15; v > seg; --v) { const LAS float* a = AGG + v * 256 + 2 * l32; const f32x2 sl = *(const LAS f32x2*)(a), hh = *(const LAS f32x2*)(a + 64); cb0 = hh[0] + __expf(sl[0]) * cb0; cb1 = hh[1] + __expf(sl[1]) * cb1; }
            *(LAS f32x2*)(CB + (nb * seg + nb) * 64 + 2 * l32) = (f32x2){r1h0 + __expf(r1s0) * cb0, r1h1 + __expf(r1s1) * cb1};
            if (nb == 2) *(LAS f32x2*)(CB + (nb * seg + nb - 1) * 64 + 2 * l32) = (f32x2){r2h0 + __expf(r2s0) * cb0, r2h1 + __expf(r2s1) * cb1};
            __syncthreads();
        }
        float CF0 = 0.f, CF1 = 0.f;
        unsigned A_lf[8], A_uf[8], A_lb[8], A_ub[8], A_g[8];
        { const int t0 = 8 * seg; rg_ld<8, false>(laf, base, t0, A_lf); rg_ld<8, false>(uf, base, t0, A_uf); rg_ld<8, false>(lab, base, t0, A_lb); rg_ld<8, false>(ub, base, t0, A_ub); rg_ld<8, false>(ygate, base, t0, A_g); }
        for (int c = 0; c <= NC; ++c) {
            const bool tail = (c == NC);
            const int tb = 128 * c + (tail ? seg : 8 * seg);
            unsigned B_lf[8], B_uf[8], B_lb[8], B_ub[8], B_g[8];
#pragma unroll
            for (int i = 0; i < 8; ++i) { B_lf[i] = 0u; B_uf[i] = 0u; B_lb[i] = 0u; B_ub[i] = 0u; B_g[i] = 0u; }
            if (c + 1 < NC) { const int t0 = 128 * (c + 1) + 8 * seg; rg_ld<8, false>(laf, base, t0, B_lf); rg_ld<8, false>(uf, base, t0, B_uf); rg_ld<8, false>(lab, base, t0, B_lb); rg_ld<8, false>(ub, base, t0, B_ub); rg_ld<8, false>(ygate, base, t0, B_g); }
            else if (c + 1 == NC) { const int t0 = 128 * NC + seg; rg_ld<1, false>(laf, base, t0, B_lf); rg_ld<1, false>(uf, base, t0, B_uf); rg_ld<1, false>(lab, base, t0, B_lb); rg_ld<1, false>(ub, base, t0, B_ub); rg_ld<1, false>(ygate, base, t0, B_g); }
            float af0[8], af1[8], ab0[8], ab1[8];
            float slf0 = 0.f, slf1 = 0.f, hf0 = 0.f, hf1 = 0.f, slb0 = 0.f, slb1 = 0.f, hb0 = 0.f, hb1 = 0.f;
#pragma unroll
            for (int i = 0; i < 8; ++i) { const float a0 = bf_lo(A_lf[i]), a1 = bf_hi(A_lf[i]); slf0 += a0; slf1 += a1; af0[i] = __expf(a0); af1[i] = __expf(a1); hf0 = af0[i] * hf0 + bf_lo(A_uf[i]); hf1 = af1[i] * hf1 + bf_hi(A_uf[i]); }
#pragma unroll
            for (int i = 7; i >= 0; --i) { const float c0 = bf_lo(A_lb[i]), c1 = bf_hi(A_lb[i]); slb0 += c0; slb1 += c1; ab0[i] = __expf(c0); ab1[i] = __expf(c1); hb0 = ab0[i] * hb0 + bf_lo(A_ub[i]); hb1 = ab1[i] * hb1 + bf_hi(A_ub[i]); }
            LAS float* ag = AGG + (c & 1) * 4096;
            { LAS float* a = ag + seg * 256 + 2 * l32; *(LAS f32x2*)(a) = (f32x2){slf0, slf1}; *(LAS f32x2*)(a + 64) = (f32x2){hf0, hf1}; *(LAS f32x2*)(a + 128) = (f32x2){slb0, slb1}; *(LAS f32x2*)(a + 192) = (f32x2){hb0, hb1}; }
            __syncthreads();
            float cf0 = CF0, cf1 = CF1;
            for (int v = 0; v < seg; ++v) { const LAS float* a = ag + v * 256 + 2 * l32; const f32x2 sl = *(const LAS f32x2*)(a), hh = *(const LAS f32x2*)(a + 64); cf0 = hh[0] + __expf(sl[0]) * cf0; cf1 = hh[1] + __expf(sl[1]) * cf1; }
            { float e0 = cf0, e1 = cf1;
                for (int v = seg; v < 16; ++v) { const LAS float* a = ag + v * 256 + 2 * l32; const f32x2 sl = *(const LAS f32x2*)(a), hh = *(const LAS f32x2*)(a + 64); e0 = hh[0] + __expf(sl[0]) * e0; e1 = hh[1] + __expf(sl[1]) * e1; }
                CF0 = e0; CF1 = e1; }
            float cb0 = 0.f, cb1 = 0.f;
            if (!tail) { const f32x2 r = *(const LAS f32x2*)(CB + (c + 1) * 64 + 2 * l32); cb0 = r[0]; cb1 = r[1]; }
            for (int v = 15; v > seg; --v) { const LAS float* a = ag + v * 256 + 2 * l32; const f32x2 sl = *(const LAS f32x2*)(a + 128), hh = *(const LAS f32x2*)(a + 192); cb0 = hh[0] + __expf(sl[0]) * cb0; cb1 = hh[1] + __expf(sl[1]) * cb1; }
            float f0[8], f1[8];
#pragma unroll
            for (int i = 0; i < 8; ++i) { cf0 = af0[i] * cf0 + bf_lo(A_uf[i]); cf1 = af1[i] * cf1 + bf_hi(A_uf[i]); f0[i] = cf0; f1[i] = cf1; }
#pragma unroll
            for (int i = 7; i >= 0; --i) { cb0 = ab0[i] * cb0 + bf_lo(A_ub[i]); cb1 = ab1[i] * cb1 + bf_hi(A_ub[i]);
                f0[i] = bf_lo(A_g[i]) * (f0[i] + cb0); f1[i] = bf_hi(A_g[i]) * (f1[i] + cb1); }
            if (!tail) {
#pragma unroll
                for (int i = 0; i < 8; ++i) *(unsigned*)(ub + base + (size_t)(tb + i) * D) = cvt_pk_bf16(f0[i], f1[i]);
            } else *(unsigned*)(ub + base + (size_t)tb * D) = cvt_pk_bf16(f0[0], f1[0]);
#pragma unroll
            for (int i = 0; i < 8; ++i) { A_lf[i] = B_lf[i]; A_uf[i] = B_uf[i]; A_lb[i] = B_lb[i]; A_ub[i] = B_ub[i]; A_g[i] = B_g[i]; }
        }
    }
}
constexpr int NA_VPITCH = 144;
constexpr int NA_WAVE_LDS = 32 * NA_VPITCH * 2 + 2048;
DI void na_attn_phase(Frame& F, const bf16_t* qkv, bf16_t* O, const float* rpb, const float* mbias) {
    int tid_ = F.wave * 64 + lane_id(); asm volatile("" : "+v"(tid_));
    const int lane = tid_ & 63, l15 = lane & 15, quad = lane >> 4;
    LAS unsigned char* wl = F.lds + F.wave * NA_WAVE_LDS;
    LAS bf16_t* vt = (LAS bf16_t*)wl;
    LAS float* rp = (LAS float*)(wl + 32 * NA_VPITCH * 2);
    int cached_h = -1;
    const float scale = 0.08838834764831845f;
    const int NITEMS = MTOK;
    for (int id = F.bid * 8 + F.wave; id < NITEMS; id += F.G * 8) {
        int b, h, it, rows;
        if (id < MPROMPT) { const int bh = id / 129; it = id - bh * 129; b = bh >> 4; h = bh & 15; rows = 32; }
        else { const int i2 = id - MPROMPT; const int bh = i2 / 257; it = i2 - bh * 257; b = NPROMPT + (bh >> 4); h = bh & 15; rows = 64; }
        const bool is_meta = (it == rows * 4);
        const int r = it >> 2, n = it & 3;
        const int so = seq_off(b);
        if (h != cached_h) {
            __builtin_amdgcn_wave_barrier();
            for (int i = lane; i < 465; i += 64) rp[i] = rpb[h * 465 + i];
            if (lane < 16) rp[480 + lane] = mbias[h * 16 + lane];
            cached_h = h; LDS_WAIT(); __builtin_amdgcn_wave_barrier(); asm volatile("" ::: "memory");
        }
        int rs = r - 4; rs = rs < 0 ? 0 : (rs > rows - 8 ? rows - 8 : rs);
        int ks = 16 * n - 8; ks = ks < 0 ? 0 : (ks > 32 ? 32 : ks);
        const int qrow = is_meta ? so + l15 : so + NMETA + 64 * r + 16 * n + l15;
        const int qcol = 16 * n + l15; int cs = qcol - 8; cs = cs < 0 ? 0 : (cs > 48 ? 48 : cs);
        bf16x8 qf[4];
#pragma unroll
        for (int s = 0; s < 4; ++s) qf[s] = *(const bf16x8*)(qkv + (size_t)qrow * 6144 + h * 128 + 32 * s + 8 * quad);
        f32x4 sv[17];
#pragma unroll
        for (int kb = 0; kb < 17; ++kb) sv[kb] = (f32x4){-1e30f, -1e30f, -1e30f, -1e30f};
        if (!is_meta) {
#pragma unroll
            for (int kb0 = 0; kb0 < 16; kb0 += 8) {
                bf16x8 kf[8][4];
#pragma unroll
                for (int i = 0; i < 8; ++i) { const int kb = kb0 + i, kr = kb >> 1; const int krow = so + NMETA + 64 * (rs + kr) + ks + 16 * (kb & 1) + l15;
#pragma unroll
                    for (int s = 0; s < 4; ++s) kf[i][s] = *(const bf16x8*)(qkv + (size_t)krow * 6144 + 2048 + h * 128 + 32 * s + 8 * quad); }
#pragma unroll
                for (int i = 0; i < 8; ++i) { const int kb = kb0 + i, kr = kb >> 1;
                    f32x4 st = (f32x4){0.f, 0.f, 0.f, 0.f};
#pragma unroll
                    for (int s = 0; s < 4; ++s) st = __builtin_amdgcn_mfma_f32_16x16x32_bf16(kf[i][s], qf[s], st, 0, 0, 0);
                    const int roff = (rs + kr) - r + 7;
#pragma unroll
                    for (int g = 0; g < 4; ++g) { const int keycol = ks + 16 * (kb & 1) + 4 * quad + g; const bool valid = (keycol >= cs) && (keycol < cs + 16);
                        int coff = keycol - qcol; coff = coff < -15 ? -15 : (coff > 15 ? 15 : coff);
                        sv[kb][g] = valid ? st[g] * scale + rp[roff * 31 + coff + 15] : -1e30f; }
                }
            }
        }
        {
            const int krow = so + l15;
            f32x4 st = (f32x4){0.f, 0.f, 0.f, 0.f};
#pragma unroll
            for (int s = 0; s < 4; ++s) { const bf16x8 kf = *(const bf16x8*)(qkv + (size_t)krow * 6144 + 2048 + h * 128 + 32 * s + 8 * quad);
                st = __builtin_amdgcn_mfma_f32_16x16x32_bf16(kf, qf[s], st, 0, 0, 0); }
#pragma unroll
            for (int g = 0; g < 4; ++g) sv[16][g] = st[g] * scale + rp[480 + 4 * quad + g];
        }
#define NA_LDV(B_, KR_) do { _Pragma("unroll") for (int i = 0; i < 8; ++i) { const int cid = i * 64 + lane, vr = cid >> 4, c16 = cid & 15; B_[i] = (u32x4){0u, 0u, 0u, 0u}; \
            if ((KR_) < 8) B_[i] = *(const u32x4*)(qkv + (size_t)(so + NMETA + 64 * (rs + (KR_)) + ks + vr) * 6144 + 4096 + h * 128 + 8 * c16); \
            else if ((KR_) == 8 && vr < 16) B_[i] = *(const u32x4*)(qkv + (size_t)(so + vr) * 6144 + 4096 + h * 128 + 8 * c16); } } while (0)
        u32x4 vb[3][8];
        if (!is_meta) { NA_LDV(vb[0], 0); NA_LDV(vb[1], 1); NA_LDV(vb[2], 2); }
        else { NA_LDV(vb[2], 8);
#pragma unroll
            for (int i = 0; i < 8; ++i) { vb[0][i] = (u32x4){0u, 0u, 0u, 0u}; vb[1][i] = vb[0][i]; } }
        float mx = -1e30f;
#pragma unroll
        for (int kb = 0; kb < 17; ++kb)
#pragma unroll
            for (int g = 0; g < 4; ++g) mx = fmaxf(mx, sv[kb][g]);
        mx = fmaxf(mx, __shfl_xor(mx, 16)); mx = fmaxf(mx, __shfl_xor(mx, 32));
        float sum = 0.f;
#pragma unroll
        for (int kb = 0; kb < 17; ++kb)
#pragma unroll
            for (int g = 0; g < 4; ++g) { const float p = __expf(sv[kb][g] - mx); sv[kb][g] = p; sum += p; }
        sum += __shfl_xor(sum, 16); sum += __shfl_xor(sum, 32);
        const float inv = 1.0f / sum;
        f32x4 ot[8];
#pragma unroll
        for (int d = 0; d < 8; ++d) ot[d] = (f32x4){0.f, 0.f, 0.f, 0.f};
#pragma unroll
        for (int kr = 0; kr < 9; ++kr) {
            if (!(is_meta && kr < 8)) {
            __builtin_amdgcn_wave_barrier(); asm volatile("" ::: "memory");
#pragma unroll
            for (int i = 0; i < 8; ++i) { const int cid = i * 64 + lane, vr = cid >> 4, c16 = cid & 15; *(LAS u32x4*)(vt + vr * NA_VPITCH + 8 * c16) = vb[kr % 3][i]; }
            LDS_WAIT(); __builtin_amdgcn_wave_barrier(); asm volatile("" ::: "memory");
            if (!is_meta && kr + 3 <= 8) NA_LDV(vb[kr % 3], kr + 3);
            f32x4 p0, p1;
            if (kr < 8) { p0 = sv[2 * kr]; p1 = sv[2 * kr + 1]; } else { p0 = sv[16]; p1 = (f32x4){0.f, 0.f, 0.f, 0.f}; }
            u32x4 pw; pw.x = cvt_pk_bf16(p0[0] * inv, p0[1] * inv); pw.y = cvt_pk_bf16(p0[2] * inv, p0[3] * inv); pw.z = cvt_pk_bf16(p1[0] * inv, p1[1] * inv); pw.w = cvt_pk_bf16(p1[2] * inv, p1[3] * inv);
            const bf16x8 pf = __builtin_bit_cast(bf16x8, pw);
            const LAS bf16_t* tb = vt + (4 * quad + (l15 >> 2)) * NA_VPITCH + 4 * (l15 & 3);
#pragma unroll
            for (int d = 0; d < 8; ++d) {
                const s16x4 lo = __builtin_amdgcn_ds_read_tr16_b64_v4i16((LAS s16x4*)(tb + 16 * d)), hi = __builtin_amdgcn_ds_read_tr16_b64_v4i16((LAS s16x4*)(tb + 16 * NA_VPITCH + 16 * d));
                const bf16x8 vf = (bf16x8){lo[0], lo[1], lo[2], lo[3], hi[0], hi[1], hi[2], hi[3]};
                ot[d] = __builtin_amdgcn_mfma_f32_16x16x32_bf16(vf, pf, ot[d], 0, 0, 0);
            }
            }
        }
#pragma unroll
        for (int d = 0; d < 8; ++d) { u32x2 w; w.x = cvt_pk_bf16(ot[d][0], ot[d][1]); w.y = cvt_pk_bf16(ot[d][2], ot[d][3]);
            *(u32x2*)(O + (size_t)qrow * D + h * 128 + 16 * d + 4 * quad) = w; }
    }
}
constexpr int GD_QS = 0, GD_KS = 17408, GD_VS = 34816, GD_ABF = 52224, GD_ADG = 61440, GD_TIB = 66560, GD_KST = 68608, GD_QKM = 87040, GD_WB = 96256, GD_VEC = 113664, GD_CW = 114944, GD_END = 121088;
constexpr int GD_O = 114944;
constexpr int P_QS = 136, P_KST = 72, P_ADG = 20, P_O = 132;
typedef short bf16x4 __attribute__((ext_vector_type(4)));

DI void gdn_conv_phase(Frame& F, int half, bf16_t* qkvp, const bf16_t* halo, const float* conv_w) {
    int tid_ = F.wave * 64 + lane_id(); asm volatile("" : "+v"(tid_));
    const int tid = tid_, piece = tid & 63, tg = tid >> 6;
    constexpr int NIT = (MTOK / 64) * 8;
    for (int item = F.bid; item < NIT; item += F.G) {
        const bool ivld = true;
        const int rb = item >> 3, cs = item & 7, col = cs * 512 + piece * 8;
        const int X = col < 1024 ? 0 : (col < 2048 ? 1 : 2);
        const int wcol = X == 0 ? half * 1024 + col : (X == 1 ? 2048 + half * 1024 + (col - 1024) : 4096 + half * 2048 + (col - 2048));
        const int r0 = 64 * rb + 8 * tg; int b, t0; row_bt(r0, b, t0); const int T = seq_len(b);
        u32x4 xr[11];
#pragma unroll
        for (int r = 0; r < 11; ++r) { const int tt = t0 - 1 + r, w = r0 - 1 + r; xr[r] = (u32x4){0u, 0u, 0u, 0u};
            if (ivld && tt >= 0 && tt < T) { const bf16_t* p;
                if (w < 64 * rb) p = halo + ((size_t)rb * 3 + 0) * 4096 + col; else if (w >= 64 * rb + 64) p = halo + ((size_t)rb * 3 + 1 + (w - 64 * rb - 64)) * 4096 + col; else p = qkvp + (size_t)w * 4096 + col;
                xr[r] = *(const u32x4*)p; } }
        f32x4 wlo[4], whi[4];
#pragma unroll
        for (int j = 0; j < 4; ++j) { wlo[j] = *(const f32x4*)(conv_w + j * 8192 + wcol); whi[j] = *(const f32x4*)(conv_w + j * 8192 + wcol + 4); }
        u32x4 res[8];
#pragma unroll
        for (int ro = 0; ro < 8; ++ro) {
            float a[8];
#pragma unroll
            for (int e = 0; e < 8; ++e) a[e] = 0.f;
#pragma unroll
            for (int j = 0; j < 4; ++j) { const u32x4 x = xr[ro + j];
                a[0] += wlo[j][0] * bf_lo(x.x); a[1] += wlo[j][1] * bf_hi(x.x); a[2] += wlo[j][2] * bf_lo(x.y); a[3] += wlo[j][3] * bf_hi(x.y);
                a[4] += whi[j][0] * bf_lo(x.z); a[5] += whi[j][1] * bf_hi(x.z); a[6] += whi[j][2] * bf_lo(x.w); a[7] += whi[j][3] * bf_hi(x.w); }
            float ss = 0.f;
#pragma unroll
            for (int e = 0; e < 8; ++e) { a[e] = siluf_(a[e]); ss += a[e] * a[e]; }
            ss += __shfl_xor(ss, 1); ss += __shfl_xor(ss, 2); ss += __shfl_xor(ss, 4); ss += __shfl_xor(ss, 8);
            const float sc = X == 2 ? 1.0f : (1.0f / sqrtf(ss + 1e-6f)) * (X == 0 ? 0.08838834764831845f : 1.0f);
            res[ro] = (u32x4){cvt_pk_bf16(a[0] * sc, a[1] * sc), cvt_pk_bf16(a[2] * sc, a[3] * sc), cvt_pk_bf16(a[4] * sc, a[5] * sc), cvt_pk_bf16(a[6] * sc, a[7] * sc)};
        }
        __syncthreads();
        if (ivld) {
#pragma unroll
            for (int ro = 0; ro < 8; ++ro) *(u32x4*)(qkvp + (size_t)(r0 + ro) * 4096 + col) = res[ro]; }
    }
}
DI bf16x8 frag_perm(const LAS bf16_t* rowp, int kbase, int quad) {
    const s16x4 a = *(const LAS s16x4*)(rowp + kbase + 4 * quad), b = *(const LAS s16x4*)(rowp + kbase + 16 + 4 * quad);
    bf16x8 r; r[0] = a[0]; r[1] = a[1]; r[2] = a[2]; r[3] = a[3]; r[4] = b[0]; r[5] = b[1]; r[6] = b[2]; r[7] = b[3]; return r;
}
DI bf16x8 pack_acc(const f32x4 a, const f32x4 b) { const u32x4 w = pack8(a, b); return __builtin_bit_cast(bf16x8, w); }
DI bf16x4 pack4(const f32x4 a) { u32x2 w; w.x = cvt_pk_bf16(a[0], a[1]); w.y = cvt_pk_bf16(a[2], a[3]); return __builtin_bit_cast(bf16x4, w); }
#define MFMA16(a, b, c) __builtin_amdgcn_mfma_f32_16x16x16bf16_1k((a), (b), (c), 0, 0, 0)


DI void gd_tok_ab(int n, int dir, int& A, int& sg) { sg = dir ? -1 : 1; A = n == 0 ? (dir ? 15 : -48) : NMETA + 64 * (n - 1) + (dir ? 63 : 0); }
DI int gd_tok(int n, int dir, int slot) { int A, sg; gd_tok_ab(n, dir, A, sg); return A + sg * slot; }
DI void gd_fetch(const bf16_t* qkvp, const float* bg, int so, int hl, int ql, int hv, int n, int dir, int tid, int wave, u32x4 (&pf)[6], float& gv, float& bv) {
    int A, sg; gd_tok_ab(n, dir, A, sg);
    const int pc = tid & 15, cq = ql * 128 + 8 * pc, ck = 1024 + cq, cv = 2048 + hl * 128 + 8 * pc;
#pragma unroll
    for (int h2 = 0; h2 < 2; ++h2) { const int t = A + sg * ((tid >> 4) + 32 * h2);
        pf[h2] = pf[2 + h2] = pf[4 + h2] = (u32x4){0u, 0u, 0u, 0u};
        if (t >= 0) { const bf16_t* rp = qkvp + (size_t)(so + t) * 4096; pf[h2] = *(const u32x4*)(rp + cq); pf[2 + h2] = *(const u32x4*)(rp + ck); pf[4 + h2] = *(const u32x4*)(rp + cv); } }
    gv = 0.f; bv = 0.f;
    if (wave == 0) { const int t1 = A + sg * (tid & 63); if (t1 >= 0) { const float* p = bg + (size_t)(so + t1) * 128 + dir * 32 + hv; bv = p[0]; gv = p[64]; } }
}
#define GD_BAR() asm volatile("s_waitcnt lgkmcnt(0)\n\ts_barrier" ::: "memory")
#define GD_IDS() int tq_ = tid0; asm volatile("" : "+v"(tq_)); const int tid = tq_, lane = tid & 63, l15 = lane & 15, quad = lane >> 4, tau = tid >> 3, sub = tid & 7; (void)l15; (void)quad; (void)tau; (void)sub; (void)lane;
constexpr int GD_OB_SPLIT = 48640;
DI bf16_t* gd_ob_row(bf16_t* obA, bf16_t* obB, int R) { return R < GD_OB_SPLIT ? obA + (size_t)R * D : obB + (size_t)(R - GD_OB_SPLIT) * D; }
DI void gdn_core_phase(Frame& F, int half, const bf16_t* qkvp, const float* bg, bf16_t* og, bf16_t* obA, bf16_t* obB) {
    int tid_ = F.wave * 64 + lane_id(); asm volatile("" : "+v"(tid_));
    const int tid0 = tid_, wave = __builtin_amdgcn_readfirstlane(tid0 >> 6);
    LAS unsigned char* L = F.lds;
    LAS bf16_t* QS = (LAS bf16_t*)(L + GD_QS); LAS bf16_t* KS = (LAS bf16_t*)(L + GD_KS); LAS bf16_t* VS = (LAS bf16_t*)(L + GD_VS);
    LAS bf16_t* ABF = (LAS bf16_t*)(L + GD_ABF); LAS float* ADG = (LAS float*)(L + GD_ADG); LAS bf16_t* TIB = (LAS bf16_t*)(L + GD_TIB);
    LAS bf16_t* KST = (LAS bf16_t*)(L + GD_KST); LAS bf16_t* QKM = (LAS bf16_t*)(L + GD_QKM);
    LAS bf16_t* WB = (LAS bf16_t*)(L + GD_WB); LAS float* OL = (LAS float*)(L + GD_O);
    LAS float* GC = (LAS float*)(L + GD_VEC); LAS float* BETA = GC + 64; LAS float* EG = GC + 128; LAS float* EKL = GC + 192; LAS float* GL = GC + 256;
    for (int ii = 0; ; ++ii) {
        int id;
        if (F.G == 256) { if (F.bid < 128) { if (ii >= 2) break; id = ii == 0 ? F.bid : 128 + F.bid; } else { if (ii >= 3) break; id = 256 + 3 * (F.bid - 128) + ii; } }
        else { id = F.bid + ii * F.G; if (id >= NSEQ * 32) break; }
        const int s_ = id < 128 ? id : id - 128;
        const int b = id < 128 ? NPROMPT + (s_ >> 5) : (s_ >> 5), hl = (s_ >> 1) & 15, dir = s_ & 1, hv = half * 16 + hl, ql = hl >> 1;
        const int so = seq_off(b), T = seq_len(b), NC = 1 + (T - NMETA) / 64;
        __syncthreads();
        {
            f32x4 Sacc[8];
#pragma unroll
            for (int i = 0; i < 8; ++i) Sacc[i] = (f32x4){0.f, 0.f, 0.f, 0.f};
            u32x4 pf[6]; float pgv, pbv;
            gd_fetch(qkvp, bg, so, hl, ql, hv, dir ? NC - 1 : 0, dir, tid0, wave, pf, pgv, pbv);
#define GD_S5() do { if (tprev >= 0) { GD_IDS(); f32x4 o[4]; _Pragma("unroll") for (int i = 0; i < 4; ++i) o[i] = *(const LAS f32x4*)(OL + tau * P_O + 16 * sub + 4 * i); \
                *(u32x4*)(gpprev) = pack8(o[0], o[1]); *(u32x4*)(gpprev + 8) = pack8(o[2], o[3]); } } while (0)
            int tprev = -1; bf16_t* gpprev = og;
            for (int step = 0; step < NC; ++step) {
                const int n = dir ? NC - 1 - step : step;
                int t, R; float gv = 0.f, bv = 0.f; bf16_t* gp;
                GD_S5();
                { GD_IDS();
                t = gd_tok(n, dir, tau);
                R = so + (t < 0 ? 0 : t);
#pragma unroll
                for (int i = 0; i < 6; ++i) { const int X = i >> 1, slot = (tid >> 4) + 32 * (i & 1), pc = tid & 15;
                    LAS bf16_t* dst = (X == 0 ? QS : (X == 1 ? KS : VS)) + slot * P_QS + 8 * pc;
                    *(LAS u32x4*)(dst) = pf[i];
                    if (X == 1) { const unsigned w4[4] = {pf[i].x, pf[i].y, pf[i].z, pf[i].w};
#pragma unroll
                        for (int e = 0; e < 8; ++e) KST[(8 * pc + e) * P_KST + slot] = (bf16_t)((e & 1) ? (w4[e >> 1] >> 16) : (w4[e >> 1] & 0xffffu)); } }
                gv = pgv; bv = pbv;
                if (step + 1 < NC) gd_fetch(qkvp, bg, so, hl, ql, hv, dir ? NC - 2 - step : step + 1, dir, tid, wave, pf, pgv, pbv);
                gp = (dir ? gd_ob_row(obA, obB, R) : og + (size_t)R * D) + hl * 128 + 16 * sub;
                }
                if (wave == 0) { GD_IDS();
                    float c = gv;
#pragma unroll
                    for (int o = 1; o < 64; o <<= 1) { const float y = __shfl_up(c, o); if (lane >= o) c += y; }
                    const float gl = __shfl(c, 63);
                    GC[lane] = c; BETA[lane] = bv; EG[lane] = __expf(c); EKL[lane] = __expf(gl - c); if (lane == 0) GL[0] = __expf(gl);
                }
                GD_BAR();
                { GD_IDS();
                    const int cb = wave >> 1;
                    bf16x8 ka[4], qa[4];
#pragma unroll
                    for (int ks = 0; ks < 4; ++ks) { ka[ks] = *(const LAS bf16x8*)(KS + (16 * cb + l15) * P_QS + 32 * ks + 8 * quad); qa[ks] = *(const LAS bf16x8*)(QS + (16 * cb + l15) * P_QS + 32 * ks + 8 * quad); }
                    const f32x4 gcc = *(const LAS f32x4*)(GC + 16 * cb + 4 * quad), btc = *(const LAS f32x4*)(BETA + 16 * cb + 4 * quad);
#pragma unroll
                    for (int s2 = 0; s2 < 2; ++s2) { const int sb = 2 * (wave & 1) + s2;
                        f32x4 kk = (f32x4){0.f, 0.f, 0.f, 0.f}, qk = kk;
#pragma unroll
                        for (int ks = 0; ks < 4; ++ks) { const bf16x8 kb = *(const LAS bf16x8*)(KS + (16 * sb + l15) * P_QS + 32 * ks + 8 * quad);
                            kk = __builtin_amdgcn_mfma_f32_16x16x32_bf16(ka[ks], kb, kk, 0, 0, 0); qk = __builtin_amdgcn_mfma_f32_16x16x32_bf16(qa[ks], kb, qk, 0, 0, 0); }
                        const int s = 16 * sb + l15; const float gcs = GC[s];
#pragma unroll
                        for (int g = 0; g < 4; ++g) { const int c = 16 * cb + 4 * quad + g;
                            const float dec = (s <= c) ? __expf(fminf(gcc[g] - gcs, 0.f)) : 0.f;
                            const float av = (s < c) ? btc[g] * kk[g] * dec : 0.f;
                            QKM[c * P_KST + s] = f2bf(qk[g] * dec);
                            ABF[c * P_KST + s] = f2bf(av);
                            if (sb == cb) ADG[(cb * 16 + 4 * quad + g) * P_ADG + l15] = av; }
                    }
                }
                GD_BAR();
                if (wave == 0) { GD_IDS();
                    float tcol[16];
#pragma unroll
                    for (int r = 0; r < 16; ++r) { float acc = (r == l15) ? 1.f : 0.f;
                        const LAS float* lr = ADG + (quad * 16 + r) * P_ADG;
#pragma unroll
                        for (int s4 = 0; s4 < (r + 3) / 4; ++s4) { const f32x4 lv = *(const LAS f32x4*)(lr + 4 * s4);
#pragma unroll
                            for (int e = 0; e < 4; ++e) if (4 * s4 + e < r) acc -= lv[e] * tcol[4 * s4 + e]; }
                        tcol[r] = acc; TIB[(quad * 16 + r) * 16 + l15] = f2bf(acc); }
                }
                f32x4 ru[4], rw[4];
                { GD_IDS();
#pragma unroll
                for (int k = 0; k < 4; ++k) { const f32x4 bt = *(const LAS f32x4*)(BETA + 16 * k + 4 * quad), eg = *(const LAS f32x4*)(EG + 16 * k + 4 * quad);
#pragma unroll
                    for (int g = 0; g < 4; ++g) { const int c = 16 * k + 4 * quad + g;
                        ru[k][g] = bf2f(VS[c * P_QS + 16 * wave + l15]) * bt[g]; rw[k][g] = bf2f(KS[c * P_QS + 16 * wave + l15]) * (bt[g] * eg[g]); } } }
                GD_BAR();
                f32x4 uu[4];
                { GD_IDS();
                    bf16x4 xu[4], xw[4];
#pragma unroll
                    for (int k = 0; k < 4; ++k) {
                        f32x4 su = (f32x4){0.f, 0.f, 0.f, 0.f}, sw = su;
#pragma unroll
                        for (int j = 0; j < 4; ++j) if (j < k) { const bf16x4 af = *(const LAS bf16x4*)(ABF + (16 * k + l15) * P_KST + 16 * j + 4 * quad);
                            su = MFMA16(af, xu[j], su); sw = MFMA16(af, xw[j], sw); }
                        const bf16x4 tf = *(const LAS bf16x4*)(TIB + (k * 16 + l15) * 16 + 4 * quad);
                        const f32x4 z4 = (f32x4){0.f, 0.f, 0.f, 0.f};
                        const f32x4 xuk = MFMA16(tf, pack4(ru[k] - su), z4), xwk = MFMA16(tf, pack4(rw[k] - sw), z4);
                        uu[k] = xuk; xu[k] = pack4(xuk); xw[k] = pack4(xwk);
#pragma unroll
                        for (int g = 0; g < 4; ++g) WB[(16 * k + 4 * quad + g) * P_QS + 16 * wave + l15] = f2bf(xwk[g]);
                    }
                }
                GD_BAR();
                { GD_IDS();
                    bf16x8 Sb[4];
#pragma unroll
                    for (int ks = 0; ks < 4; ++ks) Sb[ks] = pack_acc(Sacc[2 * ks], Sacc[2 * ks + 1]);
                    f32x4 vn[4], oo[4];
#pragma unroll
                    for (int cb = 0; cb < 4; ++cb) {
                        f32x4 ws = (f32x4){0.f, 0.f, 0.f, 0.f}, qs = ws;
#pragma unroll
                        for (int ks = 0; ks < 4; ++ks) { ws = __builtin_amdgcn_mfma_f32_16x16x32_bf16(frag_perm(WB + (16 * cb + l15) * P_QS, 32 * ks, quad), Sb[ks], ws, 0, 0, 0);
                            qs = __builtin_amdgcn_mfma_f32_16x16x32_bf16(frag_perm(QS + (16 * cb + l15) * P_QS, 32 * ks, quad), Sb[ks], qs, 0, 0, 0); }
                        const f32x4 egc = *(const LAS f32x4*)(EG + 16 * cb + 4 * quad);
                        vn[cb] = uu[cb] - ws; oo[cb] = egc * qs;
                    }
                    bf16x8 vb[2];
#pragma unroll
                    for (int kc = 0; kc < 2; ++kc) vb[kc] = pack_acc(vn[2 * kc], vn[2 * kc + 1]);
#pragma unroll
                    for (int cb = 0; cb < 4; ++cb) {
#pragma unroll
                        for (int kc = 0; kc < 2; ++kc) oo[cb] = __builtin_amdgcn_mfma_f32_16x16x32_bf16(frag_perm(QKM + (16 * cb + l15) * P_KST, 32 * kc, quad), vb[kc], oo[cb], 0, 0, 0);
#pragma unroll
                        for (int g = 0; g < 4; ++g) OL[(16 * cb + 4 * quad + g) * P_O + 16 * wave + l15] = oo[cb][g];
                        const f32x4 ek = *(const LAS f32x4*)(EKL + 16 * cb + 4 * quad);
                        vn[cb] = vn[cb] * ek;
                    }
#pragma unroll
                    for (int kc = 0; kc < 2; ++kc) vb[kc] = pack_acc(vn[2 * kc], vn[2 * kc + 1]);
                    const float egl = GL[0];
#pragma unroll
                    for (int db = 0; db < 8; ++db) { f32x4 s = Sacc[db] * egl;
#pragma unroll
                        for (int kc = 0; kc < 2; ++kc) s = __builtin_amdgcn_mfma_f32_16x16x32_bf16(frag_perm(KST + (16 * db + l15) * P_KST, 32 * kc, quad), vb[kc], s, 0, 0, 0);
                        Sacc[db] = s; }
                }
                GD_BAR();
                tprev = t; gpprev = gp;
            }
            GD_S5();
        }
    }
}

DI void gdn_combine_phase(Frame& F, bf16_t* og, bf16_t* obA, bf16_t* obB, const bf16_t* zb, const float* norm_w) {
    const int lane = F.lane(), e0 = (lane & 15) * 8;
    f32x4 nw0 = *(const f32x4*)(norm_w + e0), nw1 = *(const f32x4*)(norm_w + e0 + 4);
    for (int R = F.bid * 8 + F.wave; R < MTOK; R += F.G * 8) {
        bf16_t* op = og + (size_t)R * D + lane * 8; const bf16_t* bp = gd_ob_row(obA, obB, R) + lane * 8; const bf16_t* zp = zb + (size_t)R * D + lane * 8;
        u32x4 f[4], g[4], z[4];
#pragma unroll
        for (int q = 0; q < 4; ++q) { f[q] = *(const u32x4*)(op + 512 * q); g[q] = *(const u32x4*)(bp + 512 * q); z[q] = *(const u32x4*)(zp + 512 * q); }
#pragma unroll
        for (int q = 0; q < 4; ++q) {
            const unsigned fw[4] = {f[q].x, f[q].y, f[q].z, f[q].w}, gw[4] = {g[q].x, g[q].y, g[q].z, g[q].w}, zw[4] = {z[q].x, z[q].y, z[q].z, z[q].w};
            float o[8], zz[8]; float ss = 0.f;
#pragma unroll
            for (int k = 0; k < 4; ++k) { o[2 * k] = bf_lo(fw[k]) + bf_lo(gw[k]); o[2 * k + 1] = bf_hi(fw[k]) + bf_hi(gw[k]); zz[2 * k] = bf_lo(zw[k]); zz[2 * k + 1] = bf_hi(zw[k]); }
#pragma unroll
            for (int e = 0; e < 8; ++e) ss += o[e] * o[e];
            ss += __shfl_xor(ss, 1); ss += __shfl_xor(ss, 2); ss += __shfl_xor(ss, 4); ss += __shfl_xor(ss, 8);
            const float rn = 1.0f / sqrtf(ss * (1.0f / 128.0f) + NORM_EPS);
            f32x4 a, b2;
#pragma unroll
            for (int k = 0; k < 4; ++k) { a[k] = o[k] * rn * nw0[k] * siluf_(zz[k]); b2[k] = o[4 + k] * rn * nw1[k] * siluf_(zz[4 + k]); }
            *(u32x4*)(op + 512 * q) = pack8(a, b2);
        }
    }
}
constexpr int N_PHASES = 38;
#ifndef ALIGN_RES
#define ALIGN_RES true
#endif
#ifndef ALIGN_CONS
#define ALIGN_CONS true
#endif
#ifndef WGM_DEF
#define WGM_DEF 4
#endif
#ifndef WGM_RES
#define WGM_RES 4
#endif
#ifndef WGM_FFU
#define WGM_FFU 4
#endif
#ifndef WGM_GATES
#define WGM_GATES 4
#endif
DI pg8::Gemm mk_gemm(const void* A, unsigned lda, const void* B, unsigned ldb, long hB, int nt) { pg8::Gemm g; g.A = (const char*)A; g.B = (const char*)B; g.lda = lda; g.ldb = ldb; g.hstepA = 128L * lda; g.hstepB = hB; g.nt = nt; return g; }
DI SchedLin mk_lin(Frame& F, int nM, int nN, long a_base, long a_tile, long b_base, long b_tile, int nt = 32, int wgm = WGM_DEF) { SchedLin s; s.o.init(nM, nN, F.G, F.bid, wgm); s.a_base = a_base; s.a_tile = a_tile; s.b_base = b_base; s.b_tile = b_tile; s.nt = nt; return s; }
DI SchedRes mk_res(Frame& F, long a_tile, long b_base, long b_tile, int nt, int wgm = WGM_RES) { SchedRes s; s.init(F.G, F.bid, a_tile, b_base, b_tile, nt, wgm); return s; }

__global__ void __launch_bounds__(512, 2) trunk_fwd(Args args) {
    extern __shared__ __attribute__((aligned(16))) unsigned char lds_raw[];
    Frame F;
    F.lds = (LAS unsigned char*)lds_raw;
    F.wave = __builtin_amdgcn_readfirstlane(threadIdx.x >> 6); F.G = gridDim.x; F.bid = blockIdx.x;
    F.in = args.in; F.out = args.out; F.ws = args.ws;
    volatile LAS unsigned* MISC = (volatile LAS unsigned*)(F.lds + MISC_OFF);
    if (F.tid() < 16) MISC[F.tid()] = 0u;
    __syncthreads();
    const int lo = args.ph_lo, hi = args.ph_hi;
    unsigned* ctl = (unsigned*)(F.ws + WS_CTL);
    XcdBarrier bar; bar.bar = ctl + CW_BAR; bar.x = 0; bar.st = nullptr;
    if (hi - lo > 1) bar = xcd_barrier_post(ctl + CW_BAR, MISC + 8, F.wave == 0 && lane_id() == 0);
#define IN(k) (lo <= (k) && (k) < hi)
#define SEAM(k) do { if (IN(k) && IN((k) + 1)) xcd_barrier(bar, F.wave == 0 && lane_id() == 0); } while (0)
#ifndef REP_MASK
#define REP_MASK 0ull
#endif
#define PHASE(k, ...) if (IN(k)) { if constexpr (((REP_MASK) >> (k)) & 1ull) { __VA_ARGS__; xcd_barrier(bar, F.wave == 0 && lane_id() == 0); } __VA_ARGS__; } SEAM(k);
    LAS float* cscr = (LAS float*)(F.lds + F.wave * 16384);
    bf16_t* const XNp = F.XN(); bf16_t* const XCp = F.XC(); unsigned char* const SCR = F.SCR();
    bf16_t* const OUTB = (bf16_t*)F.out;
    constexpr unsigned LD2K = 4096;


#define CVT_BEGIN() CvtCursor cc{F.bid * 8 + F.wave, 0, F.G * 8}
#define CVT_BEGIN_RES() CvtCursor cc{(F.G == 256) ? (F.bid >= 64 ? (F.bid - 64) * 8 + F.wave : 0x3fffffff) : F.bid * 8 + F.wave, 0, (F.G == 256) ? 192 * 8 : F.G * 8}
#define PH_FIN(XI_, XO_, S1_, ...) { CVT_BEGIN(); __VA_ARGS__; ss_final_phase(F, ssp, rsv, XI_, XO_, SLAB0, S1_); }
#define PH_FFN_UP(LI_, X_) { bf16_t* wg = (bf16_t*)F.WFFN(); \
        pg8::Gemm g = mk_gemm(X_, LD2K, wg, LD2K, (long)DFF * LD2K, 32); SchedLin S = mk_lin(F, 195, 44, -(long)LD2K, 254L * LD2K, 0, 128L * LD2K, 32, WGM_FFU); \
        EpiFfnUp E{(bf16_t*)SCR, F.I(27) + (size_t)(LI_) * 3 * DFF, F.I(28) + (size_t)(LI_) * DFF, (LAS float*)(F.lds + EDGE_OFF), rsv, (const unsigned char*)(F.ws + WS_CTL + 768 * 1024)}; \
        pg8::gemm_phase<EpiFfnUp, SchedLin, true>(F.lds, g, S, E, F.wave); }
#define PH_FFN_DOWN(XI_, XO_, SS_, ...) { bf16_t* wd = (bf16_t*)F.WFFN() + (size_t)2 * DFF * D; \
        pg8::Gemm g = mk_gemm(SCR, DFF * 2, wd, DFF * 2, 128L * DFF * 2, 88); SchedRes S = mk_res(F, 256L * DFF * 2, 0, 256L * DFF * 2, 88); \
        EpiResAdd E{XI_, XO_, SS_, SLAB0}; pg8::gemm_phase<EpiResAdd, SchedRes, ALIGN_RES>(F.lds, g, S, E, F.wave); { CVT_BEGIN_RES(); __VA_ARGS__; } }
#define PH_RG_IN(X_) { bf16_t* win = (bf16_t*)F.WMIX(); \
        pg8::Gemm g = mk_gemm(X_, LD2K, win, LD2K, 128L * LD2K, 32); SchedLin S = mk_lin(F, 194, 16, 0, 256L * LD2K, 0, 256L * LD2K); \
        EpiRgIn E{OUTB, (bf16_t*)SCR, rsv}; pg8::gemm_phase<EpiRgIn, SchedLin, ALIGN_CONS>(F.lds, g, S, E, F.wave); }
#define PH_RG_CONV(J_) { rg_conv_phase(F, (const bf16_t*)SCR, XCp, F.I(7) + (size_t)(J_) * 4 * D, F.I(8) + (size_t)(J_) * D); }
#define PH_RG_GATES(J_) { bf16_t* gates = (bf16_t*)F.WMIX() + (size_t)4096 * D; \
        pg8::Gemm g = mk_gemm(XCp, LD2K, gates, 512, 8L * 131072, 4); SchedGates S; S.o.init(194, 32, F.G, F.bid, WGM_GATES); \
        EpiGates E{XCp, (bf16_t*)SCR, (bf16_t*)(SCR + B194), B194, F.I(10) + (size_t)(J_) * 2 * D, F.I(12) + (size_t)(J_) * 2 * D, F.I(13) + (size_t)(J_) * 2 * D, (LAS float*)(F.lds + EDGE_OFF)}; \
        pg8::gemm_phase<EpiGates, SchedGates, true>(F.lds, g, S, E, F.wave); }
#define PH_RG_SCAN() { rg_scan_phase(F, (const bf16_t*)SCR, (bf16_t*)(SCR + B194), (const bf16_t*)(SCR + 2 * B194), (bf16_t*)(SCR + 3 * B194), OUTB); }
#define PH_RG_OUT(XI_, XO_, ...) { bf16_t* wout = (bf16_t*)F.WMIX() + (size_t)4096 * D + (size_t)32 * 65536; \
        pg8::Gemm g = mk_gemm(SCR + 3 * B194, LD2K, wout, LD2K, 128L * LD2K, 32); SchedRes S = mk_res(F, 256L * LD2K, 0, 256L * LD2K, 32); \
        EpiResAdd E{XI_, XO_, ssp, SLAB0}; pg8::gemm_phase<EpiResAdd, SchedRes, ALIGN_RES>(F.lds, g, S, E, F.wave); { CVT_BEGIN_RES(); __VA_ARGS__; } }
#define PH_GDN_PROJ(HALF_, X_) { bf16_t* w = (bf16_t*)F.WMIX() + ((HALF_) ? (size_t)6400 * D : 0); \
        pg8::Gemm g = mk_gemm(X_, LD2K, w, LD2K, 128L * LD2K, 32); SchedLin S = mk_lin(F, 194, (HALF_) ? 24 : 25, 0, 256L * LD2K, 0, 256L * LD2K); \
        EpiGdnProj E{(bf16_t*)SCR, (HALF_) ? (bf16_t*)(SCR + 2 * B194) : XB, (float*)(SCR + 3 * B194), F.I(21), F.I(22), (bf16_t*)(SCR + 3 * B194 + 26 * MiB), rsv}; pg8::gemm_phase<EpiGdnProj, SchedLin, ALIGN_CONS>(F.lds, g, S, E, F.wave); }
#define PH_GDN_CONV(HALF_) { gdn_conv_phase(F, HALF_, (bf16_t*)SCR, (const bf16_t*)(SCR + 3 * B194 + 26 * MiB), F.I(20)); }
#define GD_OBA (OUTB + (size_t)MP * D)
#define GD_OBB ((bf16_t*)(SCR + 3 * B194 + 48 * MiB))
#define PH_GDN_CORE(HALF_) { gdn_core_phase(F, HALF_, (const bf16_t*)SCR, (const float*)(SCR + 3 * B194), (HALF_) ? XCp : OUTB, GD_OBA, GD_OBB); }
#define PH_GDN_COMB(HALF_) { gdn_combine_phase(F, (HALF_) ? XCp : OUTB, GD_OBA, GD_OBB, (HALF_) ? (const bf16_t*)(SCR + 2 * B194) : (const bf16_t*)XB, F.I(23)); }
#define PH_GDN_OUT(HALF_, XI_, XO_, SS_, ...) { bf16_t* wout = (bf16_t*)F.WMIX() + (size_t)(6400 + 6144) * D; \
        pg8::Gemm g = mk_gemm((HALF_) ? XCp : OUTB, LD2K, wout, 8192, 128L * 8192, 32); SchedRes S = mk_res(F, 256L * LD2K, (long)(HALF_) * 4096, 256L * 8192, 32); \
        EpiResAdd E{XI_, XO_, SS_, (HALF_) ? SLAB1 : SLAB0}; pg8::gemm_phase<EpiResAdd, SchedRes, ALIGN_RES>(F.lds, g, S, E, F.wave); { CVT_BEGIN_RES(); __VA_ARGS__; } }
    float* const SLAB0 = (float*)(SCR + 784 * MiB); float* const SLAB1 = (float*)(SCR + 640 * MiB); float* const NOSLAB = nullptr;
    float* const ssp = (float*)(SCR + 4 * B194);
    float* const rsv = (float*)(F.ws + WS_CTL + 256 * 1024);
    bf16_t* const NOXN = nullptr; float* const NOSS = nullptr; (void)NOXN;

    bf16_t* const XA = XNp; bf16_t* const XB = (bf16_t*)(F.ws + WS_H + B194);
    PHASE(0, { CVT_BEGIN(); cvt_rg(F, cc, 0, 0, cscr); cvt_ffn(F, cc, 0, cscr); fill_rflag(F, (unsigned char*)(F.ws + WS_CTL + 768 * 1024)); norm_phase<1>(F, XA, F.I(3), rsv); })
    PHASE(1, PH_RG_IN(XA)) PHASE(2, PH_RG_CONV(0)) PHASE(3, PH_RG_GATES(0)) PHASE(4, PH_RG_SCAN()) PHASE(5, PH_RG_OUT(XA, XB, (void)cc))
    PHASE(6, PH_FIN(XA, XB, NOSLAB, (void)cc))
    PHASE(7, PH_FFN_UP(0, XB)) PHASE(8, PH_FFN_DOWN(XB, XA, ssp, cvt_na(F, cc, cscr))) PHASE(9, PH_FIN(XB, XA, NOSLAB, (void)cc))
    PHASE(10, { pg8::Gemm g = mk_gemm(XA, LD2K, F.WMIX(), LD2K, 128L * LD2K, 32); SchedLin S = mk_lin(F, 194, 24, 0, 256L * LD2K, 0, 256L * LD2K);
        EpiPlainBf16 E{(bf16_t*)SCR, 6144, rsv}; pg8::gemm_phase<EpiPlainBf16, SchedLin, ALIGN_CONS>(F.lds, g, S, E, F.wave); })
    PHASE(11, { na_attn_phase(F, (const bf16_t*)SCR, OUTB, F.I(16), F.I(17)); })
    PHASE(12, { bf16_t* wo = (bf16_t*)F.WMIX() + (size_t)6144 * D;
        pg8::Gemm g = mk_gemm(OUTB, LD2K, wo, LD2K, 128L * LD2K, 32); SchedRes S = mk_res(F, 256L * LD2K, 0, 256L * LD2K, 32);
        EpiResAdd E{XA, XB, ssp, SLAB0}; pg8::gemm_phase<EpiResAdd, SchedRes, ALIGN_RES>(F.lds, g, S, E, F.wave); { CVT_BEGIN_RES(); cvt_ffn(F, cc, 1, cscr); } })
    PHASE(13, PH_FIN(XA, XB, NOSLAB, (void)cc))
    PHASE(14, PH_FFN_UP(1, XB)) PHASE(15, PH_FFN_DOWN(XB, XA, ssp, cvt_gdn(F, cc, cscr))) PHASE(16, PH_FIN(XB, XA, NOSLAB, (void)cc))
    PHASE(17, PH_GDN_PROJ(0, XA)) PHASE(18, PH_GDN_CONV(0)) PHASE(19, PH_GDN_CORE(0))
    PHASE(20, { PH_GDN_COMB(0) PH_GDN_PROJ(1, XA) }) PHASE(21, PH_GDN_CONV(1)) PHASE(22, PH_GDN_CORE(1))
    PHASE(23, { PH_GDN_COMB(1) PH_GDN_OUT(0, XA, XB, NOSS, cvt_ffn(F, cc, 2, cscr)) })
    PHASE(24, PH_GDN_OUT(1, XB, XA, ssp, (void)cc))
    PHASE(25, PH_FIN(XA, XA, SLAB1, (void)cc))
    PHASE(26, PH_FFN_UP(2, XA)) PHASE(27, PH_FFN_DOWN(XA, XB, ssp, cvt_rg(F, cc, 1, 3, cscr))) PHASE(28, PH_FIN(XA, XB, NOSLAB, (void)cc))
    PHASE(29, PH_RG_IN(XB)) PHASE(30, PH_RG_CONV(1)) PHASE(31, PH_RG_GATES(1)) PHASE(32, PH_RG_SCAN()) PHASE(33, PH_RG_OUT(XB, XA, cvt_ffn(F, cc, 3, cscr)))
    PHASE(34, PH_FIN(XB, XA, NOSLAB, (void)cc))
    PHASE(35, PH_FFN_UP(3, XA)) PHASE(36, PH_FFN_DOWN(XA, XB, NOSS, (void)cc))
    PHASE(37, { norm_phase<2>(F, XB, F.I(5), nullptr, XA, SLAB0); })
#undef IN
#undef SEAM
}

__global__ void fill_k(float* o, size_t n, float v) { for (size_t i = (size_t)blockIdx.x * blockDim.x + threadIdx.x; i < n; i += (size_t)gridDim.x * blockDim.x) o[i] = v; }
#ifndef MK_ONE_LAUNCH
#define MK_ONE_LAUNCH 1
#endif
extern "C" void kernel_launch(void* const* d_in, const int* in_sizes, int n_in, void* d_out, int out_size, void* d_ws, size_t ws_size, hipStream_t stream) {
    static int grid = 0;
    if (grid == 0) {
        int dev = 0, cus = 0;
        hipError_t e = hipGetDevice(&dev); if (e == hipSuccess) e = hipDeviceGetAttribute(&cus, hipDeviceAttributeMultiprocessorCount, dev);
        if (e == hipSuccess) e = hipFuncSetAttribute((const void*)trunk_fwd, hipFuncAttributeMaxDynamicSharedMemorySize, LDS_BYTES);
        if (e != hipSuccess || n_in != 30 || ws_size < WS_END || cus < 1) { fprintf(stderr, "kernel_launch: setup failed (%s), n_in %d, ws %zu\n", hipGetErrorName(e), n_in, ws_size); grid = -1; }
        else grid = cus;
        (void)hipGetLastError();
    }
    if (grid < 0) { fill_k<<<1024, 256, 0, stream>>>((float*)d_out, (size_t)out_size, 7.0f); return; }
    (void)hipMemsetAsync((char*)d_ws + WS_CTL, 0, CTL_ZERO_BYTES, stream);
    Args a{};
    for (int i = 0; i < 30; ++i) a.in[i] = (const float*)d_in[i];
    a.out = (float*)d_out; a.ws = (unsigned char*)d_ws;
#if MK_ONE_LAUNCH
    a.ph_lo = 0; a.ph_hi = N_PHASES;
    hipLaunchKernelGGL(trunk_fwd, dim3(grid), dim3(512), LDS_BYTES, stream, a);
#else
    for (int p = 0; p < N_PHASES; ++p) { a.ph_lo = p; a.ph_hi = p + 1; hipLaunchKernelGGL(trunk_fwd, dim3(grid), dim3(512), LDS_BYTES, stream, a); }
#endif
}
```
